# Optimizing an MI355X kernel written in HIP

```python
import math
import jax, jax.numpy as jnp
from jax import lax
import numpy as np


D_MODEL = 2048
BATCH = 2
SEQ = 16384
DEPTH = 1

HY_WIDTH = D_MODEL // 2
ATT_WIDTH = D_MODEL - HY_WIDTH
HY_ORDER = 2
HY_SHORT = 3
HY_EMB = 33
HY_BANDS = (HY_EMB - 1) // 2
HY_FFN = 64
HY_DIRS = 2
HY_TARGET = 1e-2
HY_FAST_DECAY = 0.3
HY_SLOW_DECAY = 1.5
HEAD_DIM = 128
N_HEADS = ATT_WIDTH // HEAD_DIM
N_KV_HEADS = 2
Q_PER_KV = N_HEADS // N_KV_HEADS
KV_WIDTH = N_KV_HEADS * HEAD_DIM
ROPE_THETA = 10000.0
ROPE_AXIS_DIM = HEAD_DIM // 2
GRID_W = 64
Q_BLOCK = 128
IN_WIDTH = (HY_ORDER + 1) * HY_WIDTH + ATT_WIDTH + 2 * KV_WIDTH
N_EXPERTS = 16
EXPERT_FF = 1536
CAPACITY_FACTOR = 2
NORM_EPS = 1e-6
DN_ALPHA = (2 * DEPTH) ** 0.25
DN_BETA = (8 * DEPTH) ** -0.25

kernel_name = "hymba_hyena_gqa_axial_ec_moe_deepnorm"


def layer_norm(x, g, b):
    xf = x.astype(jnp.float32)
    mu = jnp.mean(xf, axis=-1, keepdims=True)
    xc = xf - mu
    var = jnp.mean(xc * xc, axis=-1, keepdims=True)
    return (xc * lax.rsqrt(var + NORM_EPS) * g + b).astype(x.dtype)


def rms_norm(x, g):
    xf = x.astype(jnp.float32)
    return xf * lax.rsqrt(jnp.mean(xf * xf, axis=-1, keepdims=True) + NORM_EPS) * g


def short_conv(u, w, b):
    L = u.shape[1]
    pad = HY_SHORT // 2
    up = jnp.pad(u, ((0, 0), (pad, pad), (0, 0)))
    return sum(w[j] * up[:, j:j + L] for j in range(HY_SHORT)) + b


def hyena_filters(L, w1, b1, f1, w2, b2, f2, w3, decay):
    t = jnp.linspace(0.0, 1.0, L, dtype=jnp.float32)[:, None]
    w = 2.0 * math.pi * jnp.arange(L, dtype=jnp.float32)[:, None] / L
    f = jnp.linspace(1e-4, HY_BANDS - 1, HY_BANDS, dtype=jnp.float32)[None, :]
    emb = jnp.concatenate([t, jnp.cos(f * w), -jnp.sin(f * w)], axis=-1)
    h = jnp.sin(f1 * (emb @ w1 + b1))
    h = jnp.sin(f2 * (h @ w2 + b2))
    h = (h @ w3).astype(jnp.float32).reshape(L, HY_DIRS, HY_ORDER, HY_WIDTH)
    window = jnp.exp(-t.reshape(L, 1, 1, 1) * jnp.abs(decay.astype(jnp.float32)))
    return h * window


def bidir_fftconv(u, h_fwd, h_bwd, d_skip):
    L = u.shape[1]
    n = 2 * L
    g = jnp.concatenate([h_fwd, jnp.zeros((1, h_fwd.shape[1]), jnp.float32),
                         jnp.flip(h_bwd[1:], axis=0)], axis=0)
    uf = u.astype(jnp.float32)
    spec = jnp.fft.rfft(uf, n=n, axis=1) * jnp.fft.rfft(g, n=n, axis=0)[None]
    y = jnp.fft.irfft(spec, n=n, axis=1)[:, :L]
    return y + uf * d_skip.astype(jnp.float32)


def axial_rope(L):
    rows = L // GRID_W
    row = jnp.repeat(jnp.arange(rows, dtype=jnp.float32), GRID_W)
    col = jnp.tile(jnp.arange(GRID_W, dtype=jnp.float32), rows)
    inv = 1.0 / (ROPE_THETA ** (jnp.arange(0, ROPE_AXIS_DIM, 2, dtype=jnp.float32) / ROPE_AXIS_DIM))
    ang = jnp.concatenate([row[:, None] * inv, col[:, None] * inv], axis=-1)
    return jnp.cos(ang), jnp.sin(ang)


def apply_rope(x, cos, sin):
    xr = x.reshape(x.shape[:-1] + (HEAD_DIM // 2, 2))
    x0, x1 = xr[..., 0], xr[..., 1]
    c = cos[None, :, None, :]
    s = sin[None, :, None, :]
    return jnp.stack([x0 * c - x1 * s, x0 * s + x1 * c], axis=-1).reshape(x.shape)


def block_attention(q, k, v):
    B, L = q.shape[:2]
    nb = L // Q_BLOCK
    qb = q.reshape(B, nb, Q_BLOCK, N_KV_HEADS, Q_PER_KV, HEAD_DIM).transpose(1, 0, 2, 3, 4, 5)
    scale = HEAD_DIM ** -0.5

    def one_block(qi):
        s = jnp.einsum('bqhgd,bkhd->bhgqk', qi, k) * scale
        p = jax.nn.softmax(s, axis=-1)
        return jnp.einsum('bhgqk,bkhd->bqhgd', p, v)

    o = lax.map(one_block, qb)
    return o.transpose(1, 0, 2, 3, 4, 5).reshape(B, L, N_HEADS * HEAD_DIM)


def expert_choice_moe(x, w_router, b_router, w_gate, w_up, w_down):
    B, L, _ = x.shape
    C = CAPACITY_FACTOR * L // N_EXPERTS
    logits = jnp.einsum('bld,de->ble', x, w_router).astype(jnp.float32) + b_router
    aff = jax.nn.softmax(logits, axis=-1)
    gate, idx = lax.top_k(aff.transpose(0, 2, 1), C)
    bi = jnp.arange(B)[:, None, None]
    xg = x[bi, idx]
    h = jax.nn.silu(jnp.einsum('becd,edf->becf', xg, w_gate)) * jnp.einsum('becd,edf->becf', xg, w_up)
    y = jnp.einsum('becf,efd->becd', h, w_down) * gate[..., None]
    return jnp.zeros_like(x).at[bi, idx].add(y.astype(x.dtype))


def setup_inputs(seed: int = 0) -> dict:
    key = jax.random.key(seed)
    ks = jax.random.split(key, 32)
    f32 = jnp.float32
    nrm = lambda k, shape, s: jax.random.normal(k, shape, f32) * s
    x = nrm(ks[0], (BATCH, SEQ, D_MODEL), 1.0)
    w_in = nrm(ks[1], (D_MODEL, IN_WIDTH), D_MODEL ** -0.5)
    w_in = w_in.at[:, IN_WIDTH - KV_WIDTH:].multiply(DN_BETA)
    b_in = nrm(ks[2], (IN_WIDTH,), 0.01)
    hy_conv_w = nrm(ks[3], (HY_SHORT, (HY_ORDER + 1) * HY_WIDTH), HY_SHORT ** -0.5)
    hy_conv_b = nrm(ks[4], ((HY_ORDER + 1) * HY_WIDTH,), 0.01)
    hy_ffn_w1 = nrm(ks[5], (HY_EMB, HY_FFN), HY_EMB ** -0.5)
    hy_ffn_b1 = nrm(ks[6], (HY_FFN,), 0.1)
    hy_sin_f1 = 1.0 + nrm(ks[7], (HY_FFN,), 0.05)
    hy_ffn_w2 = nrm(ks[8], (HY_FFN, HY_FFN), HY_FFN ** -0.5)
    hy_ffn_b2 = nrm(ks[9], (HY_FFN,), 0.1)
    hy_sin_f2 = 1.0 + nrm(ks[10], (HY_FFN,), 0.05)
    hy_ffn_w3 = nrm(ks[11], (HY_FFN, HY_DIRS * HY_ORDER * HY_WIDTH), HY_FFN ** -0.5)
    min_rate = -math.log(HY_TARGET) / HY_SLOW_DECAY
    max_rate = -math.log(HY_TARGET) / HY_FAST_DECAY
    base = jnp.linspace(min_rate, max_rate, HY_WIDTH, dtype=f32)
    hy_decay = base * (1.0 + nrm(ks[12], (HY_DIRS, HY_ORDER, HY_WIDTH), 0.05))
    hy_skip = nrm(ks[13], (HY_ORDER, HY_WIDTH), 1.0)
    q_norm = 1.0 + nrm(ks[14], (HEAD_DIM,), 0.02)
    k_norm = 1.0 + nrm(ks[15], (HEAD_DIM,), 0.02)
    g_hy = 1.0 + nrm(ks[16], (HY_WIDTH,), 0.02)
    g_attn = 1.0 + nrm(ks[17], (ATT_WIDTH,), 0.02)
    w_out = nrm(ks[18], (D_MODEL, D_MODEL), D_MODEL ** -0.5 * DN_BETA)
    ln1_g = 1.0 + nrm(ks[19], (D_MODEL,), 0.02)
    ln1_b = nrm(ks[20], (D_MODEL,), 0.01)
    w_router = nrm(ks[21], (D_MODEL, N_EXPERTS), D_MODEL ** -0.5)
    b_router = nrm(ks[22], (N_EXPERTS,), 0.01)
    w_gate = nrm(ks[23], (N_EXPERTS, D_MODEL, EXPERT_FF), D_MODEL ** -0.5)
    w_up = nrm(ks[24], (N_EXPERTS, D_MODEL, EXPERT_FF), D_MODEL ** -0.5)
    w_down = nrm(ks[25], (N_EXPERTS, EXPERT_FF, D_MODEL), EXPERT_FF ** -0.5 * DN_BETA)
    ln2_g = 1.0 + nrm(ks[26], (D_MODEL,), 0.02)
    ln2_b = nrm(ks[27], (D_MODEL,), 0.01)
    return {"x": x, "w_in": w_in, "b_in": b_in, "hy_conv_w": hy_conv_w, "hy_conv_b": hy_conv_b,
            "hy_ffn_w1": hy_ffn_w1, "hy_ffn_b1": hy_ffn_b1, "hy_sin_f1": hy_sin_f1,
            "hy_ffn_w2": hy_ffn_w2, "hy_ffn_b2": hy_ffn_b2, "hy_sin_f2": hy_sin_f2,
            "hy_ffn_w3": hy_ffn_w3, "hy_decay": hy_decay, "hy_skip": hy_skip,
            "q_norm": q_norm, "k_norm": k_norm, "g_hy": g_hy, "g_attn": g_attn,
            "w_out": w_out, "ln1_g": ln1_g, "ln1_b": ln1_b, "w_router": w_router,
            "b_router": b_router, "w_gate": w_gate, "w_up": w_up, "w_down": w_down,
            "ln2_g": ln2_g, "ln2_b": ln2_b}


def reference(x, w_in, b_in, hy_conv_w, hy_conv_b, hy_ffn_w1, hy_ffn_b1, hy_sin_f1,
              hy_ffn_w2, hy_ffn_b2, hy_sin_f2, hy_ffn_w3, hy_decay, hy_skip,
              q_norm, k_norm, g_hy, g_attn, w_out, ln1_g, ln1_b, w_router, b_router,
              w_gate, w_up, w_down, ln2_g, ln2_b):
    B, L, _ = x.shape
    f32 = jnp.float32
    for _layer in range(DEPTH):
        proj = jnp.einsum('bld,de->ble', x, w_in) + b_in
        s1 = (HY_ORDER + 1) * HY_WIDTH
        s2 = s1 + ATT_WIDTH
        s3 = s2 + KV_WIDTH
        hy_in = short_conv(proj[..., :s1], hy_conv_w, hy_conv_b)
        hv, hx1, hx2 = jnp.split(hy_in, HY_ORDER + 1, axis=-1)
        filt = hyena_filters(L, hy_ffn_w1, hy_ffn_b1, hy_sin_f1, hy_ffn_w2, hy_ffn_b2,
                             hy_sin_f2, hy_ffn_w3, hy_decay)
        z = hx1.astype(f32) * bidir_fftconv(hv, filt[:, 0, 0], filt[:, 1, 0], hy_skip[0])
        y_hy = hx2.astype(f32) * bidir_fftconv(z, filt[:, 0, 1], filt[:, 1, 1], hy_skip[1])
        q = rms_norm(proj[..., s1:s2].reshape(B, L, N_HEADS, HEAD_DIM), q_norm)
        k = rms_norm(proj[..., s2:s3].reshape(B, L, N_KV_HEADS, HEAD_DIM), k_norm)
        v = proj[..., s3:].reshape(B, L, N_KV_HEADS, HEAD_DIM).astype(f32)
        cos, sin = axial_rope(L)
        y_att = block_attention(apply_rope(q, cos, sin), apply_rope(k, cos, sin), v)
        mixed = jnp.concatenate([rms_norm(y_hy, g_hy), rms_norm(y_att, g_attn)], axis=-1).astype(x.dtype)
        x = layer_norm(DN_ALPHA * x + jnp.einsum('ble,ed->bld', mixed, w_out), ln1_g, ln1_b)
        x = layer_norm(DN_ALPHA * x + expert_choice_moe(x, w_router, b_router, w_gate, w_up, w_down),
                       ln2_g, ln2_b)
    return x
```

```cpp
#include <hip/hip_runtime.h>
#include <cstdio>
#include <cstdint>
namespace pg8 {
#define PG8_LAS __attribute__((address_space(3)))
typedef unsigned short bf16_t;
typedef short bf16x8 __attribute__((ext_vector_type(8)));
typedef float f32x4 __attribute__((ext_vector_type(4)));
typedef unsigned u32x4 __attribute__((ext_vector_type(4)));
constexpr int BM = 256, BK = 64, HALF = 128, HTB = HALF * BK * 2  , STAGE_BYTES = 8 * HTB, NXCD = 8, WGM = 8;

__host__ __device__ __forceinline__ int lds_byte(int r, int c) { const int st = (r >> 4) * 2 + (c >> 5), rr = r & 15, cc = c & 31, ob = rr * 64 + cc * 2; return st * 1024 + (ob ^ (((ob >> 9) & 1) << 5)); }
__host__ __device__ __forceinline__ void stage_rc(int b, int& R, int& C) { const int st = b / 1024, sb = b % 1024, swz = sb ^ (((sb >> 9) & 1) << 5); R = (st >> 1) * 16 + swz / 64; C = (st & 1) * 32 + (swz % 64) / 2; }
__host__ __device__ __forceinline__ int perm32(int rho) { const int n = rho >> 4, i = rho & 15; return 8 * (i >> 2) + 4 * n + (i & 3); }

struct Unit { int pm, pn; };
struct Gemm { const bf16_t* A; const bf16_t* Bt; int M, N, K; };

struct StaticOrder {
    int nM, nN, nwg, G, c;
    __host__ __device__ void init(int M, int N, int G_, int c_) { nM = M / BM; nN = N / BM; nwg = nM * nN; G = G_; c = c_; }
    __host__ __device__ bool next(int i, Unit& u) const {
        const long L = (long)i * G + c; if (L >= nwg) return false;
        int wgid = (int)L; { const int q = nwg / NXCD, r = nwg % NXCD, xcd = wgid % NXCD, off = wgid / NXCD; wgid = (xcd < r ? xcd * (q + 1) : r * (q + 1) + (xcd - r) * q) + off; }
        const int nig = WGM * nN, gid = wgid / nig, fm = gid * WGM, gsz = (nM - fm) < WGM ? (nM - fm) : WGM;
        u.pm = fm + ((wgid % nig) % gsz); u.pn = (wgid % nig) / gsz; return true;
    }
    __device__ __forceinline__ void a_ready(const Unit&) const {}
    __device__ __forceinline__ void done(const Unit&) const {}
};

__device__ __forceinline__ unsigned cvt_pk_bf16(float lo, float hi) { unsigned r; asm volatile("v_cvt_pk_bf16_f32 %0, %1, %2" : "=v"(r) : "v"(lo), "v"(hi)); return r; }
template <class Epi, class Sched, bool ALIGN_EPI = false, bool SP2 = false>
__device__ __forceinline__ void gemm_phase(PG8_LAS unsigned char* lds, const Gemm g, const Sched& S, const Epi& E) {
    const int tid = threadIdx.x, wid = __builtin_amdgcn_readfirstlane(tid >> 6), lane = tid & 63, wr = wid >> 2, wc = wid & 3, fr = lane & 15, fq = lane >> 4;
    const int K = g.K, nt = K / BK;
    unsigned voffA[2], voffB[2];
#pragma unroll
    for (int i = 0; i < 2; ++i) { int R, C; stage_rc(tid * 16 + i * 8192, R, C); const int Rb = Epi::PERM ? ((R & ~31) + perm32(R & 31)) : R;
        voffA[i] = (unsigned)(R * K + C) * 2u; voffB[i] = (unsigned)(Rb * K + C) * 2u; }
    const size_t kstep = (size_t)(BK * 2);
    const size_t hstep = (size_t)HALF * K * 2;
    const size_t tstep = 2 * hstep;
    const unsigned ldsw = (unsigned)wid * 1024u;
    const int aoff = lds_byte(wr * 64 + fr, fq * 8), boff = lds_byte(wc * 32 + fr, fq * 8);
#define PG8_SA(b, h) (((b) * 2 + (h)) * HTB)
#define PG8_SB(b, h) ((4 + (b) * 2 + (h)) * HTB)
#define PG8_STAGE(bufoff, gbase, voff) do { _Pragma("unroll") for (int _i = 0; _i < 2; ++_i) \
        __builtin_amdgcn_global_load_lds((const unsigned*)((const char*)(gbase) + (voff)[_i]), (PG8_LAS unsigned*)(lds + (bufoff) + ldsw + _i * 8192), 16, 0, 0); } while (0)
#define PG8_LDA(dst, b, h) do { _Pragma("unroll") for (int m = 0; m < 4; ++m) _Pragma("unroll") for (int k = 0; k < 2; ++k) dst[m][k] = *(const PG8_LAS bf16x8*)(lds + PG8_SA(b, h) + aoff + m * 2048 + k * 1024); } while (0)
#define PG8_LDB(dst, b, h) do { _Pragma("unroll") for (int n = 0; n < 2; ++n) _Pragma("unroll") for (int k = 0; k < 2; ++k) dst[n][k] = *(const PG8_LAS bf16x8*)(lds + PG8_SB(b, h) + boff + n * 2048 + k * 1024); } while (0)
#define PG8_MMA(ai, bj, At, Bt) do { __builtin_amdgcn_s_setprio(1); _Pragma("unroll") for (int m = 0; m < 4; ++m) _Pragma("unroll") for (int n = 0; n < 2; ++n) _Pragma("unroll") for (int k = 0; k < 2; ++k) \
        acc[ai][bj][m][n] = __builtin_amdgcn_mfma_f32_16x16x32_bf16(Bt[n][k], At[m][k], acc[ai][bj][m][n], 0, 0, 0); __builtin_amdgcn_s_setprio(0); } while (0)
#define PG8_WAIT_V(n) asm volatile("s_waitcnt vmcnt(" #n ")" ::: "memory")
#define PG8_WAIT_L(n) asm volatile("s_waitcnt lgkmcnt(" #n ")" ::: "memory")
#define PG8_BAR __builtin_amdgcn_s_barrier()
#define PG8_SCHED __builtin_amdgcn_sched_barrier(0)
    Unit cur, nxt; int ui = 0;
    if (!S.next(0, cur)) return;
    f32x4 acc[2][2][4][2];
#pragma unroll
    for (int a = 0; a < 2; ++a)
#pragma unroll
        for (int b = 0; b < 2; ++b)
#pragma unroll
            for (int m = 0; m < 4; ++m)
#pragma unroll
                for (int n = 0; n < 2; ++n) acc[a][b][m][n] = (f32x4){0.f, 0.f, 0.f, 0.f};
    bf16x8 At[4][2], B0[2][2], B1[2][2];
    const char* cA = (const char*)g.A + (size_t)cur.pm * tstep; const char* cB = (const char*)g.Bt + (size_t)cur.pn * tstep;
    S.a_ready(cur);
    if constexpr (SP2) {
        PG8_STAGE(PG8_SB(0, 0), cB, voffB); PG8_STAGE(PG8_SB(0, 1), cB + hstep, voffB); PG8_STAGE(PG8_SA(0, 0), cA, voffA); PG8_STAGE(PG8_SA(0, 1), cA + hstep, voffA);
        if (wr == 1) PG8_BAR;
        PG8_WAIT_V(2); PG8_BAR;
        PG8_STAGE(PG8_SB(1, 0), cB + kstep, voffB); PG8_STAGE(PG8_SA(1, 0), cA + kstep, voffA); PG8_STAGE(PG8_SB(1, 1), cB + hstep + kstep, voffB);
        PG8_WAIT_V(6); PG8_BAR;
    } else {
        PG8_STAGE(PG8_SB(0, 0), cB, voffB); PG8_STAGE(PG8_SA(0, 0), cA, voffA); PG8_STAGE(PG8_SB(0, 1), cB + hstep, voffB); PG8_STAGE(PG8_SA(0, 1), cA + hstep, voffA);
        if (wr == 1) PG8_BAR;
        PG8_WAIT_V(4); PG8_BAR;
        PG8_STAGE(PG8_SB(1, 0), cB + kstep, voffB); PG8_STAGE(PG8_SA(1, 0), cA + kstep, voffA); PG8_STAGE(PG8_SB(1, 1), cB + hstep + kstep, voffB);
        PG8_WAIT_V(6); PG8_BAR;
    }
    for (;;) {
        const bool has_next = S.next(ui + 1, nxt);
        const char* nA = has_next ? (const char*)g.A + (size_t)nxt.pm * tstep : cA; const char* nB = has_next ? (const char*)g.Bt + (size_t)nxt.pn * tstep : cB;
        for (int t = 0; t < nt; t += 2) {
            const bool last = (t == nt - 2);
            const char* a1 = cA + (size_t)(t + 1) * kstep;
            const char* a2 = last ? nA : cA + (size_t)(t + 2) * kstep; const char* b2 = last ? nB : cB + (size_t)(t + 2) * kstep;
            const char* a3 = a2 + kstep; const char* b3 = b2 + kstep;
            if (last && has_next) S.a_ready(nxt);
            if constexpr (SP2) {
            PG8_LDB(B0, 0, 0); PG8_LDB(B1, 0, 1); PG8_SCHED; PG8_LDA(At, 0, 0); PG8_STAGE(PG8_SA(1, 1), a1 + hstep, voffA);
            PG8_WAIT_V(8); PG8_WAIT_L(0); PG8_BAR; PG8_MMA(0, 0, At, B0); PG8_MMA(0, 1, At, B1); PG8_BAR; PG8_SCHED;
            PG8_LDA(At, 0, 1); PG8_STAGE(PG8_SB(0, 0), b2, voffB); PG8_STAGE(PG8_SB(0, 1), b2 + hstep, voffB); PG8_STAGE(PG8_SA(0, 0), a2, voffA);
            PG8_WAIT_V(8); PG8_WAIT_L(0); PG8_BAR; PG8_MMA(1, 0, At, B0); PG8_MMA(1, 1, At, B1); PG8_BAR; PG8_SCHED;
            PG8_LDB(B0, 1, 0); PG8_LDB(B1, 1, 1); PG8_SCHED; PG8_LDA(At, 1, 0); PG8_STAGE(PG8_SA(0, 1), a2 + hstep, voffA);
            PG8_WAIT_V(8); PG8_WAIT_L(0); PG8_BAR; PG8_MMA(0, 0, At, B0); PG8_MMA(0, 1, At, B1); PG8_BAR; PG8_SCHED;
            PG8_LDA(At, 1, 1); PG8_STAGE(PG8_SB(1, 0), b3, voffB); PG8_STAGE(PG8_SB(1, 1), b3 + hstep, voffB); PG8_STAGE(PG8_SA(1, 0), a3, voffA);
            PG8_WAIT_V(8); PG8_WAIT_L(0); PG8_BAR; PG8_MMA(1, 0, At, B0); PG8_MMA(1, 1, At, B1); PG8_BAR; PG8_SCHED;
            } else {
            PG8_LDB(B0, 0, 0); PG8_SCHED; PG8_LDA(At, 0, 0); PG8_STAGE(PG8_SA(1, 1), a1 + hstep, voffA);
            PG8_WAIT_L(8); PG8_BAR; PG8_WAIT_L(0); PG8_MMA(0, 0, At, B0); PG8_BAR; PG8_SCHED;
            PG8_LDB(B1, 0, 1); PG8_STAGE(PG8_SB(0, 0), b2, voffB);
            PG8_BAR; PG8_WAIT_L(0); PG8_MMA(0, 1, At, B1); PG8_BAR;
            PG8_LDA(At, 0, 1); PG8_STAGE(PG8_SA(0, 0), a2, voffA);
            PG8_BAR; PG8_WAIT_L(0); PG8_MMA(1, 0, At, B0); PG8_BAR; PG8_SCHED;
            PG8_STAGE(PG8_SB(0, 1), b2 + hstep, voffB);
            PG8_WAIT_V(6); PG8_BAR; PG8_MMA(1, 1, At, B1); PG8_BAR;
            PG8_LDB(B0, 1, 0); PG8_SCHED; PG8_LDA(At, 1, 0); PG8_STAGE(PG8_SA(0, 1), a2 + hstep, voffA);
            PG8_WAIT_L(8); PG8_BAR; PG8_WAIT_L(0); PG8_MMA(0, 0, At, B0); PG8_BAR; PG8_SCHED;
            PG8_LDB(B1, 1, 1); PG8_STAGE(PG8_SB(1, 0), b3, voffB);
            PG8_BAR; PG8_WAIT_L(0); PG8_MMA(0, 1, At, B1); PG8_BAR;
            PG8_LDA(At, 1, 1); PG8_STAGE(PG8_SA(1, 0), a3, voffA);
            PG8_BAR; PG8_WAIT_L(0); PG8_MMA(1, 0, At, B0); PG8_BAR; PG8_SCHED;
            PG8_STAGE(PG8_SB(1, 1), b3 + hstep, voffB);
            PG8_WAIT_V(6); PG8_BAR; PG8_MMA(1, 1, At, B1); PG8_BAR;
            }
        }
        if constexpr (ALIGN_EPI) { if (wr == 0) PG8_BAR; }
        if constexpr (!Epi::AFTER_DRAIN) { E(acc, cur, wr, wc, fr, fq); S.done(cur); }
        if (!has_next) break;
#pragma unroll
        for (int a = 0; a < 2; ++a)
#pragma unroll
            for (int b = 0; b < 2; ++b)
#pragma unroll
                for (int m = 0; m < 4; ++m)
#pragma unroll
                    for (int n = 0; n < 2; ++n) acc[a][b][m][n] = (f32x4){0.f, 0.f, 0.f, 0.f};
        cur = nxt; cA = nA; cB = nB; ++ui;
        if constexpr (ALIGN_EPI) { if (wr == 1) PG8_BAR; }
    }
    PG8_WAIT_V(0);
    if constexpr (!ALIGN_EPI) { if (wr == 0) PG8_BAR; }
    PG8_BAR;
    if constexpr (Epi::AFTER_DRAIN) { E.fused(acc, cur, wr, wc, fr, fq, lds, wid, lane); S.done(cur); }
#undef PG8_SA
#undef PG8_SB
#undef PG8_STAGE
#undef PG8_LDA
#undef PG8_LDB
#undef PG8_MMA
#undef PG8_WAIT_V
#undef PG8_WAIT_L
#undef PG8_BAR
#undef PG8_SCHED
}
}
namespace pg8 {
__device__ __forceinline__ u32x4 pack8(f32x4 v0, f32x4 v1) { u32x4 w; w.x = cvt_pk_bf16(v0[0], v0[1]); w.y = cvt_pk_bf16(v0[2], v0[3]); w.z = cvt_pk_bf16(v1[0], v1[1]); w.w = cvt_pk_bf16(v1[2], v1[3]); return w; }
struct EpiColBias {
    static constexpr bool PERM = true, AFTER_DRAIN = false;
    bf16_t* O; int ldc; const float* bias;
    __device__ __forceinline__ void operator()(const f32x4 (&acc)[2][2][4][2], const Unit& u, int wr, int wc, int fr, int fq) const {
        const int row0 = u.pm * BM + wr * 64 + fr, col0 = u.pn * BM + wc * 32 + 8 * fq;
        f32x4 bv[2][2];
#pragma unroll
        for (int bj = 0; bj < 2; ++bj)
#pragma unroll
            for (int n = 0; n < 2; ++n) bv[bj][n] = *(const f32x4*)(bias + col0 + bj * HALF + 4 * n);
#pragma unroll
        for (int ai = 0; ai < 2; ++ai)
#pragma unroll
            for (int m = 0; m < 4; ++m) { bf16_t* rowp = O + (size_t)(row0 + ai * HALF + m * 16) * ldc + col0;
#pragma unroll
                for (int bj = 0; bj < 2; ++bj) *(u32x4*)(rowp + bj * HALF) = pack8(acc[ai][bj][m][0] + bv[bj][0], acc[ai][bj][m][1] + bv[bj][1]); }
    }
};
struct EpiRowBias {
    static constexpr bool PERM = true, AFTER_DRAIN = false;
    bf16_t* O; int ldc; const float* bias;
    __device__ __forceinline__ void operator()(const f32x4 (&acc)[2][2][4][2], const Unit& u, int wr, int wc, int fr, int fq) const {
        const int row0 = u.pm * BM + wr * 64 + fr, col0 = u.pn * BM + wc * 32 + 8 * fq;
#pragma unroll
        for (int ai = 0; ai < 2; ++ai)
#pragma unroll
            for (int m = 0; m < 4; ++m) { const int row = row0 + ai * HALF + m * 16; const float b = bias[row]; bf16_t* rowp = O + (size_t)row * ldc + col0;
#pragma unroll
                for (int bj = 0; bj < 2; ++bj) *(u32x4*)(rowp + bj * HALF) = pack8(acc[ai][bj][m][0] + b, acc[ai][bj][m][1] + b); }
    }
};
struct EpiFilt {
    static constexpr bool PERM = true, AFTER_DRAIN = false;
    bf16_t* O; int ldc; const float* decay;
    __device__ __forceinline__ void operator()(const f32x4 (&acc)[2][2][4][2], const Unit& u, int wr, int wc, int fr, int fq) const {
        const int row0 = u.pm * BM + wr * 64 + fr, col0 = u.pn * BM + wc * 32 + 8 * fq;
#pragma unroll
        for (int ai = 0; ai < 2; ++ai)
#pragma unroll
            for (int m = 0; m < 4; ++m) { const int row = row0 + ai * HALF + m * 16; const float dk = -fabsf(decay[row]) * (1.4426950408889634f / 16383.0f); bf16_t* rowp = O + (size_t)row * ldc + col0;
#pragma unroll
                for (int bj = 0; bj < 2; ++bj) { const float c0 = (float)(col0 + bj * HALF); f32x4 w0, w1;
#pragma unroll
                    for (int e = 0; e < 4; ++e) { w0[e] = __builtin_amdgcn_exp2f((c0 + (float)e) * dk); w1[e] = __builtin_amdgcn_exp2f((c0 + (float)(4 + e)) * dk); }
                    *(u32x4*)(rowp + bj * HALF) = pack8(acc[ai][bj][m][0] * w0, acc[ai][bj][m][1] * w1); } }
    }
};
struct EpiResid {
    static constexpr bool PERM = true, AFTER_DRAIN = false;
    bf16_t* O; int ldc; const float* x; float alpha;
    __device__ __forceinline__ void operator()(const f32x4 (&acc)[2][2][4][2], const Unit& u, int wr, int wc, int fr, int fq) const {
        const int row0 = u.pm * BM + wr * 64 + fr, col0 = u.pn * BM + wc * 32 + 8 * fq;
#pragma unroll
        for (int ai = 0; ai < 2; ++ai)
#pragma unroll
            for (int m = 0; m < 4; ++m) { const size_t off = (size_t)(row0 + ai * HALF + m * 16) * ldc + col0;
#pragma unroll
                for (int bj = 0; bj < 2; ++bj) { const f32x4 x0 = *(const f32x4*)(x + off + bj * HALF), x1 = *(const f32x4*)(x + off + bj * HALF + 4);
                    *(u32x4*)(O + off + bj * HALF) = pack8(x0 * alpha + acc[ai][bj][m][0], x1 * alpha + acc[ai][bj][m][1]); } }
    }
};
__device__ __forceinline__ float silu_f(float v) { return v * __builtin_amdgcn_rcpf(1.0f + __builtin_amdgcn_exp2f(-1.4426950408889634f * v)); }
struct EpiSwiGLU {
    static constexpr bool PERM = true, AFTER_DRAIN = false;
    bf16_t* O; int ldc; int nNe;
    __device__ __forceinline__ void operator()(const f32x4 (&acc)[2][2][4][2], const Unit& u, int wr, int wc, int fr, int fq) const {
        const int row0 = u.pm * BM + wr * 64 + fr, pl = u.pn - (u.pm >> 4) * nNe, col0 = pl * HALF + wc * 32 + 8 * fq;
#pragma unroll
        for (int ai = 0; ai < 2; ++ai)
#pragma unroll
            for (int m = 0; m < 4; ++m) { f32x4 h0, h1;
#pragma unroll
                for (int e = 0; e < 4; ++e) { h0[e] = silu_f(acc[ai][0][m][0][e]) * acc[ai][1][m][0][e]; h1[e] = silu_f(acc[ai][0][m][1][e]) * acc[ai][1][m][1][e]; }
                *(u32x4*)(O + (size_t)(row0 + ai * HALF + m * 16) * ldc + col0) = pack8(h0, h1); }
    }
};
struct EpiRowScale {
    static constexpr bool PERM = true, AFTER_DRAIN = false;
    bf16_t* O; int ldc; const float* gate; int nNe;
    __device__ __forceinline__ void operator()(const f32x4 (&acc)[2][2][4][2], const Unit& u, int wr, int wc, int fr, int fq) const {
        const int row0 = u.pm * BM + wr * 64 + fr, pl = u.pn - (u.pm >> 4) * nNe, col0 = pl * BM + wc * 32 + 8 * fq;
#pragma unroll
        for (int ai = 0; ai < 2; ++ai)
#pragma unroll
            for (int m = 0; m < 4; ++m) { const int row = row0 + ai * HALF + m * 16; const float g = gate[row]; bf16_t* rowp = O + (size_t)row * ldc + col0;
#pragma unroll
                for (int bj = 0; bj < 2; ++bj) *(u32x4*)(rowp + bj * HALF) = pack8(acc[ai][bj][m][0] * g, acc[ai][bj][m][1] * g); }
    }
};
struct GroupedOrder : StaticOrder {
    int nNe;
    __host__ __device__ void initg(int nNe_, int G_, int c_) { nNe = nNe_; init(65536, nNe_ * BM, G_, c_); }
    __host__ __device__ bool next(int i, Unit& u) const { if (!StaticOrder::next(i, u)) return false; u.pn += (u.pm >> 4) * nNe; return true; }
};
}
namespace att {
using bf16 = unsigned short;
constexpr int D = 128, NW = 8, QBLK = 32, KVBLK = 64; constexpr float SCALE = 0.088388347648318440f; constexpr float THR = 8.f; constexpr int SDEPTH = 2;
constexpr int LDQ = 1536, LDK = 128, LDO = 1024;
constexpr size_t SHM_V = KVBLK * D * 2, SHM_K = KVBLK * D * 2, SHM_ATTN = 2 * SHM_V + 2 * SHM_K + NW * 64 * 4;
using bf16x8 = __attribute__((ext_vector_type(8))) short;
using s16x4  = __attribute__((ext_vector_type(4))) short;
using f32x16 = __attribute__((ext_vector_type(16))) float;
using f32x8  = __attribute__((ext_vector_type(8))) float;
using u32x4  = __attribute__((ext_vector_type(4))) unsigned;
#define KSWZ(row, colB) ((row) * 256 + ((colB) ^ (((row) & 7) << 4)))
#define SBAR() __builtin_amdgcn_sched_barrier(0)
__device__ __forceinline__ int crow(int r, int hi) { return (r & 3) + 8 * (r >> 2) + 4 * hi; }
__device__ __forceinline__ unsigned cvtpk(float lo, float hi) {
  unsigned r; asm volatile("v_cvt_pk_bf16_f32 %0, %1, %2" : "=v"(r) : "v"(lo), "v"(hi)); return r;
}
__device__ __forceinline__ void partialSM(f32x16& p0, f32x16& p1, float& m_reg, float& mn, float& alpha) {
  constexpr float C = SCALE * 1.4426950408889634f;
  float pmax = p0[0]; for (int r = 1; r < 16; ++r) pmax = fmaxf(pmax, p0[r]); for (int r = 0; r < 16; ++r) pmax = fmaxf(pmax, p1[r]);
  { auto rr = __builtin_amdgcn_permlane32_swap(__float_as_uint(pmax), __float_as_uint(pmax), false, false);
    pmax = fmaxf(__uint_as_float(rr[0]), __uint_as_float(rr[1])); }
  if (__builtin_expect(__all(pmax - m_reg <= THR / SCALE), 1)) { mn = m_reg; alpha = 1.f; }
  else { mn = fmaxf(m_reg, pmax); alpha = __builtin_amdgcn_exp2f((m_reg - mn) * C); m_reg = mn; }
  float mnC = -mn * C;
  for (int r = 0; r < 16; ++r) p0[r] = fmaf(p0[r], C, mnC); for (int r = 0; r < 16; ++r) p1[r] = fmaf(p1[r], C, mnC);
  for (int r = 0; r < 16; ++r) p0[r] = __builtin_amdgcn_exp2f(p0[r]);
}
__device__ __forceinline__ void finishSM(f32x16& p0, f32x16& p1, float alpha, float& l_reg, bf16x8& pa0, bf16x8& pa1, bf16x8& pa2, bf16x8& pa3) {
  for (int r = 0; r < 16; ++r) p1[r] = __builtin_amdgcn_exp2f(p1[r]);
  float ps = 0; for (int r = 0; r < 16; ++r) ps += p0[r]; for (int r = 0; r < 16; ++r) ps += p1[r];
  { auto rr = __builtin_amdgcn_permlane32_swap(__float_as_uint(ps), __float_as_uint(ps), false, false);
    ps = __uint_as_float(rr[0]) + __uint_as_float(rr[1]); }
  l_reg = l_reg * alpha + ps;
#define PK4(P, BASE, OUT) do { unsigned a0 = cvtpk(P[BASE + 0], P[BASE + 1]), a1 = cvtpk(P[BASE + 2], P[BASE + 3]);   \
    unsigned b0 = cvtpk(P[BASE + 4], P[BASE + 5]), b1 = cvtpk(P[BASE + 6], P[BASE + 7]);                              \
    auto r0 = __builtin_amdgcn_permlane32_swap(a0, b0, false, false); auto r1 = __builtin_amdgcn_permlane32_swap(a1, b1, false, false); \
    u32x4 w = {r0[0], r1[0], r0[1], r1[1]}; OUT = *reinterpret_cast<bf16x8*>(&w); } while (0)
  PK4(p0, 0, pa0); PK4(p0, 8, pa1); PK4(p1, 0, pa2); PK4(p1, 8, pa3);
#undef PK4
}
__device__ __forceinline__ void qkt(f32x16& p0, f32x16& p1, const bf16* Ks, const bf16x8* qr, int r32, int hi) {
  p0 = f32x16{}; p1 = f32x16{};
  for (int d0 = 0; d0 < 8; ++d0) { int cb = (d0 * 16 + hi * 8) * 2;
    bf16x8 b0 = *reinterpret_cast<const bf16x8*>((const char*)Ks + KSWZ(r32, cb));
    bf16x8 b1 = *reinterpret_cast<const bf16x8*>((const char*)Ks + KSWZ(32 + r32, cb));
    p0 = __builtin_amdgcn_mfma_f32_32x32x16_bf16(b0, qr[d0], p0, 0, 0, 0);
    p1 = __builtin_amdgcn_mfma_f32_32x32x16_bf16(b1, qr[d0], p1, 0, 0, 0); }
}
__device__ __forceinline__ int v_st(int k, int c) { const int kk = (k & ~0xC) | ((k & 4) << 1) | ((k & 8) >> 1); return ((kk >> 3) * 4 + (c >> 5)) * 512 + ((kk & 7) * 32 + (c & 31)) * 2; }
__device__ __forceinline__ int v_rd_base(int lane) { return ((lane & 3) << 3) | (((lane >> 2) & 3) << 6) | (((lane >> 4) & 1) << 5) | (((lane >> 5) & 1) << 8); }
constexpr int v_rd_off(int d0, int ks, int half) { return d0 * 512 + ks * 4096 + half * 2048; }
template <int OFF> __device__ __forceinline__ s16x4 tr_read(int vb) {
  s16x4 r; asm volatile("ds_read_b64_tr_b16 %0, %1 offset:%2" : "=&v"(r) : "v"(vb), "i"(OFF) : "memory"); return r;
}
template <int D0> __device__ __forceinline__ void pv_one(f32x16& od, int vb, bf16x8 pa0, bf16x8 pa1, bf16x8 pa2, bf16x8 pa3) {
  const s16x4 l0 = tr_read<v_rd_off(D0, 0, 0)>(vb), h0 = tr_read<v_rd_off(D0, 0, 1)>(vb), l1 = tr_read<v_rd_off(D0, 1, 0)>(vb), h1 = tr_read<v_rd_off(D0, 1, 1)>(vb);
  const s16x4 l2 = tr_read<v_rd_off(D0, 2, 0)>(vb), h2 = tr_read<v_rd_off(D0, 2, 1)>(vb), l3 = tr_read<v_rd_off(D0, 3, 0)>(vb), h3 = tr_read<v_rd_off(D0, 3, 1)>(vb);
  asm volatile("s_waitcnt lgkmcnt(0)" ::: "memory"); SBAR();
#define PK(L, H) (bf16x8){L[0], L[1], L[2], L[3], H[0], H[1], H[2], H[3]}
  od = __builtin_amdgcn_mfma_f32_32x32x16_bf16(pa0, PK(l0, h0), od, 0, 0, 0);
  od = __builtin_amdgcn_mfma_f32_32x32x16_bf16(pa1, PK(l1, h1), od, 0, 0, 0);
  od = __builtin_amdgcn_mfma_f32_32x32x16_bf16(pa2, PK(l2, h2), od, 0, 0, 0);
  od = __builtin_amdgcn_mfma_f32_32x32x16_bf16(pa3, PK(l3, h3), od, 0, 0, 0);
#undef PK
}
__device__ __forceinline__ void pv_d0(f32x16* o, int vb, bf16x8 pa0, bf16x8 pa1, bf16x8 pa2, bf16x8 pa3) {
  pv_one<0>(o[0], vb, pa0, pa1, pa2, pa3); pv_one<1>(o[1], vb, pa0, pa1, pa2, pa3); pv_one<2>(o[2], vb, pa0, pa1, pa2, pa3); pv_one<3>(o[3], vb, pa0, pa1, pa2, pa3);
}
__device__ __forceinline__ void attn_unit(const bf16* __restrict__ Qb, int l0, const float* __restrict__ qn, const bf16* __restrict__ Kh, const bf16* __restrict__ Vh,
                                          bf16* __restrict__ Ob, int seq, char* lds) {
  int tid_ = threadIdx.x; asm volatile("" : "+v"(tid_));
  const int tid = tid_, wid = tid >> 6, lane = tid & 63, r32 = lane & 31, hi = lane >> 5;
  bf16* V_lds = (bf16*)lds; bf16* K_lds = (bf16*)(lds + 2 * SHM_V);
  float* ws = (float*)(lds + 2 * SHM_V + 2 * SHM_K) + wid * 64; float* li_l = ws; float* al_l = ws + 32;
  float m_reg = -1e30f, l_reg = 0; f32x16 o[4] = {}; bf16x8 qr[8];
  {
    const bf16* Qw = Qb + (long)(wid * QBLK + r32) * LDQ + hi * 8;
    const int lpos = l0 + wid * QBLK + r32; const float prow = (float)(lpos >> 6), pcol = (float)(lpos & 63);
    float ss = 0.f;
#pragma unroll
    for (int d0 = 0; d0 < 8; ++d0) { qr[d0] = *reinterpret_cast<const bf16x8*>(Qw + d0 * 16);
#pragma unroll
      for (int e = 0; e < 8; ++e) { const float v = __uint_as_float(((unsigned)(unsigned short)qr[d0][e]) << 16); ss += v * v; } }
    ss += __shfl_xor(ss, 32);
    const float rs = 1.0f / sqrtf(ss * (1.0f / 128.0f) + 1e-6f);
#pragma unroll
    for (int d0 = 0; d0 < 8; ++d0) { unsigned w[4];
      const float4 g0 = *reinterpret_cast<const float4*>(qn + d0 * 16 + hi * 8), g1 = *reinterpret_cast<const float4*>(qn + d0 * 16 + hi * 8 + 4);
      const float gg[8] = {g0.x, g0.y, g0.z, g0.w, g1.x, g1.y, g1.z, g1.w};
#pragma unroll
      for (int e2 = 0; e2 < 4; ++e2) {
        const float x0 = __uint_as_float(((unsigned)(unsigned short)qr[d0][2 * e2]) << 16) * rs * gg[2 * e2], x1 = __uint_as_float(((unsigned)(unsigned short)qr[d0][2 * e2 + 1]) << 16) * rs * gg[2 * e2 + 1];
        const int i = 8 * d0 + 4 * hi + e2, j = i & 31;
        const float inv = __builtin_amdgcn_exp2f(-(float)j * (13.287712379549449f / 32.0f));
        const float rev = (d0 < 4 ? prow : pcol) * inv * 0.15915494309189535f;
        const float c = __builtin_amdgcn_cosf(rev), s = __builtin_amdgcn_sinf(rev);
        w[e2] = cvtpk(x0 * c - x1 * s, x0 * s + x1 * c); }
      u32x4 wv = {w[0], w[1], w[2], w[3]}; qr[d0] = *reinterpret_cast<bf16x8*>(&wv); }
  }
  const int sr = tid >> 4, sc = (tid & 15) * 8, vst0 = v_st(sr, sc), vst1 = v_st(32 + sr, sc);
  const int vb0 = (int)(uintptr_t)V_lds + v_rd_base(lane);
  struct { bf16x8 vs0, vs1, ks0, ks1; } sr_[SDEPTH];
#define LD8(p) (*reinterpret_cast<const bf16x8*>(p))
#define SLOAD(i, k0) do { sr_[i].vs0 = LD8(&Vh[(long)((k0) + sr) * LDK + sc]); sr_[i].vs1 = LD8(&Vh[(long)((k0) + 32 + sr) * LDK + sc]); \
    sr_[i].ks0 = LD8(&Kh[(long)((k0) + sr) * LDK + sc]); sr_[i].ks1 = LD8(&Kh[(long)((k0) + 32 + sr) * LDK + sc]); } while (0)
#define SWRITE(b, i) do { *(bf16x8*)((char*)V_lds + (b) * SHM_V + vst0) = sr_[i].vs0;          \
    *(bf16x8*)((char*)V_lds + (b) * SHM_V + vst1) = sr_[i].vs1; int kc = sc * 2;               \
    *(bf16x8*)((char*)K_lds + (b) * SHM_K + KSWZ(sr, kc)) = sr_[i].ks0;                       \
    *(bf16x8*)((char*)K_lds + (b) * SHM_K + KSWZ(32 + sr, kc)) = sr_[i].ks1; } while (0)
#define SWAIT() asm volatile("s_waitcnt vmcnt(4)" ::: "memory")
#define RESC(a) do { if (__any((a) < 1.f)) { if (hi == 0) al_l[r32] = (a); asm volatile("s_waitcnt lgkmcnt(0)" ::: "memory"); \
    for (int d = 0; d < 4; ++d) for (int r = 0; r < 16; ++r) o[d][r] *= al_l[crow(r, hi)]; } } while (0)
  f32x16 pA0, pA1, pB0, pB1; float mnA, mnB, alA, alB; bf16x8 pa0, pa1, pa2, pa3; const int NT = seq / KVBLK;
  constexpr int SE = 0, SO = SDEPTH - 1;
  SLOAD(SE, 0); asm volatile("s_waitcnt vmcnt(0)" ::: "memory"); SWRITE(0, SE); __syncthreads();
  qkt(pA0, pA1, K_lds, qr, r32, hi); partialSM(pA0, pA1, m_reg, mnA, alA);
  SLOAD(SO, KVBLK); if (2 < NT) SLOAD(SE, 2 * KVBLK);
  SWAIT(); SWRITE(1, SO); __syncthreads();
  for (int j = 1; j + 1 < NT; j += 2) {
    SBAR(); qkt(pB0, pB1, (bf16*)((char*)K_lds + SHM_K), qr, r32, hi);
    finishSM(pA0, pA1, alA, l_reg, pa0, pa1, pa2, pa3); SBAR();
    SLOAD(SO, (j + SDEPTH) * KVBLK); SBAR();
    pv_d0(o, vb0, pa0, pa1, pa2, pa3); partialSM(pB0, pB1, m_reg, mnB, alB);
    __syncthreads(); SWAIT(); SWRITE(0, SE);
    RESC(alB); __syncthreads();
    SBAR(); qkt(pA0, pA1, K_lds, qr, r32, hi);
    finishSM(pB0, pB1, alB, l_reg, pa0, pa1, pa2, pa3); SBAR();
    if (j + 3 < NT) SLOAD(SE, (j + 1 + SDEPTH) * KVBLK); SBAR();
    pv_d0(o, vb0 + (int)SHM_V, pa0, pa1, pa2, pa3); partialSM(pA0, pA1, m_reg, mnA, alA);
    __syncthreads(); SWAIT(); SWRITE(1, SO);
    RESC(alA); __syncthreads();
  }
  SBAR(); qkt(pB0, pB1, (bf16*)((char*)K_lds + SHM_K), qr, r32, hi);
  finishSM(pA0, pA1, alA, l_reg, pa0, pa1, pa2, pa3); SBAR();
  pv_d0(o, vb0, pa0, pa1, pa2, pa3); partialSM(pB0, pB1, m_reg, mnB, alB);
  __syncthreads(); RESC(alB);
  finishSM(pB0, pB1, alB, l_reg, pa0, pa1, pa2, pa3); SBAR();
  pv_d0(o, vb0 + (int)SHM_V, pa0, pa1, pa2, pa3);
  if (hi == 0) li_l[r32] = l_reg; asm volatile("s_waitcnt lgkmcnt(0)" ::: "memory");
  float rli[16];
#pragma unroll
  for (int r = 0; r < 16; ++r) rli[r] = __builtin_amdgcn_rcpf(li_l[crow(r, hi)]);
  bf16* Ow = Ob + (long)(wid * QBLK) * LDO;
#pragma unroll
  for (int r = 0; r < 16; ++r) { int orow = crow(r, hi);
    for (int d0 = 0; d0 < 4; ++d0) { const float v = o[d0][r] * rli[r]; unsigned u = __float_as_uint(v); u = (u + 0x7fffu + ((u >> 16) & 1u)) >> 16; Ow[(long)orow * LDO + d0 * 32 + r32] = (bf16)u; } }
  __syncthreads();
#undef LD8
#undef SLOAD
#undef SWRITE
#undef SWAIT
#undef RESC
}
#undef KSWZ
#undef SBAR
}
#define HD __device__ __forceinline__
#define HY_COSREV(x) __builtin_amdgcn_cosf(x)
#define HY_SINREV(x) __builtin_amdgcn_sinf(x)
#define HY_OPAQUE(x) asm volatile("" : "+v"(x))
#define HY_OPAQUE2(w) asm volatile("" : "+v"(w.x), "+v"(w.y))
#define HY_FENCE() asm volatile("" ::: "memory")
#ifndef HD
#define HD __device__ __forceinline__
#endif
typedef float f2 __attribute__((ext_vector_type(2)));
constexpr int HY_P = 8192, HY_L = 16384, HY_BUF = 8704;
HD int hy_pidx(int p) { return p + 2 * (p >> 5); }
HD f2 cmul(f2 a, f2 w) { return (f2){a.x * w.x - a.y * w.y, a.x * w.y + a.y * w.x}; }
HD f2 cmulc(f2 a, f2 w) { return (f2){a.x * w.x + a.y * w.y, a.y * w.x - a.x * w.y}; }
template <int DIR> HD f2 hy_mi(f2 a) { return DIR > 0 ? (f2){a.y, -a.x} : (f2){-a.y, a.x}; }
HD f2 hy_cis(float rev) { return (f2){HY_COSREV(rev), HY_SINREV(rev)}; }
HD float hy_bf(unsigned short u) { return __builtin_bit_cast(float, (unsigned)u << 16); }
HD unsigned hy_f2bf(float f) { unsigned u = __builtin_bit_cast(unsigned, f); return (u + 0x7fffu + ((u >> 16) & 1u)) >> 16; }
HD f2 hy_unpack(unsigned w) { return (f2){__builtin_bit_cast(float, w << 16), __builtin_bit_cast(float, w & 0xffff0000u)}; }
HD unsigned hy_pack(f2 v) { return hy_f2bf(v.x) | (hy_f2bf(v.y) << 16); }

template <int DIR> HD void hy_r4(f2& x0, f2& x1, f2& x2, f2& x3) {
    const f2 s02 = x0 + x2, d02 = x0 - x2, s13 = x1 + x3, d13 = hy_mi<DIR>(x1 - x3);
    x0 = s02 + s13; x1 = d02 + d13; x2 = s02 - s13; x3 = d02 - d13;
}
template <int DIR> HD void hy_dft16(f2 (&x)[16]) {
#pragma unroll
    for (int b = 0; b < 4; ++b) hy_r4<DIR>(x[b], x[4 + b], x[8 + b], x[12 + b]);
    constexpr float C1 = 0.92387953251128674f, S1 = 0.38268343236508977f, H = 0.70710678118654752f;
#define HY_TW(idx, cr, ci) x[idx] = cmul(x[idx], (f2){(cr), DIR > 0 ? (ci) : -(ci)})
    HY_TW(5, C1, -S1); HY_TW(9, H, -H); HY_TW(13, S1, -C1);
    HY_TW(6, H, -H); x[10] = hy_mi<DIR>(x[10]); HY_TW(14, -H, -H);
    HY_TW(7, S1, -C1); HY_TW(11, -H, -H); HY_TW(15, -C1, S1);
#undef HY_TW
#pragma unroll
    for (int c = 0; c < 4; ++c) hy_r4<DIR>(x[4 * c], x[4 * c + 1], x[4 * c + 2], x[4 * c + 3]);
}
#define HY_OUT(k) (4 * ((k) & 3) + ((k) >> 2))
template <int SL> HD void hy_fwd_store(f2* X, int base, f2 (&x)[16], f2 w1) {
    X[hy_pidx(base)] = x[0];
    f2 w = w1;
#pragma unroll
    for (int k0 = 1; k0 < 16; ++k0) { X[hy_pidx(base + (k0 << SL))] = cmul(x[HY_OUT(k0)], w); w = cmul(w, w1); }
}
template <int SL> HD void hy_inv_load(const f2* X, int base, f2 (&x)[16], f2 w1) {
    x[0] = X[hy_pidx(base)];
    f2 w = w1;
#pragma unroll
    for (int k0 = 1; k0 < 16; ++k0) { x[k0] = cmulc(X[hy_pidx(base + (k0 << SL))], w); w = cmul(w, w1); }
}
template <int DIR, int SL> HD void hy_pass(f2* X, int t, f2 w1) {
    HY_OPAQUE(t); HY_OPAQUE2(w1);
    const int blk = t >> SL, n0 = t & ((1 << SL) - 1), base = (blk << (SL + 4)) + n0;
    f2 x[16];
    if (DIR > 0) {
#pragma unroll
        for (int k = 0; k < 16; ++k) x[k] = X[hy_pidx(base + (k << SL))];
        hy_dft16<1>(x);
        hy_fwd_store<SL>(X, base, x, w1);
    } else {
        hy_inv_load<SL>(X, base, x, w1);
        hy_dft16<-1>(x);
#pragma unroll
        for (int n1 = 0; n1 < 16; ++n1) X[hy_pidx(base + (n1 << SL))] = x[HY_OUT(n1)];
    }
}
HD f2 hy_cr(int R) { return R == 0 ? (f2){1.f, 0.f} : R == 1 ? (f2){0.f, -1.f} : R == 2 ? (f2){-1.f, 0.f} : (f2){0.f, 1.f}; }
HD void hy_load_B(f2* B, int t, int R, const unsigned* zp  , f2 w1) {
    HY_OPAQUE(t); HY_OPAQUE2(w1);
    const f2 cr = hy_cr(R);
    f2 x[16];
#pragma unroll
    for (int n1 = 0; n1 < 16; ++n1) {
        const f2 z0 = hy_unpack(zp[(2 * n1) * 512 + t]), z1 = hy_unpack(zp[(2 * n1 + 1) * 512 + t]);
        const f2 s = z0 + cmul(z1, cr);
        x[n1] = cmul(s, hy_cis(-(float)(R * (t + 512 * n1)) * (1.0f / 32768.0f)));
    }
    hy_dft16<1>(x);
    hy_fwd_store<9>(B, t, x, w1);
}
HD void hy_load_A(f2* A, int t, int R, const unsigned short* hf, const unsigned short* hb, f2 w1) {
    HY_OPAQUE(t); HY_OPAQUE2(w1);
    const f2 cr = hy_cr(R); const float c2 = (R & 1) ? -1.f : 1.f;
    f2 x[16];
#pragma unroll
    for (int n1 = 0; n1 < 16; ++n1) {
        const int np = t + 512 * n1;
        const float g0 = hy_bf(hf[np]), g1 = hy_bf(hf[np + HY_P]), g2 = hy_bf(hb[np ? HY_L - np : 0]) * (np ? 1.f : 0.f), g3 = hy_bf(hb[HY_P - np]);
        const f2 s = (f2){g0 + c2 * g2 + (g1 + g3) * cr.x, (g1 - g3) * cr.y};
        x[n1] = cmul(s, hy_cis(-(float)(R * np) * (1.0f / 32768.0f)));
        if ((n1 & 3) == 3) HY_FENCE();
    }
    hy_dft16<1>(x);
    hy_fwd_store<9>(A, t, x, w1);
}
HD void hy_mid(const f2* A, f2* B, int t) {
    HY_OPAQUE(t);
#pragma unroll
    for (int j = 0; j < 8; ++j) {
        const int ip = hy_pidx(2 * (t + 512 * j));
        const f2 a0 = A[ip], a1 = A[ip + 1], b0 = B[ip], b1 = B[ip + 1];
        const f2 y0 = cmul(b0 + b1, a0 + a1), y1 = cmul(b0 - b1, a0 - a1);
        B[ip] = y0 + y1; B[ip + 1] = y0 - y1;
    }
}
HD void hy_inv1_acc(const f2* B, int t, int R, f2 w1, f2 (&yacc)[16][2]) {
    HY_OPAQUE(t); HY_OPAQUE2(w1);
    const f2 cr = hy_cr(R);
    f2 x[16];
    hy_inv_load<9>(B, t, x, w1);
    hy_dft16<-1>(x);
#pragma unroll
    for (int n1 = 0; n1 < 16; ++n1) {
        const f2 v = cmul(x[HY_OUT(n1)], hy_cis((float)(R * (t + 512 * n1)) * (1.0f / 32768.0f)));
        yacc[n1][0] += v;
        yacc[n1][1] += cmulc(v, cr);
    }
}
HD f2 hy_sconv(const unsigned short* row, int n, float w0, float w1, float w2, float cb) {
    const int nm = n > 0 ? n - 1 : 0, np = n < HY_L - 1 ? n + 1 : HY_L - 1;
    const float wm = n > 0 ? w0 : 0.f, wp = n < HY_L - 1 ? w2 : 0.f;
    const float a0 = hy_bf(row[nm]), a1 = hy_bf(row[n]), a2 = hy_bf(row[np]);
    const float b0 = hy_bf(row[HY_L + nm]), b1 = hy_bf(row[HY_L + n]), b2 = hy_bf(row[HY_L + np]);
    return (f2){wm * a0 + w1 * a1 + wp * a2 + cb, wm * b0 + w1 * b1 + wp * b2 + cb};
}
struct HyTw { f2 w8192, w512, w32; };
HD HyTw hy_tw(int t) { HyTw w; w.w8192 = hy_cis(-(float)t * (1.0f / 8192.0f)); w.w512 = hy_cis(-(float)(t & 31) * (1.0f / 512.0f)); w.w32 = hy_cis(-(float)(t & 1) * (1.0f / 32.0f)); return w; }
constexpr int NWAVES = 8;
#ifndef MK_N_LAUNCHES
#define MK_N_LAUNCHES 1
#endif
constexpr int N_PHASES = 12;
constexpr int N_LAUNCHES = MK_N_LAUNCHES;
constexpr int BATCH = 2, SEQ = 16384, DM = 2048, MTOK = BATCH * SEQ;
constexpr int HYW = 1024, NHY = 3072, NATT = 1536, INW = 4608;
constexpr int NE = 16, EFF = 1536, CAP = 2048, MOE_ROWS = NE * BATCH * CAP;
constexpr float LN_EPS = 1e-6f, DN_ALPHA = 1.189207115002721f;
typedef unsigned short bf16;
typedef unsigned v4u __attribute__((ext_vector_type(4)));
typedef float f32x4 __attribute__((ext_vector_type(4)));
typedef short bf16x8 __attribute__((ext_vector_type(8)));
#define LAS __attribute__((address_space(3)))
#define RLX_AGENT __ATOMIC_RELAXED, __HIP_MEMORY_SCOPE_AGENT
constexpr size_t MiB = 1u << 20;
constexpr size_t WS_CTL = 0, CTL_ZERO_BYTES = 1 * MiB;
constexpr size_t WS_H2 = 1 * MiB;
constexpr size_t WS_W3T = 9 * MiB;
constexpr size_t WS_AFF = 11 * MiB;
constexpr size_t WS_IDX = 13 * MiB;
constexpr size_t WS_GATE = 13 * MiB + 256 * 1024;
constexpr size_t WS_SLOT = 13 * MiB + 512 * 1024;
constexpr size_t WS_WIN = 16 * MiB;
constexpr size_t WS_WOUT = 34 * MiB;
constexpr size_t WS_WGU = 42 * MiB;
constexpr size_t WS_WD = 234 * MiB;
constexpr size_t WS_XB = 330 * MiB;
constexpr size_t WS_PT = 458 * MiB;
constexpr size_t WS_QKV = 650 * MiB;
constexpr size_t WS_FILT = 746 * MiB;
constexpr size_t WS_KP = 874 * MiB, WS_VP = 890 * MiB;
constexpr size_t WS_YHT = 906 * MiB;
constexpr size_t WS_ZPG = 330 * MiB;
constexpr size_t WS_YATT = 330 * MiB;
constexpr size_t WS_MIX = 394 * MiB;
constexpr size_t WS_T = 522 * MiB;
constexpr size_t WS_X1 = 650 * MiB;
constexpr size_t WS_XG = 330 * MiB;
constexpr size_t WS_HB = 778 * MiB;
constexpr size_t WS_Y = 330 * MiB;
constexpr size_t WS_END = 1024 * MiB;
constexpr int CW_TMO = 0, CW_BAR = 4096;
constexpr int RING_BYTES = 139264;
constexpr int LDSCTL_OFF = RING_BYTES, MISC_OFF = LDSCTL_OFF + 320;
constexpr int LDS_BYTES = 147456;
static_assert(2 * HY_BUF * 8 <= RING_BYTES && pg8::STAGE_BYTES <= RING_BYTES && (int)att::SHM_ATTN <= RING_BYTES && MISC_OFF + 128 <= LDS_BYTES, "LDS map");

__device__ __forceinline__ unsigned f2bf(float f) { unsigned u = __builtin_bit_cast(unsigned, f); return (u + 0x7fffu + ((u >> 16) & 1u)) >> 16; }
__device__ __forceinline__ unsigned pk2(float lo, float hi) { return f2bf(lo) | (f2bf(hi) << 16); }
__device__ __forceinline__ float bflo(unsigned w) { return __builtin_bit_cast(float, w << 16); }
__device__ __forceinline__ float bfhi(unsigned w) { return __builtin_bit_cast(float, w & 0xffff0000u); }
__device__ __forceinline__ float wave_sum(float v) {
#pragma unroll
    for (int o = 1; o < 64; o <<= 1) v += __shfl_xor(v, o);
    return v;
}
#define LDS_WAIT() asm volatile("s_waitcnt lgkmcnt(0)" ::: "memory")
#define XB_TMO      128
#define XB_XCNT(j)  (256  + 64 * (j))
#define XB_XSUB(j)  (1280 + 64 * (j))
#define XB_XGEN(j)  (2304 + 64 * (j))
#define XB_TOP      3328
#define XB_TOPGEN   3392
#define XCD_BAR_WORDS 3456
#define XB_SPIN_CAP (1u << 18)

__device__ __forceinline__ unsigned xb_ld(unsigned* p)              { return __hip_atomic_load(p, __ATOMIC_RELAXED, __HIP_MEMORY_SCOPE_AGENT); }
__device__ __forceinline__ unsigned xb_add(unsigned* p, unsigned v) { return __hip_atomic_fetch_add(p, v, __ATOMIC_RELAXED, __HIP_MEMORY_SCOPE_AGENT); }
__device__ __forceinline__ unsigned xb_xcc_id() { return (unsigned)__builtin_amdgcn_s_getreg((3 << 11) | 20) & 0xFu; }
#define XB_SPIN(cond, bar) do { unsigned _sp = 0; while (cond) { __builtin_amdgcn_s_sleep(1); \
    if ((++_sp & 255u) == 0u) { if (xb_ld(&(bar)[XB_TMO])) break; if (_sp > XB_SPIN_CAP) { atomicAdd(&(bar)[XB_TMO], 1u); break; } } } } while (0)

struct XcdBarrier {
    unsigned* bar; unsigned x;
    volatile LAS unsigned* st;
};

__device__ __forceinline__ XcdBarrier xcd_barrier_post(unsigned* bar, volatile LAS unsigned* st) {
    XcdBarrier b; b.bar = bar; b.x = xb_xcc_id(); b.st = st;
    if (threadIdx.x == 0) (void)xb_add(&bar[XB_XCNT(b.x)], 1u);
    return b;
}
__device__ __forceinline__ void xcd_barrier_complete(unsigned* bar, unsigned x, unsigned& nloc, unsigned& nx) {
    const unsigned G = gridDim.x * gridDim.y * gridDim.z;
    unsigned sum, cnt, mine, sp = 0u;
    for (;;) {
        sum = 0u; cnt = 0u; mine = 0u;
#pragma unroll
        for (unsigned j = 0; j < 16; ++j) { const unsigned c = xb_ld(&bar[XB_XCNT(j)]); sum += c; cnt += (c > 0u) ? 1u : 0u; mine = (j == x) ? c : mine; }
        if (sum == G) break;
        __builtin_amdgcn_s_sleep(1);
        if ((++sp & 255u) == 0u) { if (xb_ld(&bar[XB_TMO])) break; if (sp > XB_SPIN_CAP) { atomicAdd(&bar[XB_TMO], 1u); break; } }
    }
    nloc = mine > 0u ? mine : 1u; nx = cnt > 0u ? cnt : 1u;
}

__device__ __forceinline__ void xcd_barrier(const XcdBarrier& b) {
    asm volatile("s_waitcnt vmcnt(0)" ::: "memory");
    __syncthreads();
    if (threadIdx.x == 0) {
        unsigned* bar = b.bar;
        __builtin_amdgcn_s_waitcnt(0);
        unsigned nloc = b.st[0], nx = b.st[1];
        if (nloc == 0u) { xcd_barrier_complete(bar, b.x, nloc, nx); b.st[0] = nloc; b.st[1] = nx; }
        const unsigned old = xb_add(&bar[XB_XSUB(b.x)], 1u);
        const unsigned gen = old / nloc;
        if (old + 1u == (gen + 1u) * nloc) {
            __builtin_amdgcn_fence(__ATOMIC_RELEASE, "agent");
            asm volatile("s_waitcnt vmcnt(0)" ::: "memory");
            const unsigned og = xb_add(&bar[XB_TOP], 1u);
            const unsigned tg = og / nx;
            if (og + 1u == (tg + 1u) * nx) xb_add(&bar[XB_TOPGEN], 1u);
            else XB_SPIN(xb_ld(&bar[XB_TOPGEN]) == tg, bar);
            __builtin_amdgcn_fence(__ATOMIC_ACQUIRE, "agent");
            xb_add(&bar[XB_XGEN(b.x)], 1u);
            asm volatile("s_waitcnt vmcnt(0)" ::: "memory");
        } else {
            XB_SPIN(xb_ld(&bar[XB_XGEN(b.x)]) == gen, bar);
            __builtin_amdgcn_fence(__ATOMIC_ACQUIRE, "agent");
            asm volatile("s_waitcnt vmcnt(0)" ::: "memory");
        }
    }
    __syncthreads();
}
struct Ctx { LAS unsigned char* lds; int tid, lane, wave, G, gw, NGW; };
#define COSREV(x) __builtin_amdgcn_cosf(x)
#define SINREV(x) __builtin_amdgcn_sinf(x)

__device__ __forceinline__ void transpose_item(const float* W, int ldw, int k0, int n0, bf16* dst, int ldk, LAS float* scr, int lane) {
#pragma unroll 8
    for (int i = 0; i < 32; ++i) { const int kk = 2 * i + (lane >> 5); scr[kk * 33 + (lane & 31)] = W[(size_t)(k0 + kk) * ldw + n0 + (lane & 31)]; }
    LDS_WAIT(); asm volatile("" ::: "memory");
    const int c = lane & 7;
#pragma unroll
    for (int j = 0; j < 4; ++j) { const int n = (lane >> 3) + 8 * j; const LAS float* s = scr + (8 * c) * 33 + n;
        v4u o; o.x = pk2(s[0 * 33], s[1 * 33]); o.y = pk2(s[2 * 33], s[3 * 33]); o.z = pk2(s[4 * 33], s[5 * 33]); o.w = pk2(s[6 * 33], s[7 * 33]);
        *(v4u*)(dst + (size_t)n * ldk + 8 * c) = o; }
    LDS_WAIT(); asm volatile("" ::: "memory");
}
template <class KP> __device__ __forceinline__ void p0_prologue(const Ctx& C, KP inp, unsigned char* ws) {
#define in(k) ((const float*)(__attribute__((address_space(1))) const float*)inp[k])
    LAS float* scr = (LAS float*)(C.lds + C.wave * 16384);
    const int lane = C.lane;
    bf16* WIN = (bf16*)(ws + WS_WIN); bf16* WOUT = (bf16*)(ws + WS_WOUT); bf16* WGU = (bf16*)(ws + WS_WGU); bf16* WD = (bf16*)(ws + WS_WD); bf16* W3T = (bf16*)(ws + WS_W3T);
    constexpr int I_IN = 32 * 144, I_OUT = 32 * 64, I_G = 16 * 32 * 48, I_D = 16 * 24 * 64, I_3 = 128;
    constexpr int NITEMS = I_IN + I_OUT + 2 * I_G + I_D + I_3;
    for (int it = C.gw; it < NITEMS; it += C.NGW) {
        int r = it;
        if (r < I_IN) { const int kb = r / 144, nb = r % 144; transpose_item(in(1), INW, 64 * kb, 32 * nb, WIN + (size_t)(32 * nb) * DM + 64 * kb, DM, scr, lane); continue; } r -= I_IN;
        if (r < I_OUT) { const int kb = r / 64, nb = r % 64; transpose_item(in(18), DM, 64 * kb, 32 * nb, WOUT + (size_t)(32 * nb) * DM + 64 * kb, DM, scr, lane); continue; } r -= I_OUT;
        if (r < 2 * I_G) { const int up = r >= I_G; if (up) r -= I_G; const int e = r / (32 * 48), q = r % (32 * 48), kb = q / 48, nb = q % 48, n0 = 32 * nb;
            const size_t drow = (size_t)e * 3072 + (n0 >> 7) * 256 + (n0 & 127) + (up ? 128 : 0);
            transpose_item((up ? in(24) : in(23)) + (size_t)e * DM * EFF, EFF, 64 * kb, n0, WGU + drow * DM + 64 * kb, DM, scr, lane); continue; } r -= 2 * I_G;
        if (r < I_D) { const int e = r / (24 * 64), q = r % (24 * 64), kb = q / 64, nb = q % 64;
            transpose_item(in(25) + (size_t)e * EFF * DM, DM, 64 * kb, 32 * nb, WD + ((size_t)e * DM + 32 * nb) * EFF + 64 * kb, EFF, scr, lane); continue; } r -= I_D;
        transpose_item(in(11), 4096, 0, 32 * r, W3T + (size_t)(32 * r) * 256, 256, scr, lane);
    }
    for (int i = C.gw * 64 + lane; i < 4096 * 24; i += C.NGW * 64) { const int row = i / 24, ch = i % 24; *(v4u*)(W3T + (size_t)row * 256 + 64 + 8 * ch) = (v4u){0u, 0u, 0u, 0u}; }
    { const float* x = in(0); bf16* XB = (bf16*)(ws + WS_XB);
      for (size_t i = (size_t)C.gw * 64 + lane; i < (size_t)MTOK * DM / 8; i += (size_t)C.NGW * 64) { const f32x4 a = *(const f32x4*)(x + i * 8), b = *(const f32x4*)(x + i * 8 + 4);
          v4u o; o.x = pk2(a[0], a[1]); o.y = pk2(a[2], a[3]); o.z = pk2(b[0], b[1]); o.w = pk2(b[2], b[3]); *(v4u*)(XB + i * 8) = o; } }
    { const float* w1 = in(5); const float* b1 = in(6); const float* f1 = in(7); const float* w2 = in(8); const float* b2 = in(9); const float* fq2 = in(10); bf16* H2 = (bf16*)(ws + WS_H2);
      const float b1k = b1[lane], f1k = f1[lane], b2k = b2[lane], f2k = fq2[lane];
      for (int t = C.gw; t < SEQ; t += C.NGW) {
          float acc = b1k + ((float)t * (1.0f / 16383.0f)) * w1[lane];
#pragma unroll
          for (int i = 0; i < 16; ++i) { const float fi = 1e-4f + (float)i * ((15.0f - 1e-4f) / 15.0f); const float rev = fi * (float)t * (1.0f / 16384.0f);
              acc += COSREV(rev) * w1[(1 + i) * 64 + lane] - SINREV(rev) * w1[(17 + i) * 64 + lane]; }
          const float h1 = SINREV(f1k * acc * 0.15915494309189535f);
          scr[lane] = h1; LDS_WAIT(); asm volatile("" ::: "memory");
          float a2 = b2k;
#pragma unroll 16
          for (int j = 0; j < 64; ++j) a2 += scr[j] * w2[j * 64 + lane];
          const float h2 = SINREV(f2k * a2 * 0.15915494309189535f);
          LDS_WAIT(); asm volatile("" ::: "memory");
          bf16* o = H2 + (size_t)t * 256; o[lane] = (bf16)f2bf(h2); o[64 + lane] = 0; o[128 + lane] = 0; o[192 + lane] = 0;
      } }
#undef in
}

__device__ __forceinline__ void p2_kpass(const Ctx& C, const float* kn, unsigned char* ws) {
    const bf16* QKV = (const bf16*)(ws + WS_QKV); bf16* KP = (bf16*)(ws + WS_KP); bf16* VP = (bf16*)(ws + WS_VP);
    const int lane = C.lane; const float g0 = kn[2 * lane], g1 = kn[2 * lane + 1];
    const float inv = __builtin_amdgcn_exp2f(-(float)(lane & 31) * (13.287712379549449f / 32.0f));
    for (int it = C.gw; it < MTOK * 2; it += C.NGW) { const int m = it >> 1, kvh = it & 1, b = m >> 14, l = m & (SEQ - 1);
        const unsigned pk = *(const unsigned*)(QKV + (size_t)m * NATT + 1024 + kvh * 128 + 2 * lane);
        const unsigned pv = *(const unsigned*)(QKV + (size_t)m * NATT + 1280 + kvh * 128 + 2 * lane);
        float x0 = bflo(pk), x1 = bfhi(pk);
        const float ss = wave_sum(x0 * x0 + x1 * x1), rs = 1.0f / sqrtf(ss * (1.0f / 128.0f) + LN_EPS);
        x0 *= rs * g0; x1 *= rs * g1;
        const float pos = (float)(lane < 32 ? (l >> 6) : (l & 63)), rev = pos * inv * 0.15915494309189535f, c = COSREV(rev), s = SINREV(rev);
        const size_t o = (((size_t)(b * 2 + kvh) * SEQ + l) * 128) + 2 * lane;
        *(unsigned*)(KP + o) = pk2(x0 * c - x1 * s, x0 * s + x1 * c); *(unsigned*)(VP + o) = pv; }
}

__device__ __forceinline__ void hy_unit(int c, const float* cw, const float* cbias, const float* skip, unsigned char* ws, f2* A, f2* B, int t) {
    const bf16* PT = (const bf16*)(ws + WS_PT); const bf16* FILT = (const bf16*)(ws + WS_FILT); bf16* YHT = (bf16*)(ws + WS_YHT);
    const HyTw tw = hy_tw(t);
    f2 yacc[16][2]; unsigned* zp = (unsigned*)(ws + WS_ZPG) + (size_t)blockIdx.x * (32 * 512);
    HY_OPAQUE(t);
    { const bf16* row = PT + (size_t)c * MTOK; const float w0 = cw[c], w1 = cw[NHY + c], w2 = cw[2 * NHY + c], cb = cbias[c];
#pragma unroll
      for (int n1 = 0; n1 < 16; ++n1) {
#pragma unroll
          for (int j = 0; j < 2; ++j) zp[(2 * n1 + j) * 512 + t] = hy_pack(hy_sconv(row, t + 512 * n1 + HY_P * j, w0, w1, w2, cb));
          if (n1 & 1) HY_FENCE(); } }
#pragma unroll 1
    for (int order = 0; order < 2; ++order) {
        const bf16* hf = FILT + (size_t)(order * 1024 + c) * SEQ; const bf16* hb = FILT + (size_t)(2048 + order * 1024 + c) * SEQ;
#pragma unroll
        for (int n1 = 0; n1 < 16; ++n1) { yacc[n1][0] = (f2){0.f, 0.f}; yacc[n1][1] = (f2){0.f, 0.f}; }
#pragma unroll 1
        for (int R = 0; R < 4; ++R) {
            hy_load_A(A, t, R, hf, hb, tw.w8192); hy_load_B(B, t, R, zp, tw.w8192); __syncthreads();
            hy_pass<1, 5>(A, t, tw.w512); hy_pass<1, 5>(B, t, tw.w512); __syncthreads();
            hy_pass<1, 1>(A, t, tw.w32); hy_pass<1, 1>(B, t, tw.w32); __syncthreads();
            hy_mid(A, B, t); __syncthreads();
            hy_pass<-1, 1>(B, t, tw.w32); __syncthreads();
            hy_pass<-1, 5>(B, t, tw.w512); __syncthreads();
            hy_inv1_acc(B, t, R, tw.w8192, yacc);
        }
        const int ch = (order + 1) * HYW + c;
        HY_OPAQUE(t);
        const bf16* row = PT + (size_t)ch * MTOK; const float w0 = cw[ch], w1 = cw[NHY + ch], w2 = cw[2 * NHY + ch], cb = cbias[ch], d = skip[order * HYW + c];
        bf16* o0 = YHT + (size_t)c * SEQ; bf16* o1 = YHT + (size_t)(HYW + c) * SEQ;
#pragma unroll
        for (int n1 = 0; n1 < 16; ++n1) {
#pragma unroll
            for (int j = 0; j < 2; ++j) { const int n = t + 512 * n1 + HY_P * j; const f2 ux = hy_sconv(row, n, w0, w1, w2, cb), zz = hy_unpack(zp[(2 * n1 + j) * 512 + t]);
                const f2 y = ux * (yacc[n1][j] * (1.0f / 32768.0f) + zz * d);
                if (order == 0) zp[(2 * n1 + j) * 512 + t] = hy_pack(y); else { o0[n] = (bf16)hy_f2bf(y.x); o1[n] = (bf16)hy_f2bf(y.y); } }
            if (n1 & 1) HY_FENCE(); }
    }
}

__device__ __forceinline__ void p4_merge(const Ctx& C, const float* ghy, const float* gatt, unsigned char* ws) {
    const bf16* YHT = (const bf16*)(ws + WS_YHT); const bf16* YATT = (const bf16*)(ws + WS_YATT); bf16* MIX = (bf16*)(ws + WS_MIX);
    const int lane = C.lane, tid = C.tid;
    for (int m = C.gw; m < MTOK; m += C.NGW) { const bf16* r = YATT + (size_t)m * 1024;
        const v4u a = *(const v4u*)(r + 8 * lane), b = *(const v4u*)(r + 512 + 8 * lane);
        float v[16]; v[0] = bflo(a.x); v[1] = bfhi(a.x); v[2] = bflo(a.y); v[3] = bfhi(a.y); v[4] = bflo(a.z); v[5] = bfhi(a.z); v[6] = bflo(a.w); v[7] = bfhi(a.w);
        v[8] = bflo(b.x); v[9] = bfhi(b.x); v[10] = bflo(b.y); v[11] = bfhi(b.y); v[12] = bflo(b.z); v[13] = bfhi(b.z); v[14] = bflo(b.w); v[15] = bfhi(b.w);
        float ss = 0.f;
#pragma unroll
        for (int i = 0; i < 16; ++i) ss += v[i] * v[i];
        const float rs = 1.0f / sqrtf(wave_sum(ss) * (1.0f / 1024.0f) + LN_EPS);
        const f32x4 g0 = *(const f32x4*)(gatt + 8 * lane), g1 = *(const f32x4*)(gatt + 8 * lane + 4), g2 = *(const f32x4*)(gatt + 512 + 8 * lane), g3 = *(const f32x4*)(gatt + 512 + 8 * lane + 4);
        v4u o0, o1;
        o0.x = pk2(v[0] * rs * g0[0], v[1] * rs * g0[1]); o0.y = pk2(v[2] * rs * g0[2], v[3] * rs * g0[3]); o0.z = pk2(v[4] * rs * g1[0], v[5] * rs * g1[1]); o0.w = pk2(v[6] * rs * g1[2], v[7] * rs * g1[3]);
        o1.x = pk2(v[8] * rs * g2[0], v[9] * rs * g2[1]); o1.y = pk2(v[10] * rs * g2[2], v[11] * rs * g2[3]); o1.z = pk2(v[12] * rs * g3[0], v[13] * rs * g3[1]); o1.w = pk2(v[14] * rs * g3[2], v[15] * rs * g3[3]);
        bf16* d = MIX + (size_t)m * DM + 1024; *(v4u*)(d + 8 * lane) = o0; *(v4u*)(d + 512 + 8 * lane) = o1; }
    LAS unsigned short* tile = (LAS unsigned short*)C.lds; LAS float* red = (LAS float*)(C.lds + 512 * 136);
    const int tau = tid & 63, cg = tid >> 6;
    for (int u = blockIdx.x; u < MTOK / 64; u += C.G) { const int b = u >> 8, n0 = (u & 255) * 64;
        unsigned pk[2][32]; float ss = 0.f;
#pragma unroll
        for (int h = 0; h < 2; ++h) {
            __syncthreads();
#pragma unroll
            for (int i = 0; i < 8; ++i) { const int cl = i * 64 + (tid >> 3), seg = tid & 7;
                const v4u v = *(const v4u*)(YHT + ((size_t)(b * 1024 + h * 512 + cl)) * SEQ + n0 + 8 * seg);
                LAS unsigned* d = (LAS unsigned*)(tile + cl * 68 + 8 * seg); d[0] = v.x; d[1] = v.y; d[2] = v.z; d[3] = v.w; }
            __syncthreads();
#pragma unroll
            for (int k = 0; k < 32; ++k) { const unsigned lo = tile[(cg * 64 + 2 * k) * 68 + tau], hi2 = tile[(cg * 64 + 2 * k + 1) * 68 + tau];
                pk[h][k] = lo | (hi2 << 16); const float a = bflo(lo << 0), bb = __builtin_bit_cast(float, hi2 << 16); ss += a * a + bb * bb; }
        }
        __syncthreads();
        red[cg * 64 + tau] = ss; __syncthreads();
        float tot = 0.f;
#pragma unroll
        for (int g = 0; g < 8; ++g) tot += red[g * 64 + tau];
        const float rs = 1.0f / sqrtf(tot * (1.0f / 1024.0f) + LN_EPS);
        bf16* d = MIX + (size_t)(b * SEQ + n0 + tau) * DM;
#pragma unroll
        for (int h = 0; h < 2; ++h) { const int c0 = h * 512 + cg * 64;
#pragma unroll
            for (int q = 0; q < 8; ++q) { const f32x4 g0 = *(const f32x4*)(ghy + c0 + 8 * q), g1 = *(const f32x4*)(ghy + c0 + 8 * q + 4); v4u o;
                o.x = pk2(bflo(pk[h][4 * q]) * rs * g0[0], bfhi(pk[h][4 * q]) * rs * g0[1]); o.y = pk2(bflo(pk[h][4 * q + 1]) * rs * g0[2], bfhi(pk[h][4 * q + 1]) * rs * g0[3]);
                o.z = pk2(bflo(pk[h][4 * q + 2]) * rs * g1[0], bfhi(pk[h][4 * q + 2]) * rs * g1[1]); o.w = pk2(bflo(pk[h][4 * q + 3]) * rs * g1[2], bfhi(pk[h][4 * q + 3]) * rs * g1[3]);
                *(v4u*)(d + c0 + 8 * q) = o; } }
    }
}

__device__ __forceinline__ void p6_ln_router(const Ctx& C, const float* g, const float* be, const float* wr, const float* br, unsigned char* ws) {
    const bf16* T = (const bf16*)(ws + WS_T); bf16* X1 = (bf16*)(ws + WS_X1); float* AFF = (float*)(ws + WS_AFF);
    const int lane = C.lane; LAS f32x4* wl = (LAS f32x4*)C.lds;
    __syncthreads();
    for (int idx = C.tid; idx < 2048 * 4; idx += 512) { const int k = idx >> 2, q = idx & 3, pos = (k >> 9) * 512 + (k & 7) * 64 + ((k >> 3) & 63); wl[q * 2048 + pos] = *(const f32x4*)(wr + k * 16 + 4 * q); }
    __syncthreads();
    for (int m = C.gw; m < MTOK; m += C.NGW) {
        float v[4][8]; float s = 0.f;
#pragma unroll
        for (int j = 0; j < 4; ++j) { const v4u a = *(const v4u*)(T + (size_t)m * DM + 512 * j + 8 * lane);
            v[j][0] = bflo(a.x); v[j][1] = bfhi(a.x); v[j][2] = bflo(a.y); v[j][3] = bfhi(a.y); v[j][4] = bflo(a.z); v[j][5] = bfhi(a.z); v[j][6] = bflo(a.w); v[j][7] = bfhi(a.w);
#pragma unroll
            for (int e = 0; e < 8; ++e) s += v[j][e]; }
        const float mean = wave_sum(s) * (1.0f / DM); float q2 = 0.f;
#pragma unroll
        for (int j = 0; j < 4; ++j)
#pragma unroll
            for (int e = 0; e < 8; ++e) { v[j][e] -= mean; q2 += v[j][e] * v[j][e]; }
        const float rstd = 1.0f / sqrtf(wave_sum(q2) * (1.0f / DM) + LN_EPS);
        float acc[16];
#pragma unroll
        for (int e = 0; e < 16; ++e) acc[e] = 0.f;
#pragma unroll
        for (int j = 0; j < 4; ++j) { const int k0 = 512 * j + 8 * lane;
            const f32x4 ga = *(const f32x4*)(g + k0), gb = *(const f32x4*)(g + k0 + 4), ba = *(const f32x4*)(be + k0), bb = *(const f32x4*)(be + k0 + 4);
#pragma unroll
            for (int e = 0; e < 8; ++e) { const float xv = v[j][e] * rstd * (e < 4 ? ga[e & 3] : gb[e & 3]) + (e < 4 ? ba[e & 3] : bb[e & 3]); v[j][e] = xv;
                const int pos = j * 512 + e * 64 + lane;
#pragma unroll
                for (int q = 0; q < 4; ++q) { const f32x4 w = wl[q * 2048 + pos]; acc[4 * q] += xv * w[0]; acc[4 * q + 1] += xv * w[1]; acc[4 * q + 2] += xv * w[2]; acc[4 * q + 3] += xv * w[3]; }
                if (e & 1) asm volatile("" ::: "memory"); }
            v4u o; o.x = pk2(v[j][0], v[j][1]); o.y = pk2(v[j][2], v[j][3]); o.z = pk2(v[j][4], v[j][5]); o.w = pk2(v[j][6], v[j][7]);
            *(v4u*)(X1 + (size_t)m * DM + k0) = o; }
        float mx = -1e30f;
#pragma unroll
        for (int e = 0; e < 16; ++e) { acc[e] = wave_sum(acc[e]) + br[e]; mx = fmaxf(mx, acc[e]); }
        float den = 0.f;
#pragma unroll
        for (int e = 0; e < 16; ++e) { acc[e] = __expf(acc[e] - mx); den += acc[e]; }
        float mine = 0.f;
#pragma unroll
        for (int e = 0; e < 16; ++e) mine = (lane == e) ? acc[e] : mine;
        if (lane < 16) AFF[(size_t)((m >> 14) * 16 + lane) * SEQ + (m & (SEQ - 1))] = mine / den;
    }
    __syncthreads();
}

__device__ __forceinline__ void p7_topk(const Ctx& C, int be, unsigned char* ws) {
    const float* AFF = (const float*)(ws + WS_AFF); int* IDX = (int*)(ws + WS_IDX); float* GATE = (float*)(ws + WS_GATE); short* SLOT = (short*)(ws + WS_SLOT);
    LAS unsigned* keys = (LAS unsigned*)C.lds;
    LAS unsigned* hist = (LAS unsigned*)(C.lds + 67584); LAS unsigned* misc = hist + 256; LAS unsigned* wsum = misc + 8;
    const int tid = C.tid, lane = C.lane, b = be >> 4, e = be & 15;
    __syncthreads();
    for (int i = tid; i < SEQ; i += 512) keys[i + (i >> 5)] = __float_as_uint(AFF[(size_t)be * SEQ + i]);
    unsigned prefix = 0u, mask = 0u, remaining = CAP;
#pragma unroll 1
    for (int pass = 0; pass < 4; ++pass) { const int shift = 24 - 8 * pass;
        if (tid < 256) hist[tid] = 0u;
        __syncthreads();
        for (int i = tid; i < SEQ; i += 512) { const unsigned k = keys[i + (i >> 5)]; if ((k & mask) == prefix) atomicAdd((unsigned*)&hist[(k >> shift) & 255u], 1u); }
        __syncthreads();
        if (tid < 64) { const unsigned c0 = hist[4 * lane], c1 = hist[4 * lane + 1], c2 = hist[4 * lane + 2], c3 = hist[4 * lane + 3]; const unsigned s4 = c0 + c1 + c2 + c3;
            unsigned inc = s4;
#pragma unroll
            for (int o = 1; o < 64; o <<= 1) { const unsigned y = __shfl_up(inc, o); if (lane >= o) inc += y; }
            const unsigned total = __shfl(inc, 63); unsigned cum = total - inc;
            const unsigned cs[4] = {c0, c1, c2, c3};
#pragma unroll
            for (int q = 3; q >= 0; --q) { if (cum < remaining && cum + cs[q] >= remaining) { misc[0] = 4 * lane + q; misc[1] = remaining - cum; } cum += cs[q]; } }
        __syncthreads();
        prefix |= misc[0] << shift; mask |= 0xffu << shift; remaining = misc[1];
        __syncthreads();
    }
    const unsigned T = prefix, need_eq = remaining;
    unsigned cg = 0, ce = 0;
#pragma unroll 8
    for (int i = 0; i < 32; ++i) { const unsigned k = keys[33 * tid + i]; cg += (k > T); ce += (k == T); }
    unsigned inc = cg | (ce << 16);
#pragma unroll
    for (int o = 1; o < 64; o <<= 1) { const unsigned y = __shfl_up(inc, o); if (lane >= o) inc += y; }
    if (lane == 63) wsum[C.wave] = inc;
    __syncthreads();
    unsigned off = 0;
#pragma unroll
    for (int w = 0; w < 8; ++w) off += (w < C.wave) ? wsum[w] : 0u;
    const unsigned ex = inc - (cg | (ce << 16)) + off; unsigned pg = ex & 0xffffu, pe = ex >> 16;
    const size_t rbase = (size_t)(e * 2 + b) * CAP;
#pragma unroll 4
    for (int i = 0; i < 32; ++i) { const unsigned k = keys[33 * tid + i]; const int tok = 32 * tid + i; int slot = -1;
        if (k > T) { slot = (int)(pg + (pe < need_eq ? pe : need_eq)); ++pg; }
        else if (k == T) { if (pe < need_eq) slot = (int)(pg + pe); ++pe; }
        SLOT[((size_t)b * SEQ + tok) * 16 + e] = (short)slot;
        if (slot >= 0) { IDX[rbase + slot] = tok; GATE[rbase + slot] = __uint_as_float(k); } }
    __syncthreads();
}

__device__ __forceinline__ void p8_gather(const Ctx& C, unsigned char* ws) {
    const bf16* X1 = (const bf16*)(ws + WS_X1); bf16* XG = (bf16*)(ws + WS_XG); const int* IDX = (const int*)(ws + WS_IDX);
    for (int r = C.gw; r < MOE_ROWS; r += C.NGW) { const int b = (r >> 11) & 1, tok = IDX[r];
        const v4u* s = (const v4u*)(X1 + (size_t)(b * SEQ + tok) * DM) + C.lane; v4u* d = (v4u*)(XG + (size_t)r * DM) + C.lane;
        const v4u a = s[0], bq = s[64], c = s[128], dd = s[192]; d[0] = a; d[64] = bq; d[128] = c; d[192] = dd; }
}

__device__ __forceinline__ void p11_final(const Ctx& C, const float* g, const float* be, float* out, unsigned char* ws) {
    const bf16* X1 = (const bf16*)(ws + WS_X1); const bf16* Y = (const bf16*)(ws + WS_Y); const short* SLOT = (const short*)(ws + WS_SLOT);
    const int lane = C.lane;
    for (int m = C.gw; m < MTOK; m += C.NGW) { const int b = m >> 14;
        float v[4][8];
#pragma unroll
        for (int j = 0; j < 4; ++j) { const v4u a = *(const v4u*)(X1 + (size_t)m * DM + 512 * j + 8 * lane);
            v[j][0] = bflo(a.x); v[j][1] = bfhi(a.x); v[j][2] = bflo(a.y); v[j][3] = bfhi(a.y); v[j][4] = bflo(a.z); v[j][5] = bfhi(a.z); v[j][6] = bflo(a.w); v[j][7] = bfhi(a.w);
#pragma unroll
            for (int e = 0; e < 8; ++e) v[j][e] *= DN_ALPHA; }
        const v4u s0 = *(const v4u*)(SLOT + (size_t)m * 16), s1 = *(const v4u*)(SLOT + (size_t)m * 16 + 8);
        const unsigned sw[8] = {s0.x, s0.y, s0.z, s0.w, s1.x, s1.y, s1.z, s1.w};
#pragma unroll
        for (int e = 0; e < 16; ++e) { const int sl = __builtin_amdgcn_readfirstlane((int)(short)((e & 1) ? (sw[e >> 1] >> 16) : (sw[e >> 1] & 0xffffu)));
            if (sl >= 0) { const bf16* yr = Y + ((size_t)(e * 2 + b) * CAP + sl) * DM;
#pragma unroll
                for (int j = 0; j < 4; ++j) { const v4u a = *(const v4u*)(yr + 512 * j + 8 * lane);
                    v[j][0] += bflo(a.x); v[j][1] += bfhi(a.x); v[j][2] += bflo(a.y); v[j][3] += bfhi(a.y); v[j][4] += bflo(a.z); v[j][5] += bfhi(a.z); v[j][6] += bflo(a.w); v[j][7] += bfhi(a.w); } } }
        float s = 0.f;
#pragma unroll
        for (int j = 0; j < 4; ++j)
#pragma unroll
            for (int e = 0; e < 8; ++e) s += v[j][e];
        const float mean = wave_sum(s) * (1.0f / DM); float q2 = 0.f;
#pragma unroll
        for (int j = 0; j < 4; ++j)
#pragma unroll
            for (int e = 0; e < 8; ++e) { v[j][e] -= mean; q2 += v[j][e] * v[j][e]; }
        const float rstd = 1.0f / sqrtf(wave_sum(q2) * (1.0f / DM) + LN_EPS);
#pragma unroll
        for (int j = 0; j < 4; ++j) { const int k0 = 512 * j + 8 * lane;
            const f32x4 ga = *(const f32x4*)(g + k0), gb = *(const f32x4*)(g + k0 + 4), ba = *(const f32x4*)(be + k0), bb = *(const f32x4*)(be + k0 + 4);
            f32x4 o0, o1;
#pragma unroll
            for (int e = 0; e < 4; ++e) { o0[e] = v[j][e] * rstd * ga[e] + ba[e]; o1[e] = v[j][4 + e] * rstd * gb[e] + bb[e]; }
            *(f32x4*)(out + (size_t)m * DM + k0) = o0; *(f32x4*)(out + (size_t)m * DM + k0 + 4) = o1; }
    }
}
struct Args { const float* in[28]; float* out; unsigned char* ws; int ph_lo, ph_hi; };
__global__ void __launch_bounds__(NWAVES * 64, 2) mega_fwd(Args args) {
    extern __shared__ __attribute__((aligned(16))) unsigned char lds[];
    Ctx C; C.lds = (LAS unsigned char*)lds; C.tid = threadIdx.x; C.lane = C.tid & 63; C.wave = __builtin_amdgcn_readfirstlane(C.tid >> 6);
    C.G = gridDim.x; C.gw = blockIdx.x * NWAVES + C.wave; C.NGW = C.G * NWAVES;
    unsigned char* ws = args.ws; unsigned* ctl = (unsigned*)(ws + WS_CTL);
    volatile LAS unsigned* MISC = (volatile LAS unsigned*)(C.lds + MISC_OFF);
    for (int u = C.tid; u < (LDS_BYTES - LDSCTL_OFF) / 4; u += NWAVES * 64) ((LAS unsigned*)(C.lds + LDSCTL_OFF))[u] = 0u;
    __syncthreads();
    XcdBarrier bar; bar.bar = ctl + CW_BAR; bar.x = 0; bar.st = nullptr;
    if (N_LAUNCHES == 1) bar = xcd_barrier_post(ctl + CW_BAR, MISC + 8);
    const int lo = args.ph_lo, hi = args.ph_hi;
#ifndef PH_MASK
#define PH_MASK 0xfff
#endif
#define IN(k) (((PH_MASK >> (k)) & 1) && lo <= (k) && (k) < hi)
#define SEAM(k) do { if (IN(k) && IN((k) + 1)) xcd_barrier(bar); } while (0)
    typedef const float* __attribute__((address_space(4))) const* KPtr;
    KPtr in0 = (KPtr)__builtin_amdgcn_kernarg_segment_ptr();
#define LAUNDER_IN() KPtr in = in0; asm volatile("" : "+s"(in))
#define GIN(k) ((const float*)(__attribute__((address_space(1))) const float*)in[k])
    LAS unsigned char* ring = C.lds;

    if (IN(0)) { LAUNDER_IN(); p0_prologue(C, in, ws); __syncthreads(); }
    SEAM(0);
    if (IN(1)) { LAUNDER_IN();
        { pg8::Gemm g{(const bf16*)(ws + WS_WIN), (const bf16*)(ws + WS_XB), NHY, MTOK, DM}; pg8::StaticOrder S; S.init(NHY, MTOK, C.G, (int)blockIdx.x);
          pg8::EpiRowBias E{(bf16*)(ws + WS_PT), MTOK, GIN(2)};
          pg8::gemm_phase<pg8::EpiRowBias, pg8::StaticOrder, true, true>(ring, g, S, E); }
        __syncthreads();
        { pg8::Gemm g{(const bf16*)(ws + WS_XB), (const bf16*)(ws + WS_WIN) + (size_t)NHY * DM, MTOK, NATT, DM}; pg8::StaticOrder S; S.init(MTOK, NATT, C.G, (int)blockIdx.x);
          pg8::EpiColBias E{(bf16*)(ws + WS_QKV), NATT, GIN(2) + NHY};
          pg8::gemm_phase<pg8::EpiColBias, pg8::StaticOrder, true, true>(ring, g, S, E); }
        __syncthreads();
        { pg8::Gemm g{(const bf16*)(ws + WS_W3T), (const bf16*)(ws + WS_H2), 4096, SEQ, 256}; pg8::StaticOrder S; S.init(4096, SEQ, C.G, (int)blockIdx.x);
          pg8::EpiFilt E{(bf16*)(ws + WS_FILT), SEQ, GIN(12)};
          pg8::gemm_phase<pg8::EpiFilt, pg8::StaticOrder, true, true>(ring, g, S, E); }
        __syncthreads();
    }
    SEAM(1);
    if (IN(2)) { LAUNDER_IN();
        p2_kpass(C, GIN(15), ws);
        f2* A = (f2*)lds; f2* B = A + HY_BUF;
        for (int c = blockIdx.x; c < HYW; c += C.G) { hy_unit(c, GIN(3), GIN(4), GIN(13), ws, A, B, C.tid); __syncthreads(); }
    }
    SEAM(2);
    if (IN(3)) { LAUNDER_IN();
        const bf16* QKV = (const bf16*)(ws + WS_QKV); const bf16* KP = (const bf16*)(ws + WS_KP); const bf16* VP = (const bf16*)(ws + WS_VP); bf16* YATT = (bf16*)(ws + WS_YATT);
        for (int rnd = 0; rnd * C.G < 1024; ++rnd) {
            int b, h, qb;
            if (C.G == 256) { const int xcd = blockIdx.x & 7, w = blockIdx.x >> 3, pair = xcd >> 1, idx = (xcd & 1) * 128 + rnd * 32 + w; b = pair >> 1; h = (pair & 1) * 4 + (idx >> 6); qb = idx & 63; }
            else { const int u = rnd * C.G + blockIdx.x; if (u >= 1024) break; b = u >> 9; h = (u >> 6) & 7; qb = u & 63; }
            const int kvh = h >> 2; const size_t m0 = (size_t)b * SEQ + qb * 256;
            att::attn_unit(QKV + m0 * NATT + h * 128, qb * 256, GIN(14), KP + (size_t)(b * 2 + kvh) * SEQ * 128, VP + (size_t)(b * 2 + kvh) * SEQ * 128, YATT + m0 * 1024 + h * 128, SEQ, (char*)lds);
        }
    }
    SEAM(3);
    if (IN(4)) { LAUNDER_IN(); p4_merge(C, GIN(16), GIN(17), ws); __syncthreads(); }
    SEAM(4);
    if (IN(5)) { LAUNDER_IN();
        pg8::Gemm g{(const bf16*)(ws + WS_MIX), (const bf16*)(ws + WS_WOUT), MTOK, DM, DM}; pg8::StaticOrder S; S.init(MTOK, DM, C.G, (int)blockIdx.x);
        pg8::EpiResid E{(bf16*)(ws + WS_T), DM, GIN(0), DN_ALPHA};
        pg8::gemm_phase<pg8::EpiResid, pg8::StaticOrder, true, true>(ring, g, S, E);
        __syncthreads();
    }
    SEAM(5);
    if (IN(6)) { LAUNDER_IN(); p6_ln_router(C, GIN(19), GIN(20), GIN(21), GIN(22), ws); }
    SEAM(6);
    if (IN(7)) { LAUNDER_IN(); for (int be = blockIdx.x; be < BATCH * NE; be += C.G) p7_topk(C, be, ws); }
    SEAM(7);
    if (IN(8)) { p8_gather(C, ws); }
    SEAM(8);
    if (IN(9)) { LAUNDER_IN();
        pg8::Gemm g{(const bf16*)(ws + WS_XG), (const bf16*)(ws + WS_WGU), MOE_ROWS, 3072, DM}; pg8::GroupedOrder S; S.initg(12, C.G, (int)blockIdx.x);
        pg8::EpiSwiGLU E{(bf16*)(ws + WS_HB), EFF, 12};
        pg8::gemm_phase<pg8::EpiSwiGLU, pg8::GroupedOrder, true, true>(ring, g, S, E);
        __syncthreads();
    }
    SEAM(9);
    if (IN(10)) { LAUNDER_IN();
        pg8::Gemm g{(const bf16*)(ws + WS_HB), (const bf16*)(ws + WS_WD), MOE_ROWS, DM, EFF}; pg8::GroupedOrder S; S.initg(8, C.G, (int)blockIdx.x);
        pg8::EpiRowScale E{(bf16*)(ws + WS_Y), DM, (const float*)(ws + WS_GATE), 8};
        pg8::gemm_phase<pg8::EpiRowScale, pg8::GroupedOrder, true, true>(ring, g, S, E);
        __syncthreads();
    }
    SEAM(10);
    if (IN(11)) { LAUNDER_IN(); p11_final(C, GIN(26), GIN(27), args.out, ws); }
#undef IN
#undef SEAM
}

extern "C" void kernel_launch(void* const* d_in, const int* in_sizes, int n_in, void* d_out, int out_size, void* d_ws, size_t ws_size, hipStream_t stream) {
    static int grid = 0;
    if (grid == 0) {
        if (n_in != 28 || in_sizes[0] != MTOK * DM || out_size != MTOK * DM || ws_size < WS_END) { fprintf(stderr, "kernel_launch: unexpected shapes (n_in %d, in0 %d, out %d, ws %zu < %zu)\n", n_in, n_in > 0 ? in_sizes[0] : -1, out_size, ws_size, (size_t)WS_END); grid = -1; return; }
        int dev = 0, cus = 0, per_cu = 0;
        if (hipGetDevice(&dev) != hipSuccess || hipDeviceGetAttribute(&cus, hipDeviceAttributeMultiprocessorCount, dev) != hipSuccess) { grid = -1; return; }
        if (hipFuncSetAttribute((const void*)mega_fwd, hipFuncAttributeMaxDynamicSharedMemorySize, LDS_BYTES) != hipSuccess) { fprintf(stderr, "kernel_launch: hipFuncSetAttribute failed\n"); grid = -1; return; }
        if (hipOccupancyMaxActiveBlocksPerMultiprocessor(&per_cu, (const void*)mega_fwd, NWAVES * 64, LDS_BYTES) != hipSuccess || per_cu < 1) { fprintf(stderr, "kernel_launch: occupancy query says %d\n", per_cu); }
        (void)hipGetLastError();
        grid = cus;
    }
    if (grid < 0) return;
    if (hipMemsetAsync((char*)d_ws + WS_CTL, 0, CTL_ZERO_BYTES, stream) != hipSuccess) return;
    Args a{};
    for (int i = 0; i < 28; ++i) a.in[i] = (const float*)d_in[i];
    a.out = (float*)d_out; a.ws = (unsigned char*)d_ws;
    for (int li = 0; li < N_LAUNCHES; ++li) {
        a.ph_lo = (N_LAUNCHES == 1) ? 0 : li; a.ph_hi = (N_LAUNCHES == 1) ? N_PHASES : li + 1;
        hipLaunchKernelGGL(mega_fwd, dim3(grid), dim3(NWAVES * 64), LDS_BYTES, stream, a);
    }
}
```

```cpp
#include <hip/hip_runtime.h>
#include <cstdio>
#include <cstdint>
namespace pg8 {
#define PG8_LAS __attribute__((address_space(3)))
typedef unsigned short bf16_t;
typedef short bf16x8 __attribute__((ext_vector_type(8)));
typedef float f32x4 __attribute__((ext_vector_type(4)));
typedef unsigned u32x4 __attribute__((ext_vector_type(4)));
constexpr int BM = 256, BK = 64, HALF = 128, HTB = HALF * BK * 2  , STAGE_BYTES = 8 * HTB, NXCD = 8, WGM = 8;

__host__ __device__ __forceinline__ int lds_byte(int r, int c) { const int st = (r >> 4) * 2 + (c >> 5), rr = r & 15, cc = c & 31, ob = rr * 64 + cc * 2; return st * 1024 + (ob ^ (((ob >> 9) & 1) << 5)); }
__host__ __device__ __forceinline__ void stage_rc(int b, int& R, int& C) { const int st = b / 1024, sb = b % 1024, swz = sb ^ (((sb >> 9) & 1) << 5); R = (st >> 1) * 16 + swz / 64; C = (st & 1) * 32 + (swz % 64) / 2; }
__host__ __device__ __forceinline__ int perm32(int rho) { const int n = rho >> 4, i = rho & 15; return 8 * (i >> 2) + 4 * n + (i & 3); }

struct Unit { int pm, pn; };
struct Gemm { const bf16_t* A; const bf16_t* Bt; int M, N, K; };

struct StaticOrder {
    int nM, nN, nwg, G, c, reps;
    __host__ __device__ void init(int M, int N, int G_, int c_) { nM = M / BM; nN = N / BM; nwg = nM * nN; G = G_; c = c_; reps = 1; }
    __host__ __device__ bool next(int i, Unit& u) const {
        long L = (long)i * G + c; if (L >= (long)nwg * reps) return false; L %= nwg;
        int wgid = (int)L; { const int q = nwg / NXCD, r = nwg % NXCD, xcd = wgid % NXCD, off = wgid / NXCD; wgid = (xcd < r ? xcd * (q + 1) : r * (q + 1) + (xcd - r) * q) + off; }
        const int nig = WGM * nN, gid = wgid / nig, fm = gid * WGM, gsz = (nM - fm) < WGM ? (nM - fm) : WGM;
        u.pm = fm + ((wgid % nig) % gsz); u.pn = (wgid % nig) / gsz; return true;
    }
    __device__ __forceinline__ void a_ready(const Unit&) const {}
    __device__ __forceinline__ void done(const Unit&) const {}
};

__device__ __forceinline__ unsigned cvt_pk_bf16(float lo, float hi) { unsigned r; asm volatile("v_cvt_pk_bf16_f32 %0, %1, %2" : "=v"(r) : "v"(lo), "v"(hi)); return r; }
template <class Epi, class Sched, bool ALIGN_EPI = false, bool SP2 = false>
__device__ __forceinline__ void gemm_phase(PG8_LAS unsigned char* lds, const Gemm g, const Sched& S, const Epi& E) {
    const int tid = threadIdx.x, wid = __builtin_amdgcn_readfirstlane(tid >> 6), lane = tid & 63, wr = wid >> 2, wc = wid & 3, fr = lane & 15, fq = lane >> 4;
    const int K = g.K, nt = K / BK;
    unsigned voffA[2], voffB[2];
#pragma unroll
    for (int i = 0; i < 2; ++i) { int R, C; stage_rc(tid * 16 + i * 8192, R, C); const int Rb = Epi::PERM ? ((R & ~31) + perm32(R & 31)) : R;
        voffA[i] = (unsigned)(R * K + C) * 2u; voffB[i] = (unsigned)(Rb * K + C) * 2u; }
    const size_t kstep = (size_t)(BK * 2);
    const size_t hstep = (size_t)HALF * K * 2;
    const size_t tstep = 2 * hstep;
    const unsigned ldsw = (unsigned)wid * 1024u;
    const int aoff = lds_byte(wr * 64 + fr, fq * 8), boff = lds_byte(wc * 32 + fr, fq * 8);
#define PG8_SA(b, h) (((b) * 2 + (h)) * HTB)
#define PG8_SB(b, h) ((4 + (b) * 2 + (h)) * HTB)
#define PG8_STAGE(bufoff, gbase, voff) do { _Pragma("unroll") for (int _i = 0; _i < 2; ++_i) \
        __builtin_amdgcn_global_load_lds((const unsigned*)((const char*)(gbase) + (voff)[_i]), (PG8_LAS unsigned*)(lds + (bufoff) + ldsw + _i * 8192), 16, 0, 0); } while (0)
#define PG8_LDA(dst, b, h) do { _Pragma("unroll") for (int m = 0; m < 4; ++m) _Pragma("unroll") for (int k = 0; k < 2; ++k) dst[m][k] = *(const PG8_LAS bf16x8*)(lds + PG8_SA(b, h) + aoff + m * 2048 + k * 1024); } while (0)
#define PG8_LDB(dst, b, h) do { _Pragma("unroll") for (int n = 0; n < 2; ++n) _Pragma("unroll") for (int k = 0; k < 2; ++k) dst[n][k] = *(const PG8_LAS bf16x8*)(lds + PG8_SB(b, h) + boff + n * 2048 + k * 1024); } while (0)
#define PG8_MMA(ai, bj, At, Bt) do { __builtin_amdgcn_s_setprio(1); _Pragma("unroll") for (int m = 0; m < 4; ++m) _Pragma("unroll") for (int n = 0; n < 2; ++n) _Pragma("unroll") for (int k = 0; k < 2; ++k) \
        acc[ai][bj][m][n] = __builtin_amdgcn_mfma_f32_16x16x32_bf16(Bt[n][k], At[m][k], acc[ai][bj][m][n], 0, 0, 0); __builtin_amdgcn_s_setprio(0); } while (0)
#define PG8_WAIT_V(n) asm volatile("s_waitcnt vmcnt(" #n ")" ::: "memory")
#define PG8_WAIT_L(n) asm volatile("s_waitcnt lgkmcnt(" #n ")" ::: "memory")
#define PG8_BAR __builtin_amdgcn_s_barrier()
#define PG8_SCHED __builtin_amdgcn_sched_barrier(0)
    Unit cur, nxt; int ui = 0;
    if (!S.next(0, cur)) return;
    f32x4 acc[2][2][4][2];
#pragma unroll
    for (int a = 0; a < 2; ++a)
#pragma unroll
        for (int b = 0; b < 2; ++b)
#pragma unroll
            for (int m = 0; m < 4; ++m)
#pragma unroll
                for (int n = 0; n < 2; ++n) acc[a][b][m][n] = (f32x4){0.f, 0.f, 0.f, 0.f};
    bf16x8 At[4][2], B0[2][2], B1[2][2];
    const char* cA = (const char*)g.A + (size_t)cur.pm * tstep; const char* cB = (const char*)g.Bt + (size_t)cur.pn * tstep;
    S.a_ready(cur);
    if constexpr (SP2) {
        PG8_STAGE(PG8_SB(0, 0), cB, voffB); PG8_STAGE(PG8_SB(0, 1), cB + hstep, voffB); PG8_STAGE(PG8_SA(0, 0), cA, voffA); PG8_STAGE(PG8_SA(0, 1), cA + hstep, voffA);
        if (wr == 1) PG8_BAR;
        PG8_WAIT_V(2); PG8_BAR;
        PG8_STAGE(PG8_SB(1, 0), cB + kstep, voffB); PG8_STAGE(PG8_SA(1, 0), cA + kstep, voffA); PG8_STAGE(PG8_SB(1, 1), cB + hstep + kstep, voffB);
        PG8_WAIT_V(6); PG8_BAR;
    } else {
        PG8_STAGE(PG8_SB(0, 0), cB, voffB); PG8_STAGE(PG8_SA(0, 0), cA, voffA); PG8_STAGE(PG8_SB(0, 1), cB + hstep, voffB); PG8_STAGE(PG8_SA(0, 1), cA + hstep, voffA);
        if (wr == 1) PG8_BAR;
        PG8_WAIT_V(4); PG8_BAR;
        PG8_STAGE(PG8_SB(1, 0), cB + kstep, voffB); PG8_STAGE(PG8_SA(1, 0), cA + kstep, voffA); PG8_STAGE(PG8_SB(1, 1), cB + hstep + kstep, voffB);
        PG8_WAIT_V(6); PG8_BAR;
    }
    for (;;) {
        const bool has_next = S.next(ui + 1, nxt);
        const char* nA = has_next ? (const char*)g.A + (size_t)nxt.pm * tstep : cA; const char* nB = has_next ? (const char*)g.Bt + (size_t)nxt.pn * tstep : cB;
        for (int t = 0; t < nt; t += 2) {
            const bool last = (t == nt - 2);
            const char* a1 = cA + (size_t)(t + 1) * kstep;
            const char* a2 = last ? nA : cA + (size_t)(t + 2) * kstep; const char* b2 = last ? nB : cB + (size_t)(t + 2) * kstep;
            const char* a3 = a2 + kstep; const char* b3 = b2 + kstep;
            if (last && has_next) S.a_ready(nxt);
            if constexpr (SP2) {
            PG8_LDB(B0, 0, 0); PG8_LDB(B1, 0, 1); PG8_SCHED; PG8_LDA(At, 0, 0); PG8_STAGE(PG8_SA(1, 1), a1 + hstep, voffA);
            PG8_WAIT_V(8); PG8_WAIT_L(0); PG8_BAR; PG8_MMA(0, 0, At, B0); PG8_MMA(0, 1, At, B1); PG8_BAR; PG8_SCHED;
            PG8_LDA(At, 0, 1); PG8_STAGE(PG8_SB(0, 0), b2, voffB); PG8_STAGE(PG8_SB(0, 1), b2 + hstep, voffB); PG8_STAGE(PG8_SA(0, 0), a2, voffA);
            PG8_WAIT_V(8); PG8_WAIT_L(0); PG8_BAR; PG8_MMA(1, 0, At, B0); PG8_MMA(1, 1, At, B1); PG8_BAR; PG8_SCHED;
            PG8_LDB(B0, 1, 0); PG8_LDB(B1, 1, 1); PG8_SCHED; PG8_LDA(At, 1, 0); PG8_STAGE(PG8_SA(0, 1), a2 + hstep, voffA);
            PG8_WAIT_V(8); PG8_WAIT_L(0); PG8_BAR; PG8_MMA(0, 0, At, B0); PG8_MMA(0, 1, At, B1); PG8_BAR; PG8_SCHED;
            PG8_LDA(At, 1, 1); PG8_STAGE(PG8_SB(1, 0), b3, voffB); PG8_STAGE(PG8_SB(1, 1), b3 + hstep, voffB); PG8_STAGE(PG8_SA(1, 0), a3, voffA);
            PG8_WAIT_V(8); PG8_WAIT_L(0); PG8_BAR; PG8_MMA(1, 0, At, B0); PG8_MMA(1, 1, At, B1); PG8_BAR; PG8_SCHED;
            } else {
            PG8_LDB(B0, 0, 0); PG8_SCHED; PG8_LDA(At, 0, 0); PG8_STAGE(PG8_SA(1, 1), a1 + hstep, voffA);
            PG8_WAIT_L(8); PG8_BAR; PG8_WAIT_L(0); PG8_MMA(0, 0, At, B0); PG8_BAR; PG8_SCHED;
            PG8_LDB(B1, 0, 1); PG8_STAGE(PG8_SB(0, 0), b2, voffB);
            PG8_BAR; PG8_WAIT_L(0); PG8_MMA(0, 1, At, B1); PG8_BAR;
            PG8_LDA(At, 0, 1); PG8_STAGE(PG8_SA(0, 0), a2, voffA);
            PG8_BAR; PG8_WAIT_L(0); PG8_MMA(1, 0, At, B0); PG8_BAR; PG8_SCHED;
            PG8_STAGE(PG8_SB(0, 1), b2 + hstep, voffB);
            PG8_WAIT_V(6); PG8_BAR; PG8_MMA(1, 1, At, B1); PG8_BAR;
            PG8_LDB(B0, 1, 0); PG8_SCHED; PG8_LDA(At, 1, 0); PG8_STAGE(PG8_SA(0, 1), a2 + hstep, voffA);
            PG8_WAIT_L(8); PG8_BAR; PG8_WAIT_L(0); PG8_MMA(0, 0, At, B0); PG8_BAR; PG8_SCHED;
            PG8_LDB(B1, 1, 1); PG8_STAGE(PG8_SB(1, 0), b3, voffB);
            PG8_BAR; PG8_WAIT_L(0); PG8_MMA(0, 1, At, B1); PG8_BAR;
            PG8_LDA(At, 1, 1); PG8_STAGE(PG8_SA(1, 0), a3, voffA);
            PG8_BAR; PG8_WAIT_L(0); PG8_MMA(1, 0, At, B0); PG8_BAR; PG8_SCHED;
            PG8_STAGE(PG8_SB(1, 1), b3 + hstep, voffB);
            PG8_WAIT_V(6); PG8_BAR; PG8_MMA(1, 1, At, B1); PG8_BAR;
            }
        }
        if constexpr (ALIGN_EPI) { if (wr == 0) PG8_BAR; }
        if constexpr (!Epi::AFTER_DRAIN) { E(acc, cur, wr, wc, fr, fq); S.done(cur); }
        if (!has_next) break;
#pragma unroll
        for (int a = 0; a < 2; ++a)
#pragma unroll
            for (int b = 0; b < 2; ++b)
#pragma unroll
                for (int m = 0; m < 4; ++m)
#pragma unroll
                    for (int n = 0; n < 2; ++n) acc[a][b][m][n] = (f32x4){0.f, 0.f, 0.f, 0.f};
        cur = nxt; cA = nA; cB = nB; ++ui;
        if constexpr (ALIGN_EPI) { if (wr == 1) PG8_BAR; }
    }
    PG8_WAIT_V(0);
    if constexpr (!ALIGN_EPI) { if (wr == 0) PG8_BAR; }
    PG8_BAR;
    if constexpr (Epi::AFTER_DRAIN) { E.fused(acc, cur, wr, wc, fr, fq, lds, wid, lane); S.done(cur); }
#undef PG8_SA
#undef PG8_SB
#undef PG8_STAGE
#undef PG8_LDA
#undef PG8_LDB
#undef PG8_MMA
#undef PG8_WAIT_V
#undef PG8_WAIT_L
#undef PG8_BAR
#undef PG8_SCHED
}
}
namespace pg8 {
typedef int v4i_t __attribute__((ext_vector_type(4)));
typedef int v8i_t __attribute__((ext_vector_type(8)));
__device__ __forceinline__ v8i_t cat32(bf16x8 lo, bf16x8 hi) { const v4i_t a = __builtin_bit_cast(v4i_t, lo), b = __builtin_bit_cast(v4i_t, hi); return __builtin_shufflevector(a, b, 0, 1, 2, 3, 4, 5, 6, 7); }
template <class Epi, class Sched, class Gth, bool ALIGN_EPI = false, bool SP2 = true>
__device__ __forceinline__ void gemm_phase_g8(PG8_LAS unsigned char* lds, const Gemm g, const Sched& S, const Epi& E, const Gth& Gt) {
    static_assert(SP2, "gemm_phase_g8: SP2 loop only");
    const int tid = threadIdx.x, wid = __builtin_amdgcn_readfirstlane(tid >> 6), lane = tid & 63, wr = wid >> 2, wc = wid & 3, fr = lane & 15, fq = lane >> 4;
    const int K = g.K, nt = K / BK;
    unsigned voffA[2], voffB[2]; int Rr[2], Cc[2];
#pragma unroll
    for (int i = 0; i < 2; ++i) { int R, C; stage_rc(tid * 16 + i * 8192, R, C); const int Rb = Epi::PERM ? ((R & ~31) + perm32(R & 31)) : R;
        voffA[i] = (unsigned)(R * K + C) * 2u; voffB[i] = (unsigned)(Rb * K + C) * 2u; Rr[i] = R; Cc[i] = C; }
    (void)voffA;
    unsigned gC[2][2], gN[2][2];
#define PG8_GFILL(dst, pm_) do { _Pragma("unroll") for (int h_ = 0; h_ < 2; ++h_) _Pragma("unroll") for (int i_ = 0; i_ < 2; ++i_) dst[h_][i_] = (unsigned)Gt.row((pm_) * BM + h_ * HALF + Rr[i_]) * (unsigned)(K * 2) + (unsigned)(Cc[i_] * 2); } while (0)
    const size_t kstep = (size_t)(BK * 2);
    const size_t hstep = (size_t)HALF * K * 2;
    const size_t tstep = 2 * hstep;
    const unsigned ldsw = (unsigned)wid * 1024u;
    const int aoff = lds_byte(wr * 64 + fr, fq * 8), boff = lds_byte(wc * 32 + fr, fq * 8);
#define PG8_SA(b, h) (((b) * 2 + (h)) * HTB)
#define PG8_SB(b, h) ((4 + (b) * 2 + (h)) * HTB)
#define PG8_STAGE(bufoff, gbase, voff) do { _Pragma("unroll") for (int _i = 0; _i < 2; ++_i) \
        __builtin_amdgcn_global_load_lds((const unsigned*)((const char*)(gbase) + (voff)[_i]), (PG8_LAS unsigned*)(lds + (bufoff) + ldsw + _i * 8192), 16, 0, 0); } while (0)
#define PG8_LDA(dst, b, h) do { _Pragma("unroll") for (int m = 0; m < 4; ++m) dst[m] = cat32(*(const PG8_LAS bf16x8*)(lds + PG8_SA(b, h) + aoff + m * 2048), *(const PG8_LAS bf16x8*)(lds + PG8_SA(b, h) + aoff + m * 2048 + 1024)); } while (0)
#define PG8_LDB(dst, b, h) do { _Pragma("unroll") for (int n = 0; n < 2; ++n) dst[n] = cat32(*(const PG8_LAS bf16x8*)(lds + PG8_SB(b, h) + boff + n * 2048), *(const PG8_LAS bf16x8*)(lds + PG8_SB(b, h) + boff + n * 2048 + 1024)); } while (0)
#define PG8_MMA(ai, bj, At, Bt) do { __builtin_amdgcn_s_setprio(1); _Pragma("unroll") for (int m = 0; m < 4; ++m) _Pragma("unroll") for (int n = 0; n < 2; ++n) \
        asm volatile("v_mfma_scale_f32_16x16x128_f8f6f4 %0, %1, %2, %0, %3, %4 op_sel_hi:[0,0,0]" : "+v"(acc[ai][bj][m][n]) : "v"(Bt[n]), "v"(At[m]), "v"(scw), "v"(sca)); __builtin_amdgcn_s_setprio(0); } while (0)
#define PG8_WAIT_V(n) asm volatile("s_waitcnt vmcnt(" #n ")" ::: "memory")
#define PG8_WAIT_L(n) asm volatile("s_waitcnt lgkmcnt(" #n ")" ::: "memory")
#define PG8_BAR __builtin_amdgcn_s_barrier()
#define PG8_SCHED __builtin_amdgcn_sched_barrier(0)
    Unit cur, nxt; int ui = 0;
    if (!S.next(0, cur)) return;
    f32x4 acc[2][2][4][2];
#pragma unroll
    for (int a = 0; a < 2; ++a)
#pragma unroll
        for (int b = 0; b < 2; ++b)
#pragma unroll
            for (int m = 0; m < 4; ++m)
#pragma unroll
                for (int n = 0; n < 2; ++n) acc[a][b][m][n] = (f32x4){0.f, 0.f, 0.f, 0.f};
    v8i_t At[4], B0[2], B1[2]; const int scw = 0x7a7a7a7a, sca = 0x7f7f7f7f;
    const char* Ab = (const char*)g.A; const char* cB = (const char*)g.Bt + (size_t)cur.pn * tstep;
    PG8_GFILL(gC, cur.pm);
    S.a_ready(cur);
    if constexpr (SP2) {
        PG8_STAGE(PG8_SB(0, 0), cB, voffB); PG8_STAGE(PG8_SB(0, 1), cB + hstep, voffB); PG8_STAGE(PG8_SA(0, 0), Ab, gC[0]); PG8_STAGE(PG8_SA(0, 1), Ab, gC[1]);
        if (wr == 1) PG8_BAR;
        PG8_WAIT_V(2); PG8_BAR;
        PG8_STAGE(PG8_SB(1, 0), cB + kstep, voffB); PG8_STAGE(PG8_SA(1, 0), Ab + kstep, gC[0]); PG8_STAGE(PG8_SB(1, 1), cB + hstep + kstep, voffB);
        PG8_WAIT_V(6); PG8_BAR;
    }
    for (;;) {
        const bool has_next = S.next(ui + 1, nxt);
        const char* nB = has_next ? (const char*)g.Bt + (size_t)nxt.pn * tstep : cB;
        if (has_next) PG8_GFILL(gN, nxt.pm); else { gN[0][0] = gC[0][0]; gN[0][1] = gC[0][1]; gN[1][0] = gC[1][0]; gN[1][1] = gC[1][1]; }
        for (int t = 0; t < nt; t += 2) {
            const bool last = (t == nt - 2);
            const char* a1 = Ab + (size_t)(t + 1) * kstep;
            const char* a2 = last ? Ab : Ab + (size_t)(t + 2) * kstep; const char* b2 = last ? nB : cB + (size_t)(t + 2) * kstep;
            unsigned g2[2][2];
#pragma unroll
            for (int h_ = 0; h_ < 2; ++h_)
#pragma unroll
                for (int i_ = 0; i_ < 2; ++i_) g2[h_][i_] = last ? gN[h_][i_] : gC[h_][i_];
            const char* a3 = a2 + kstep; const char* b3 = b2 + kstep;
            if (last && has_next) S.a_ready(nxt);
            if constexpr (SP2) {
            PG8_LDB(B0, 0, 0); PG8_LDB(B1, 0, 1); PG8_SCHED; PG8_LDA(At, 0, 0); PG8_STAGE(PG8_SA(1, 1), a1, gC[1]);
            PG8_WAIT_V(8); PG8_WAIT_L(0); PG8_BAR; PG8_MMA(0, 0, At, B0); PG8_MMA(0, 1, At, B1); PG8_BAR; PG8_SCHED;
            PG8_LDA(At, 0, 1); PG8_STAGE(PG8_SB(0, 0), b2, voffB); PG8_STAGE(PG8_SB(0, 1), b2 + hstep, voffB); PG8_STAGE(PG8_SA(0, 0), a2, g2[0]);
            PG8_WAIT_V(8); PG8_WAIT_L(0); PG8_BAR; PG8_MMA(1, 0, At, B0); PG8_MMA(1, 1, At, B1); PG8_BAR; PG8_SCHED;
            PG8_LDB(B0, 1, 0); PG8_LDB(B1, 1, 1); PG8_SCHED; PG8_LDA(At, 1, 0); PG8_STAGE(PG8_SA(0, 1), a2, g2[1]);
            PG8_WAIT_V(8); PG8_WAIT_L(0); PG8_BAR; PG8_MMA(0, 0, At, B0); PG8_MMA(0, 1, At, B1); PG8_BAR; PG8_SCHED;
            PG8_LDA(At, 1, 1); PG8_STAGE(PG8_SB(1, 0), b3, voffB); PG8_STAGE(PG8_SB(1, 1), b3 + hstep, voffB); PG8_STAGE(PG8_SA(1, 0), a3, g2[0]);
            PG8_WAIT_V(8); PG8_WAIT_L(0); PG8_BAR; PG8_MMA(1, 0, At, B0); PG8_MMA(1, 1, At, B1); PG8_BAR; PG8_SCHED;
            }
        }
        asm volatile("s_nop 15\n\ts_nop 15\n\ts_nop 15" ::: "memory");
        if constexpr (ALIGN_EPI) { if (wr == 0) PG8_BAR; }
        if constexpr (!Epi::AFTER_DRAIN) { E(acc, cur, wr, wc, fr, fq); S.done(cur); }
        if (!has_next) break;
#pragma unroll
        for (int a = 0; a < 2; ++a)
#pragma unroll
            for (int b = 0; b < 2; ++b)
#pragma unroll
                for (int m = 0; m < 4; ++m)
#pragma unroll
                    for (int n = 0; n < 2; ++n) acc[a][b][m][n] = (f32x4){0.f, 0.f, 0.f, 0.f};
        cur = nxt; cB = nB; ++ui; gC[0][0] = gN[0][0]; gC[0][1] = gN[0][1]; gC[1][0] = gN[1][0]; gC[1][1] = gN[1][1];
        if constexpr (ALIGN_EPI) { if (wr == 1) PG8_BAR; }
    }
    PG8_WAIT_V(0);
    if constexpr (!ALIGN_EPI) { if (wr == 0) PG8_BAR; }
    PG8_BAR;
    if constexpr (Epi::AFTER_DRAIN) { E.fused(acc, cur, wr, wc, fr, fq, lds, wid, lane); S.done(cur); }
#undef PG8_SA
#undef PG8_SB
#undef PG8_STAGE
#undef PG8_LDA
#undef PG8_LDB
#undef PG8_MMA
#undef PG8_WAIT_V
#undef PG8_WAIT_L
#undef PG8_BAR
#undef PG8_SCHED
#undef PG8_GFILL
}


}
namespace pg8 {
template <class Epi, class Sched, int SCW, int SCA, bool ALIGN_EPI = false, bool SP2 = true>
__device__ __forceinline__ void gemm_phase_8(PG8_LAS unsigned char* lds, const Gemm g, const Sched& S, const Epi& E) {
    static_assert(SP2, "gemm_phase_8: SP2 loop only");
    const int tid = threadIdx.x, wid = __builtin_amdgcn_readfirstlane(tid >> 6), lane = tid & 63, wr = wid >> 2, wc = wid & 3, fr = lane & 15, fq = lane >> 4;
    const int K = g.K, nt = K / BK;
    unsigned voffA[2], voffB[2];
#pragma unroll
    for (int i = 0; i < 2; ++i) { int R, C; stage_rc(tid * 16 + i * 8192, R, C); const int Rb = Epi::PERM ? ((R & ~31) + perm32(R & 31)) : R;
        voffA[i] = (unsigned)(R * K + C) * 2u; voffB[i] = (unsigned)(Rb * K + C) * 2u; }
    const size_t kstep = (size_t)(BK * 2);
    const size_t hstep = (size_t)HALF * K * 2;
    const size_t tstep = 2 * hstep;
    const unsigned ldsw = (unsigned)wid * 1024u;
    const int aoff = lds_byte(wr * 64 + fr, fq * 8), boff = lds_byte(wc * 32 + fr, fq * 8);
#define PG8_SA(b, h) (((b) * 2 + (h)) * HTB)
#define PG8_SB(b, h) ((4 + (b) * 2 + (h)) * HTB)
#define PG8_STAGE(bufoff, gbase, voff) do { _Pragma("unroll") for (int _i = 0; _i < 2; ++_i) \
        __builtin_amdgcn_global_load_lds((const unsigned*)((const char*)(gbase) + (voff)[_i]), (PG8_LAS unsigned*)(lds + (bufoff) + ldsw + _i * 8192), 16, 0, 0); } while (0)
#define PG8_LDA(dst, b, h) do { _Pragma("unroll") for (int m = 0; m < 4; ++m) dst[m] = cat32(*(const PG8_LAS bf16x8*)(lds + PG8_SA(b, h) + aoff + m * 2048), *(const PG8_LAS bf16x8*)(lds + PG8_SA(b, h) + aoff + m * 2048 + 1024)); } while (0)
#define PG8_LDB(dst, b, h) do { _Pragma("unroll") for (int n = 0; n < 2; ++n) dst[n] = cat32(*(const PG8_LAS bf16x8*)(lds + PG8_SB(b, h) + boff + n * 2048), *(const PG8_LAS bf16x8*)(lds + PG8_SB(b, h) + boff + n * 2048 + 1024)); } while (0)
#define PG8_MMA(ai, bj, At, Bt) do { __builtin_amdgcn_s_setprio(1); _Pragma("unroll") for (int m = 0; m < 4; ++m) _Pragma("unroll") for (int n = 0; n < 2; ++n) \
        asm volatile("v_mfma_scale_f32_16x16x128_f8f6f4 %0, %1, %2, %0, %3, %4 op_sel_hi:[0,0,0]" : "+v"(acc[ai][bj][m][n]) : "v"(Bt[n]), "v"(At[m]), "v"(scw), "v"(sca)); __builtin_amdgcn_s_setprio(0); } while (0)
#define PG8_WAIT_V(n) asm volatile("s_waitcnt vmcnt(" #n ")" ::: "memory")
#define PG8_WAIT_L(n) asm volatile("s_waitcnt lgkmcnt(" #n ")" ::: "memory")
#define PG8_BAR __builtin_amdgcn_s_barrier()
#define PG8_SCHED __builtin_amdgcn_sched_barrier(0)
    Unit cur, nxt; int ui = 0;
    if (!S.next(0, cur)) return;
    f32x4 acc[2][2][4][2];
#pragma unroll
    for (int a = 0; a < 2; ++a)
#pragma unroll
        for (int b = 0; b < 2; ++b)
#pragma unroll
            for (int m = 0; m < 4; ++m)
#pragma unroll
                for (int n = 0; n < 2; ++n) acc[a][b][m][n] = (f32x4){0.f, 0.f, 0.f, 0.f};
    v8i_t At[4], B0[2], B1[2]; const int scw = SCW * 0x01010101, sca = SCA * 0x01010101;
    const char* cA = (const char*)g.A + (size_t)cur.pm * tstep; const char* cB = (const char*)g.Bt + (size_t)cur.pn * tstep;
    S.a_ready(cur);
    if constexpr (SP2) {
        PG8_STAGE(PG8_SB(0, 0), cB, voffB); PG8_STAGE(PG8_SB(0, 1), cB + hstep, voffB); PG8_STAGE(PG8_SA(0, 0), cA, voffA); PG8_STAGE(PG8_SA(0, 1), cA + hstep, voffA);
        if (wr == 1) PG8_BAR;
        PG8_WAIT_V(2); PG8_BAR;
        PG8_STAGE(PG8_SB(1, 0), cB + kstep, voffB); PG8_STAGE(PG8_SA(1, 0), cA + kstep, voffA); PG8_STAGE(PG8_SB(1, 1), cB + hstep + kstep, voffB);
        PG8_WAIT_V(6); PG8_BAR;
    }
    for (;;) {
        const bool has_next = S.next(ui + 1, nxt);
        const char* nA = has_next ? (const char*)g.A + (size_t)nxt.pm * tstep : cA; const char* nB = has_next ? (const char*)g.Bt + (size_t)nxt.pn * tstep : cB;
        for (int t = 0; t < nt; t += 2) {
            const bool last = (t == nt - 2);
            const char* a1 = cA + (size_t)(t + 1) * kstep;
            const char* a2 = last ? nA : cA + (size_t)(t + 2) * kstep; const char* b2 = last ? nB : cB + (size_t)(t + 2) * kstep;
            const char* a3 = a2 + kstep; const char* b3 = b2 + kstep;
            if (last && has_next) S.a_ready(nxt);
            if constexpr (SP2) {
            PG8_LDB(B0, 0, 0); PG8_LDB(B1, 0, 1); PG8_SCHED; PG8_LDA(At, 0, 0); PG8_STAGE(PG8_SA(1, 1), a1 + hstep, voffA);
            PG8_WAIT_V(8); PG8_WAIT_L(0); PG8_BAR; PG8_MMA(0, 0, At, B0); PG8_MMA(0, 1, At, B1); PG8_BAR; PG8_SCHED;
            PG8_LDA(At, 0, 1); PG8_STAGE(PG8_SB(0, 0), b2, voffB); PG8_STAGE(PG8_SB(0, 1), b2 + hstep, voffB); PG8_STAGE(PG8_SA(0, 0), a2, voffA);
            PG8_WAIT_V(8); PG8_WAIT_L(0); PG8_BAR; PG8_MMA(1, 0, At, B0); PG8_MMA(1, 1, At, B1); PG8_BAR; PG8_SCHED;
            PG8_LDB(B0, 1, 0); PG8_LDB(B1, 1, 1); PG8_SCHED; PG8_LDA(At, 1, 0); PG8_STAGE(PG8_SA(0, 1), a2 + hstep, voffA);
            PG8_WAIT_V(8); PG8_WAIT_L(0); PG8_BAR; PG8_MMA(0, 0, At, B0); PG8_MMA(0, 1, At, B1); PG8_BAR; PG8_SCHED;
            PG8_LDA(At, 1, 1); PG8_STAGE(PG8_SB(1, 0), b3, voffB); PG8_STAGE(PG8_SB(1, 1), b3 + hstep, voffB); PG8_STAGE(PG8_SA(1, 0), a3, voffA);
            PG8_WAIT_V(8); PG8_WAIT_L(0); PG8_BAR; PG8_MMA(1, 0, At, B0); PG8_MMA(1, 1, At, B1); PG8_BAR; PG8_SCHED;
            }
        }
        asm volatile("s_nop 15\n\ts_nop 15\n\ts_nop 15" ::: "memory");
        if constexpr (ALIGN_EPI) { if (wr == 0) PG8_BAR; }
        if constexpr (!Epi::AFTER_DRAIN) { E(acc, cur, wr, wc, fr, fq); S.done(cur); }
        if (!has_next) break;
#pragma unroll
        for (int a = 0; a < 2; ++a)
#pragma unroll
            for (int b = 0; b < 2; ++b)
#pragma unroll
                for (int m = 0; m < 4; ++m)
#pragma unroll
                    for (int n = 0; n < 2; ++n) acc[a][b][m][n] = (f32x4){0.f, 0.f, 0.f, 0.f};
        cur = nxt; cA = nA; cB = nB; ++ui;
        if constexpr (ALIGN_EPI) { if (wr == 1) PG8_BAR; }
    }
    PG8_WAIT_V(0);
    if constexpr (!ALIGN_EPI) { if (wr == 0) PG8_BAR; }
    PG8_BAR;
    if constexpr (Epi::AFTER_DRAIN) { E.fused(acc, cur, wr, wc, fr, fq, lds, wid, lane); S.done(cur); }
#undef PG8_SA
#undef PG8_SB
#undef PG8_STAGE
#undef PG8_LDA
#undef PG8_LDB
#undef PG8_MMA
#undef PG8_WAIT_V
#undef PG8_WAIT_L
#undef PG8_BAR
#undef PG8_SCHED
}


}
namespace pg8 {
__device__ __forceinline__ u32x4 pack8(f32x4 v0, f32x4 v1) { u32x4 w; w.x = cvt_pk_bf16(v0[0], v0[1]); w.y = cvt_pk_bf16(v0[2], v0[3]); w.z = cvt_pk_bf16(v1[0], v1[1]); w.w = cvt_pk_bf16(v1[2], v1[3]); return w; }
struct EpiColBias {
    static constexpr bool PERM = true, AFTER_DRAIN = false;
    bf16_t* O; int ldc; const float* bias;
    __device__ __forceinline__ void operator()(const f32x4 (&acc)[2][2][4][2], const Unit& u, int wr, int wc, int fr, int fq) const {
        const int row0 = u.pm * BM + wr * 64 + fr, col0 = u.pn * BM + wc * 32 + 8 * fq;
        f32x4 bv[2][2];
#pragma unroll
        for (int bj = 0; bj < 2; ++bj)
#pragma unroll
            for (int n = 0; n < 2; ++n) bv[bj][n] = *(const f32x4*)(bias + col0 + bj * HALF + 4 * n);
#pragma unroll
        for (int ai = 0; ai < 2; ++ai)
#pragma unroll
            for (int m = 0; m < 4; ++m) { bf16_t* rowp = O + (size_t)(row0 + ai * HALF + m * 16) * ldc + col0;
#pragma unroll
                for (int bj = 0; bj < 2; ++bj) *(u32x4*)(rowp + bj * HALF) = pack8(acc[ai][bj][m][0] + bv[bj][0], acc[ai][bj][m][1] + bv[bj][1]); }
    }
};
struct EpiRowBias {
    static constexpr bool PERM = true, AFTER_DRAIN = false;
    bf16_t* O; int ldc; const float* bias;
    __device__ __forceinline__ void operator()(const f32x4 (&acc)[2][2][4][2], const Unit& u, int wr, int wc, int fr, int fq) const {
        const int row0 = u.pm * BM + wr * 64 + fr, col0 = u.pn * BM + wc * 32 + 8 * fq;
#pragma unroll
        for (int ai = 0; ai < 2; ++ai)
#pragma unroll
            for (int m = 0; m < 4; ++m) { const int row = row0 + ai * HALF + m * 16; const float b = bias[row]; bf16_t* rowp = O + (size_t)row * ldc + col0;
#pragma unroll
                for (int bj = 0; bj < 2; ++bj) *(u32x4*)(rowp + bj * HALF) = pack8(acc[ai][bj][m][0] + b, acc[ai][bj][m][1] + b); }
    }
};
struct EpiFilt {
    static constexpr bool PERM = true, AFTER_DRAIN = false;
    bf16_t* O; int ldc; const float* decay;
    __device__ __forceinline__ void operator()(const f32x4 (&acc)[2][2][4][2], const Unit& u, int wr, int wc, int fr, int fq) const {
        const int row0 = u.pm * BM + wr * 64 + fr, col0 = u.pn * BM + wc * 32 + 8 * fq;
#pragma unroll
        for (int ai = 0; ai < 2; ++ai)
#pragma unroll
            for (int m = 0; m < 4; ++m) { const int row = row0 + ai * HALF + m * 16; const float dk = -fabsf(decay[row]) * (1.4426950408889634f / 16383.0f); bf16_t* rowp = O + (size_t)row * ldc + col0;
#pragma unroll
                for (int bj = 0; bj < 2; ++bj) { const float c0 = (float)(col0 + bj * HALF); f32x4 w0, w1;
#pragma unroll
                    for (int e = 0; e < 4; ++e) { w0[e] = __builtin_amdgcn_exp2f((c0 + (float)e) * dk); w1[e] = __builtin_amdgcn_exp2f((c0 + (float)(4 + e)) * dk); }
                    *(u32x4*)(rowp + bj * HALF) = pack8(acc[ai][bj][m][0] * w0, acc[ai][bj][m][1] * w1); } }
    }
};
struct EpiResid {
    static constexpr bool PERM = true, AFTER_DRAIN = false;
    bf16_t* O; int ldc; const bf16_t* x; float alpha;
    __device__ __forceinline__ void operator()(const f32x4 (&acc)[2][2][4][2], const Unit& u, int wr, int wc, int fr, int fq) const {
        const int row0 = u.pm * BM + wr * 64 + fr, col0 = u.pn * BM + wc * 32 + 8 * fq;
#pragma unroll
        for (int ai = 0; ai < 2; ++ai)
#pragma unroll
            for (int m = 0; m < 4; ++m) { const size_t off = (size_t)(row0 + ai * HALF + m * 16) * ldc + col0;
#pragma unroll
                for (int bj = 0; bj < 2; ++bj) { const u32x4 xv = *(const u32x4*)(x + off + bj * HALF);
                    const f32x4 x0 = {__builtin_bit_cast(float, xv.x << 16), __builtin_bit_cast(float, xv.x & 0xffff0000u), __builtin_bit_cast(float, xv.y << 16), __builtin_bit_cast(float, xv.y & 0xffff0000u)};
                    const f32x4 x1 = {__builtin_bit_cast(float, xv.z << 16), __builtin_bit_cast(float, xv.z & 0xffff0000u), __builtin_bit_cast(float, xv.w << 16), __builtin_bit_cast(float, xv.w & 0xffff0000u)};
                    *(u32x4*)(O + off + bj * HALF) = pack8(x0 * alpha + acc[ai][bj][m][0], x1 * alpha + acc[ai][bj][m][1]); } }
    }
};
__device__ __forceinline__ float silu_f(float v) { return v * __builtin_amdgcn_rcpf(1.0f + __builtin_amdgcn_exp2f(-1.4426950408889634f * v)); }
struct EpiSwiGLU {
    static constexpr bool PERM = true, AFTER_DRAIN = false;
    bf16_t* O; int ldc; int nNe;
    __device__ __forceinline__ void operator()(const f32x4 (&acc)[2][2][4][2], const Unit& u, int wr, int wc, int fr, int fq) const {
        const int row0 = u.pm * BM + wr * 64 + fr, pl = u.pn - (u.pm >> 4) * nNe, col0 = pl * HALF + wc * 32 + 8 * fq;
#pragma unroll
        for (int ai = 0; ai < 2; ++ai)
#pragma unroll
            for (int m = 0; m < 4; ++m) { f32x4 h0, h1;
#pragma unroll
                for (int e = 0; e < 4; ++e) { h0[e] = silu_f(acc[ai][0][m][0][e]) * acc[ai][1][m][0][e]; h1[e] = silu_f(acc[ai][0][m][1][e]) * acc[ai][1][m][1][e]; }
                *(u32x4*)(O + (size_t)(row0 + ai * HALF + m * 16) * ldc + col0) = pack8(h0, h1); }
    }
};
struct EpiSwiGLU8 {
    static constexpr bool PERM = true, AFTER_DRAIN = false;
    unsigned char* O; int ldc; int nNe;
    __device__ __forceinline__ void operator()(const f32x4 (&acc)[2][2][4][2], const Unit& u, int wr, int wc, int fr, int fq) const {
        typedef int v2i_ __attribute__((ext_vector_type(2)));
        const int row0 = u.pm * BM + wr * 64 + fr, pl = u.pn - (u.pm >> 4) * nNe, col0 = pl * HALF + wc * 32 + 8 * fq;
#pragma unroll
        for (int ai = 0; ai < 2; ++ai)
#pragma unroll
            for (int m = 0; m < 4; ++m) { float h[8];
#pragma unroll
                for (int e = 0; e < 4; ++e) { h[e] = 8.f * silu_f(acc[ai][0][m][0][e]) * acc[ai][1][m][0][e]; h[4 + e] = 8.f * silu_f(acc[ai][0][m][1][e]) * acc[ai][1][m][1][e]; }
                int w0 = 0, w1 = 0;
                w0 = __builtin_amdgcn_cvt_pk_fp8_f32(h[0], h[1], w0, false); w0 = __builtin_amdgcn_cvt_pk_fp8_f32(h[2], h[3], w0, true);
                w1 = __builtin_amdgcn_cvt_pk_fp8_f32(h[4], h[5], w1, false); w1 = __builtin_amdgcn_cvt_pk_fp8_f32(h[6], h[7], w1, true);
                *(v2i_*)(O + (size_t)(row0 + ai * HALF + m * 16) * ldc + col0) = (v2i_){w0, w1}; }
    }
};
struct EpiRowScale {
    static constexpr bool PERM = true, AFTER_DRAIN = false;
    unsigned char* O; int ldc; const float* gate; int nNe;
    __device__ __forceinline__ void operator()(const f32x4 (&acc)[2][2][4][2], const Unit& u, int wr, int wc, int fr, int fq) const {
        typedef int v2i_ __attribute__((ext_vector_type(2)));
        const int row0 = u.pm * BM + wr * 64 + fr, pl = u.pn - (u.pm >> 4) * nNe, col0 = pl * BM + wc * 32 + 8 * fq;
#pragma unroll
        for (int ai = 0; ai < 2; ++ai)
#pragma unroll
            for (int m = 0; m < 4; ++m) { const int row = row0 + ai * HALF + m * 16; const float g = 64.f * gate[row]; unsigned char* rowp = O + (size_t)row * ldc + col0;
#pragma unroll
                for (int bj = 0; bj < 2; ++bj) { const f32x4 v0 = acc[ai][bj][m][0] * g, v1 = acc[ai][bj][m][1] * g; int w0 = 0, w1 = 0;
                    w0 = __builtin_amdgcn_cvt_pk_fp8_f32(v0[0], v0[1], w0, false); w0 = __builtin_amdgcn_cvt_pk_fp8_f32(v0[2], v0[3], w0, true);
                    w1 = __builtin_amdgcn_cvt_pk_fp8_f32(v1[0], v1[1], w1, false); w1 = __builtin_amdgcn_cvt_pk_fp8_f32(v1[2], v1[3], w1, true);
                    *(v2i_*)(rowp + bj * HALF) = (v2i_){w0, w1}; } }
    }
};
struct GroupedOrder : StaticOrder {
    int nNe;
    __host__ __device__ void initg(int nNe_, int G_, int c_) { nNe = nNe_; init(65536, nNe_ * BM, G_, c_); }
    __host__ __device__ bool next(int i, Unit& u) const { if (!StaticOrder::next(i, u)) return false; u.pn += (u.pm >> 4) * nNe; return true; }
};
}
#ifndef PROBE_SEC
#define PROBE_SEC 0
#endif
#define ATSEC_B(id) do { if (PROBE_SEC == (id)) { t0_ = __builtin_amdgcn_s_memrealtime(); } } while (0)
#define ATSEC_E(id) do { if (PROBE_SEC == (id)) { tacc_ += __builtin_amdgcn_s_memrealtime() - t0_; } } while (0)
namespace att {
using bf16 = unsigned short;
constexpr int D = 128, NW = 8, QBLK = 32, KVBLK = 64; constexpr float SCALE = 0.088388347648318440f; constexpr float THR = 1.f; constexpr int SDEPTH = 2;
constexpr int LDQ = 1536, LDK = 128, LDO = 1024;
constexpr size_t SHM_V = KVBLK * D * 2, SHM_K = KVBLK * D * 2, SHM_ATTN = 8 * (KVBLK * D) + NW * 64 * 4;
using bf16x8 = __attribute__((ext_vector_type(8))) short;
using s16x4  = __attribute__((ext_vector_type(4))) short;
using f32x16 = __attribute__((ext_vector_type(16))) float;
using f32x8  = __attribute__((ext_vector_type(8))) float;
using u32x4  = __attribute__((ext_vector_type(4))) unsigned;
#define KSWZ(row, colB) ((row) * 256 + ((colB) ^ (((row) & 7) << 4)))
#define SBAR() __builtin_amdgcn_sched_barrier(0)
__device__ __forceinline__ int crow(int r, int hi) { return (r & 3) + 8 * (r >> 2) + 4 * hi; }
__device__ __forceinline__ unsigned cvtpk(float lo, float hi) {
  unsigned r; asm volatile("v_cvt_pk_bf16_f32 %0, %1, %2" : "=v"(r) : "v"(lo), "v"(hi)); return r;
}
__device__ __forceinline__ void partialSM(f32x16& p0, f32x16& p1, float& m_reg, float& mn, float& alpha) {
  constexpr float C = SCALE * 1.4426950408889634f;
  float pmax = p0[0]; for (int r = 1; r < 16; ++r) pmax = fmaxf(pmax, p0[r]); for (int r = 0; r < 16; ++r) pmax = fmaxf(pmax, p1[r]);
  { auto rr = __builtin_amdgcn_permlane32_swap(__float_as_uint(pmax), __float_as_uint(pmax), false, false);
    pmax = fmaxf(__uint_as_float(rr[0]), __uint_as_float(rr[1])); }
  if (__builtin_expect(__all(pmax - m_reg <= THR / SCALE), 1)) { mn = m_reg; alpha = 1.f; }
  else { mn = fmaxf(m_reg, pmax); alpha = __builtin_amdgcn_exp2f((m_reg - mn) * C); m_reg = mn; }
  float mnC = 7.0f - mn * C;
  for (int r = 0; r < 16; ++r) p0[r] = fmaf(p0[r], C, mnC); for (int r = 0; r < 16; ++r) p1[r] = fmaf(p1[r], C, mnC);
  for (int r = 0; r < 16; ++r) p0[r] = __builtin_amdgcn_exp2f(p0[r]);
}
__device__ __forceinline__ void finishSM(f32x16& p0, f32x16& p1, float alpha, float& l_reg, bf16x8& pa0, bf16x8& pa1, bf16x8& pa2, bf16x8& pa3) {
  for (int r = 0; r < 16; ++r) p1[r] = __builtin_amdgcn_exp2f(p1[r]);
  float ps = 0; for (int r = 0; r < 16; ++r) ps += p0[r]; for (int r = 0; r < 16; ++r) ps += p1[r];
  { auto rr = __builtin_amdgcn_permlane32_swap(__float_as_uint(ps), __float_as_uint(ps), false, false);
    ps = __uint_as_float(rr[0]) + __uint_as_float(rr[1]); }
  l_reg = l_reg * alpha + ps;
#define PK4(P, BASE, OUT) do { unsigned a0 = cvtpk(P[BASE + 0], P[BASE + 1]), a1 = cvtpk(P[BASE + 2], P[BASE + 3]);   \
    unsigned b0 = cvtpk(P[BASE + 4], P[BASE + 5]), b1 = cvtpk(P[BASE + 6], P[BASE + 7]);                              \
    auto r0 = __builtin_amdgcn_permlane32_swap(a0, b0, false, false); auto r1 = __builtin_amdgcn_permlane32_swap(a1, b1, false, false); \
    u32x4 w = {r0[0], r1[0], r0[1], r1[1]}; OUT = *reinterpret_cast<bf16x8*>(&w); } while (0)
  PK4(p0, 0, pa0); PK4(p0, 8, pa1); PK4(p1, 0, pa2); PK4(p1, 8, pa3);
#undef PK4
}
__device__ __forceinline__ void qkt(f32x16& p0, f32x16& p1, const bf16* Ks, const bf16x8* qr, int r32, int hi) {
  p0 = f32x16{}; p1 = f32x16{};
  __builtin_amdgcn_s_setprio(1);
  for (int d0 = 0; d0 < 8; ++d0) { int cb = (d0 * 16 + hi * 8) * 2;
    bf16x8 b0 = *reinterpret_cast<const bf16x8*>((const char*)Ks + KSWZ(r32, cb));
    bf16x8 b1 = *reinterpret_cast<const bf16x8*>((const char*)Ks + KSWZ(32 + r32, cb));
    p0 = __builtin_amdgcn_mfma_f32_32x32x16_bf16(b0, qr[d0], p0, 0, 0, 0);
    p1 = __builtin_amdgcn_mfma_f32_32x32x16_bf16(b1, qr[d0], p1, 0, 0, 0); }
  __builtin_amdgcn_s_setprio(0);
}
using v8i = __attribute__((ext_vector_type(8))) int;
using v4i = __attribute__((ext_vector_type(4))) int;
constexpr size_t SHM_K8 = KVBLK * D;
__device__ __forceinline__ int k8img(int r, int c) { return r * 128 + ((c ^ ((r >> 1) & 7)) << 4); }
__device__ __forceinline__ v8i ld32(const char* p0, const char* p1) { const v4i a = *reinterpret_cast<const v4i*>(p0), b = *reinterpret_cast<const v4i*>(p1); return __builtin_shufflevector(a, b, 0, 1, 2, 3, 4, 5, 6, 7); }
__device__ __forceinline__ void qkt8(f32x16& p0, f32x16& p1, const char* Ks, const v8i* q8, int r32, int hi, float init) {
#pragma unroll
  for (int r = 0; r < 16; ++r) { p0[r] = init; p1[r] = init; }
  __builtin_amdgcn_s_setprio(1);
#pragma unroll
  for (int s = 0; s < 2; ++s) { const int c = 4 * s + 2 * hi;
    const v8i a0 = ld32(Ks + k8img(r32, c), Ks + k8img(r32, c + 1)), a1 = ld32(Ks + k8img(32 + r32, c), Ks + k8img(32 + r32, c + 1));
    p0 = __builtin_amdgcn_mfma_scale_f32_32x32x64_f8f6f4(a0, q8[s], p0, 0, 0, 0, 0x7f7f7f7f, 0, 0x7c7c7c7c);
    p1 = __builtin_amdgcn_mfma_scale_f32_32x32x64_f8f6f4(a1, q8[s], p1, 0, 0, 0, 0x7f7f7f7f, 0, 0x7c7c7c7c); }
  __builtin_amdgcn_s_setprio(0);
}
template <bool FIRST> __device__ __forceinline__ void partialSM8(f32x16& p0, f32x16& p1, float& m2, float& alpha) {
  constexpr float THR2 = THR * 1.4426950408889634f;
  float pmax = p0[0]; for (int r = 1; r < 16; ++r) pmax = fmaxf(pmax, p0[r]); for (int r = 0; r < 16; ++r) pmax = fmaxf(pmax, p1[r]);
  { auto rr = __builtin_amdgcn_permlane32_swap(__float_as_uint(pmax), __float_as_uint(pmax), false, false);
    pmax = fmaxf(__uint_as_float(rr[0]), __uint_as_float(rr[1])); }
  if (!FIRST && __builtin_expect(__all(pmax <= 7.0f + THR2), 1)) { alpha = 1.f; }
  else { const float d = FIRST ? pmax - 7.0f : fmaxf(pmax - 7.0f, 0.f); alpha = FIRST ? 0.f : __builtin_amdgcn_exp2f(-d); m2 += d;
    for (int r = 0; r < 16; ++r) p0[r] -= d; for (int r = 0; r < 16; ++r) p1[r] -= d; }
  for (int r = 0; r < 16; ++r) p0[r] = __builtin_amdgcn_exp2f(p0[r]);
}
__device__ __forceinline__ int v8img(int c, int q) { return c * 64 + ((q ^ ((c >> 2) & 3)) << 4); }
__device__ __forceinline__ void finishSM8(f32x16& p0, f32x16& p1, v8i& pa) {
  for (int r = 0; r < 16; ++r) p1[r] = __builtin_amdgcn_exp2f(p1[r]);
  int w[8];
#pragma unroll
  for (int i = 0; i < 4; ++i) { int a = 0, b = 0;
    a = __builtin_amdgcn_cvt_pk_fp8_f32(p0[4 * i], p0[4 * i + 1], a, false); a = __builtin_amdgcn_cvt_pk_fp8_f32(p0[4 * i + 2], p0[4 * i + 3], a, true);
    b = __builtin_amdgcn_cvt_pk_fp8_f32(p1[4 * i], p1[4 * i + 1], b, false); b = __builtin_amdgcn_cvt_pk_fp8_f32(p1[4 * i + 2], p1[4 * i + 3], b, true);
    w[i] = a; w[4 + i] = b; }
  pa = (v8i){w[0], w[1], w[2], w[3], w[4], w[5], w[6], w[7]};
}
using f32x4_ = __attribute__((ext_vector_type(4))) float;
__device__ __forceinline__ void pv8(f32x16* o, f32x4_& l4, const char* Vs, const v8i& pa, const v8i& bsel, int r32, int hi) {
  l4 = __builtin_amdgcn_mfma_scale_f32_16x16x128_f8f6f4(pa, bsel, l4, 0, 0, 0, 0x7f7f7f7f, 0, 0x7f7f7f7f);
#pragma unroll
  for (int d0 = 0; d0 < 4; ++d0) { const int c = 32 * d0 + r32;
    const v8i b = ld32(Vs + v8img(c, 2 * hi), Vs + v8img(c, 2 * hi + 1));
    o[d0] = __builtin_amdgcn_mfma_scale_f32_32x32x64_f8f6f4(pa, b, o[d0], 0, 0, 0, 0x7f7f7f7f, 0, 0x7d7d7d7d); }
}
#define ATT_SB() __builtin_amdgcn_sched_barrier(0)
#define ATT_CVT4(P, I) ({ int a_; asm volatile("" : "=v"(a_)); a_ = __builtin_amdgcn_cvt_pk_fp8_f32(P[4 * (I)], P[4 * (I) + 1], a_, false); a_ = __builtin_amdgcn_cvt_pk_fp8_f32(P[4 * (I) + 2], P[4 * (I) + 3], a_, true); a_; })
#define ATT_EXP4(P, I) do { P[4 * (I)] = __builtin_amdgcn_exp2f(P[4 * (I)]); P[4 * (I) + 1] = __builtin_amdgcn_exp2f(P[4 * (I) + 1]); P[4 * (I) + 2] = __builtin_amdgcn_exp2f(P[4 * (I) + 2]); P[4 * (I) + 3] = __builtin_amdgcn_exp2f(P[4 * (I) + 3]); } while (0)
__device__ __forceinline__ float att_max3(float a, float b, float c) { float r; asm("v_max3_f32 %0, %1, %2, %3" : "=v"(r) : "v"(a), "v"(b), "v"(c)); return r; }
#define ATT_MAX16(P, MA, MB) do { MA = att_max3(P[0], P[1], P[2]); MB = att_max3(P[9], P[10], P[11]); MA = att_max3(MA, P[3], P[4]); MB = att_max3(MB, P[12], P[13]); MA = att_max3(MA, P[5], P[6]); MB = att_max3(MB, P[14], P[15]); MA = att_max3(MA, P[7], P[8]); } while (0)
#define ATT_MF "v_mfma_scale_f32_32x32x64_f8f6f4 %[acc], %[a], %[b], %[acc], %[sa], %[sb] op_sel_hi:[0,0,0]"
template <bool PREF, bool DK, bool DV>
__device__ __forceinline__ void att_step(f32x16& c0, f32x16& c1, f32x16& q0, f32x16& q1, float& m2, float& alpha, f32x16& ci, f32x16* o, f32x4_& l4, v8i& ka0, v8i& ka1,
                                         const char* Ks, const char* Vs, const char* Kn, const v8i* q8, const v8i& bsel, const int (&kofs)[4], const int (&vofs)[2],
                                         const unsigned char* kg, const unsigned char* vg, unsigned kd, unsigned vd, unsigned koff, unsigned voff) {
  constexpr float THR2 = THR * 1.4426950408889634f;
  const int s1 = 0x7f7f7f7f, sq = 0x7c7c7c7c, sv = 0x7d7d7d7d;
  const v8i a0 = ka0, a1 = ka1;
  asm volatile("v_mfma_scale_f32_32x32x64_f8f6f4 %[d], %[a], %[b], %[c], %[sa], %[sb] op_sel_hi:[0,0,0]"
               : [d] "=&v"(c0), "+v"(q0), "+v"(q1) : [a] "v"(a0), [b] "v"(q8[0]), [c] "v"(ci), [sa] "v"(s1), [sb] "v"(sq) : "memory"); ATT_SB();
  if constexpr (DK) asm volatile("s_mov_b32 m0, %2\n\ts_nop 0\n\tglobal_load_lds_dwordx4 %0, %1" :: "v"(koff), "s"(kg), "s"(kd) : "memory");
  if constexpr (DV) asm volatile("s_mov_b32 m0, %2\n\ts_nop 0\n\tglobal_load_lds_dwordx4 %0, %1" :: "v"(voff), "s"(vg), "s"(vd) : "memory");
  const v8i b0 = ld32(Ks + kofs[2], Ks + kofs[3]), b1 = ld32(Ks + kofs[2] + 4096, Ks + kofs[3] + 4096);
  ATT_EXP4(q1, 0); int w0 = ATT_CVT4(q0, 0);
  asm volatile("v_mfma_scale_f32_32x32x64_f8f6f4 %[d], %[a], %[b], %[c], %[sa], %[sb] op_sel_hi:[0,0,0]"
               : [d] "=&v"(c1), "+v"(q0), "+v"(q1), "+v"(w0) : [a] "v"(a1), [b] "v"(q8[0]), [c] "v"(ci), [sa] "v"(s1), [sb] "v"(sq) : "memory"); ATT_SB();
  ATT_EXP4(q1, 1); int w1 = ATT_CVT4(q0, 1), w2 = ATT_CVT4(q0, 2);
  asm volatile(ATT_MF : [acc] "+v"(c0), "+v"(q0), "+v"(q1), "+v"(w1), "+v"(w2) : [a] "v"(b0), [b] "v"(q8[1]), [sa] "v"(s1), [sb] "v"(sq) : "memory"); ATT_SB();
  const v8i v0 = ld32(Vs + vofs[0], Vs + vofs[1]), v1 = ld32(Vs + vofs[0] + 2048, Vs + vofs[1] + 2048);
  ATT_EXP4(q1, 2); int w3 = ATT_CVT4(q0, 3), w4 = ATT_CVT4(q1, 0);
  asm volatile(ATT_MF : [acc] "+v"(c1), "+v"(q1), "+v"(w3), "+v"(w4) : [a] "v"(b1), [b] "v"(q8[1]), [sa] "v"(s1), [sb] "v"(sq) : "memory"); ATT_SB();
  ATT_EXP4(q1, 3); const int w5 = ATT_CVT4(q1, 1), w6 = ATT_CVT4(q1, 2), w7 = ATT_CVT4(q1, 3);
  v8i pa = (v8i){w0, w1, w2, w3, w4, w5, w6, w7};
  asm volatile("s_nop 1\n\tv_mfma_scale_f32_16x16x128_f8f6f4 %[acc], %[a], %[b], %[acc], %[sa], %[sb] op_sel_hi:[0,0,0]"
               : [acc] "+v"(l4), "+v"(c0) : [a] "v"(pa), [b] "v"(bsel), [sa] "v"(s1), [sb] "v"(s1) : "memory"); ATT_SB();
  const v8i v2 = ld32(Vs + vofs[0] + 4096, Vs + vofs[1] + 4096);
  float pm0, pm0b; ATT_MAX16(c0, pm0, pm0b);
  asm volatile(ATT_MF : [acc] "+v"(o[0]), "+v"(pm0), "+v"(pm0b), "+v"(c1) : [a] "v"(pa), [b] "v"(v0), [sa] "v"(s1), [sb] "v"(sv) : "memory"); ATT_SB();
  const v8i v3 = ld32(Vs + vofs[0] + 6144, Vs + vofs[1] + 6144);
  float pm1, pm1b; ATT_MAX16(c1, pm1, pm1b);
  asm volatile(ATT_MF : [acc] "+v"(o[1]), "+v"(pm1), "+v"(pm1b) : [a] "v"(pa), [b] "v"(v1), [sa] "v"(s1), [sb] "v"(sv) : "memory"); ATT_SB();
  float pmax = fmaxf(att_max3(pm0, pm0b, pm1), pm1b);
  { auto rr = __builtin_amdgcn_permlane32_swap(__float_as_uint(pmax), __float_as_uint(pmax), false, false); pmax = fmaxf(__uint_as_float(rr[0]), __uint_as_float(rr[1])); }
  if (__builtin_expect(__all(pmax <= 7.0f + THR2), 1)) { alpha = 1.f; }
  else { const float d = fmaxf(pmax - 7.0f, 0.f); alpha = __builtin_amdgcn_exp2f(-d); m2 += d; const float init = 7.0f - m2;
#pragma unroll
    for (int r = 0; r < 16; ++r) { c0[r] -= d; c1[r] -= d; ci[r] = init; } }
  asm volatile(ATT_MF : [acc] "+v"(o[2]), "+v"(c0) : [a] "v"(pa), [b] "v"(v2), [sa] "v"(s1), [sb] "v"(sv) : "memory"); ATT_SB();
  if constexpr (PREF) { ka0 = ld32(Kn + kofs[0], Kn + kofs[1]); ka1 = ld32(Kn + kofs[0] + 4096, Kn + kofs[1] + 4096); }
  ATT_EXP4(c0, 0); ATT_EXP4(c0, 1);
  asm volatile(ATT_MF : [acc] "+v"(o[3]), "+v"(c0) : [a] "v"(pa), [b] "v"(v3), [sa] "v"(s1), [sb] "v"(sv) : "memory"); ATT_SB();
  ATT_EXP4(c0, 2); ATT_EXP4(c0, 3);
  asm volatile("" : "+v"(c0)); ATT_SB();
}
__device__ __forceinline__ int v_st(int k, int c) { const int kk = (k & ~0xC) | ((k & 4) << 1) | ((k & 8) >> 1); return ((kk >> 3) * 4 + (c >> 5)) * 512 + ((kk & 7) * 32 + (c & 31)) * 2; }
__device__ __forceinline__ int v_rd_base(int lane) { return ((lane & 3) << 3) | (((lane >> 2) & 3) << 6) | (((lane >> 4) & 1) << 5) | (((lane >> 5) & 1) << 8); }
constexpr int v_rd_off(int d0, int ks, int half) { return d0 * 512 + ks * 4096 + half * 2048; }
template <int OFF> __device__ __forceinline__ s16x4 tr_read(int vb) {
  s16x4 r; asm volatile("ds_read_b64_tr_b16 %0, %1 offset:%2" : "=&v"(r) : "v"(vb), "i"(OFF) : "memory"); return r;
}
template <int D0> __device__ __forceinline__ void pv_one(f32x16& od, int vb, bf16x8 pa0, bf16x8 pa1, bf16x8 pa2, bf16x8 pa3) {
  const s16x4 l0 = tr_read<v_rd_off(D0, 0, 0)>(vb), h0 = tr_read<v_rd_off(D0, 0, 1)>(vb), l1 = tr_read<v_rd_off(D0, 1, 0)>(vb), h1 = tr_read<v_rd_off(D0, 1, 1)>(vb);
  const s16x4 l2 = tr_read<v_rd_off(D0, 2, 0)>(vb), h2 = tr_read<v_rd_off(D0, 2, 1)>(vb), l3 = tr_read<v_rd_off(D0, 3, 0)>(vb), h3 = tr_read<v_rd_off(D0, 3, 1)>(vb);
  asm volatile("s_waitcnt lgkmcnt(0)" ::: "memory"); SBAR();
#define PK(L, H) (bf16x8){L[0], L[1], L[2], L[3], H[0], H[1], H[2], H[3]}
  od = __builtin_amdgcn_mfma_f32_32x32x16_bf16(pa0, PK(l0, h0), od, 0, 0, 0);
  od = __builtin_amdgcn_mfma_f32_32x32x16_bf16(pa1, PK(l1, h1), od, 0, 0, 0);
  od = __builtin_amdgcn_mfma_f32_32x32x16_bf16(pa2, PK(l2, h2), od, 0, 0, 0);
  od = __builtin_amdgcn_mfma_f32_32x32x16_bf16(pa3, PK(l3, h3), od, 0, 0, 0);
#undef PK
}
__device__ __forceinline__ void pv_d0(f32x16* o, int vb, bf16x8 pa0, bf16x8 pa1, bf16x8 pa2, bf16x8 pa3) {
  pv_one<0>(o[0], vb, pa0, pa1, pa2, pa3); pv_one<1>(o[1], vb, pa0, pa1, pa2, pa3); pv_one<2>(o[2], vb, pa0, pa1, pa2, pa3); pv_one<3>(o[3], vb, pa0, pa1, pa2, pa3);
}
__device__ __forceinline__ void attn_unit(const bf16* __restrict__ Qb, int l0, const float* __restrict__ qn, const unsigned char* __restrict__ Kh, const unsigned char* __restrict__ Vh,
                                          bf16* __restrict__ Ob, int seq, char* lds) {
  int tid_ = threadIdx.x; asm volatile("" : "+v"(tid_));
  const int tid = tid_, wid = tid >> 6, lane = tid & 63, r32 = lane & 31, hi = lane >> 5;
  char* V_lds = lds; char* K_lds = lds + 4 * SHM_K8;
  float* ws = (float*)(lds + 8 * SHM_K8) + wid * 64; float* li_l = ws; float* al_l = ws + 32;
  float m_reg = 0.f; f32x4_ l4 = {0.f, 0.f, 0.f, 0.f}; f32x16 o[4] = {}; v8i q8[2];
  {
    const bf16* Qw = Qb + (long)(wid * QBLK + r32) * LDQ + hi * 32;
    const int lpos = l0 + wid * QBLK + r32; const float prow = (float)(lpos >> 6), pcol = (float)(lpos & 63);
    bf16x8 qraw[2][4]; float ss = 0.f;
#pragma unroll
    for (int s_ = 0; s_ < 2; ++s_)
#pragma unroll
      for (int c = 0; c < 4; ++c) { qraw[s_][c] = *reinterpret_cast<const bf16x8*>(Qw + 64 * s_ + 8 * c);
#pragma unroll
        for (int e = 0; e < 8; ++e) { const float v = __uint_as_float(((unsigned)(unsigned short)qraw[s_][c][e]) << 16); ss += v * v; } }
    ss += __shfl_xor(ss, 32);
    const float rs = 1.0201391f / sqrtf(ss * (1.0f / 128.0f) + 1e-6f);
#pragma unroll
    for (int s_ = 0; s_ < 2; ++s_) { int w[8];
#pragma unroll
      for (int c = 0; c < 4; ++c) { const int d = 64 * s_ + 32 * hi + 8 * c;
        const float4 g0 = *reinterpret_cast<const float4*>(qn + d), g1 = *reinterpret_cast<const float4*>(qn + d + 4);
        const float gg[8] = {g0.x, g0.y, g0.z, g0.w, g1.x, g1.y, g1.z, g1.w}; float r8[8];
#pragma unroll
        for (int e2 = 0; e2 < 4; ++e2) {
          const float x0 = __uint_as_float(((unsigned)(unsigned short)qraw[s_][c][2 * e2]) << 16) * rs * gg[2 * e2], x1 = __uint_as_float(((unsigned)(unsigned short)qraw[s_][c][2 * e2 + 1]) << 16) * rs * gg[2 * e2 + 1];
          const int i = 32 * s_ + 16 * hi + 4 * c + e2, j = i & 31;
          const float inv = __builtin_amdgcn_exp2f(-(float)j * (13.287712379549449f / 32.0f));
          const float rev = (s_ == 0 ? prow : pcol) * inv * 0.15915494309189535f;
          const float cc = __builtin_amdgcn_cosf(rev), sn_ = __builtin_amdgcn_sinf(rev);
          r8[2 * e2] = x0 * cc - x1 * sn_; r8[2 * e2 + 1] = x0 * sn_ + x1 * cc; }
        int w0 = 0, w1 = 0;
        w0 = __builtin_amdgcn_cvt_pk_fp8_f32(r8[0], r8[1], w0, false); w0 = __builtin_amdgcn_cvt_pk_fp8_f32(r8[2], r8[3], w0, true);
        w1 = __builtin_amdgcn_cvt_pk_fp8_f32(r8[4], r8[5], w1, false); w1 = __builtin_amdgcn_cvt_pk_fp8_f32(r8[6], r8[7], w1, true);
        w[2 * c] = w0; w[2 * c + 1] = w1; }
      q8[s_] = (v8i){w[0], w[1], w[2], w[3], w[4], w[5], w[6], w[7]}; }
  }
  const int wu = __builtin_amdgcn_readfirstlane(wid);
  const int lrow = (16 * (lane & 15) + 4 * (lane >> 4)) & 31;
  v8i bsel; { const int c_ = ((lane & 15) < 2 && ((lane >> 4) & 1) == (lane & 15)) ? 0x38383838 : 0; bsel = (v8i){c_, c_, c_, c_, c_, c_, c_, c_}; asm volatile("" : "+v"(bsel)); }
  unsigned koff; const unsigned voff = (unsigned)(wu * 1024 + 16 * lane);
  { const int row = 8 * wu + (lane >> 3), pos = lane & 7; koff = (unsigned)(row * 128 + ((pos ^ ((row >> 1) & 7)) << 4)); }
  const unsigned kdst = (unsigned)(size_t)K_lds + (unsigned)(wu * 1024), vdst = (unsigned)(size_t)V_lds + (unsigned)(wu * 1024);
#define DMA_K(slot, key0) asm volatile("s_mov_b32 m0, %2\n\ts_nop 0\n\tglobal_load_lds_dwordx4 %0, %1" :: "v"(koff), "s"(Kh + (size_t)(key0) * 128), "s"(kdst + (unsigned)((slot) * SHM_K8)) : "memory")
#define DMA_V(slot, key0) asm volatile("s_mov_b32 m0, %2\n\ts_nop 0\n\tglobal_load_lds_dwordx4 %0, %1" :: "v"(voff), "s"(Vh + (size_t)(key0) * 128), "s"(vdst + (unsigned)((slot) * SHM_K8)) : "memory")
#define DMA_BAR(n) asm volatile("s_waitcnt vmcnt(" #n ") lgkmcnt(0)\n\ts_barrier" ::: "memory")
#define RESC(a) do { if (__any((a) < 1.f)) { if (hi == 0) al_l[r32] = (a); asm volatile("s_nop 15\n\ts_nop 15\n\ts_nop 15\n\ts_waitcnt lgkmcnt(0)" ::: "memory"); \
    for (int d = 0; d < 4; ++d) for (int r = 0; r < 16; ++r) o[d][r] *= al_l[crow(r, hi)]; l4 *= *reinterpret_cast<const f32x4_*>(al_l + lrow); } } while (0)
#define KSLOT(s) (K_lds + (s) * SHM_K8)
#define VSLOT(s) (V_lds + (s) * SHM_K8)
  f32x16 pA0, pA1, pB0, pB1; float mnA, mnB, alA, alB; v8i pa; const int NT = seq / KVBLK;
  DMA_K(0, 0); DMA_K(1, KVBLK); DMA_V(0, 0); DMA_K(2, 2 * KVBLK); DMA_V(1, KVBLK); DMA_K(3, 3 * KVBLK);
  DMA_BAR(3);
  qkt8(pA0, pA1, KSLOT(0), q8, r32, hi, 7.0f); partialSM8<true>(pA0, pA1, m_reg, alA);
  f32x16 ci; const int kofs[4] = {k8img(r32, 2 * hi), k8img(r32, 2 * hi + 1), k8img(r32, 4 + 2 * hi), k8img(r32, 5 + 2 * hi)}, vofs[2] = {v8img(r32, 2 * hi), v8img(r32, 2 * hi + 1)};
  v8i ka0 = ld32(KSLOT(1) + kofs[0], KSLOT(1) + kofs[1]), ka1 = ld32(KSLOT(1) + kofs[0] + 4096, KSLOT(1) + kofs[1] + 4096);
  DMA_BAR(2);
#pragma unroll
  for (int r = 0; r < 16; ++r) ci[r] = 7.0f - m_reg;
#define ATT_STEP(t_, S_, CUR0, CUR1, PRV0, PRV1, ALC, PREF_, DK_, DV_, WAITN) do { SBAR(); \
    att_step<PREF_, DK_, DV_>(CUR0, CUR1, PRV0, PRV1, m_reg, ALC, ci, o, l4, ka0, ka1, KSLOT(S_), VSLOT(((S_) + 3) & 3), KSLOT(((S_) + 1) & 3), q8, bsel, kofs, vofs, \
        Kh + (size_t)((t_) + 3) * (KVBLK * 128), Vh + (size_t)((t_) + 1) * (KVBLK * 128), kdst + (unsigned)((((S_) + 3) & 3) * SHM_K8), vdst + (unsigned)((((S_) + 1) & 3) * SHM_K8), koff, voff); \
    RESC(ALC); DMA_BAR(WAITN); } while (0)
  int j = 1;
  for (; j + 3 < NT - 2; j += 4) {
    ATT_STEP(j,     1, pB0, pB1, pA0, pA1, alB, true, true, true, 2);
    ATT_STEP(j + 1, 2, pA0, pA1, pB0, pB1, alA, true, true, true, 2);
    ATT_STEP(j + 2, 3, pB0, pB1, pA0, pA1, alB, true, true, true, 2);
    ATT_STEP(j + 3, 0, pA0, pA1, pB0, pB1, alA, true, true, true, 2);
  }
  ATT_STEP(j,     1, pB0, pB1, pA0, pA1, alB, true, false, true, 0);
  ATT_STEP(j + 1, 2, pA0, pA1, pB0, pB1, alA, false, false, true, 0);
#undef ATT_STEP
  SBAR(); qkt8(pB0, pB1, KSLOT((NT - 1) & 3), q8, r32, hi, 7.0f - m_reg);
  finishSM8(pA0, pA1, pa); SBAR();
  pv8(o, l4, VSLOT((NT - 2) & 3), pa, bsel, r32, hi); partialSM8<false>(pB0, pB1, m_reg, alB);
  RESC(alB);
  finishSM8(pB0, pB1, pa); SBAR();
  pv8(o, l4, VSLOT((NT - 1) & 3), pa, bsel, r32, hi);
#undef KSLOT
#undef VSLOT
#undef DMA_K
#undef DMA_V
#undef DMA_BAR
  if ((lane & 15) < 2) *reinterpret_cast<f32x4_*>(li_l + lrow) = l4; asm volatile("s_waitcnt lgkmcnt(0)" ::: "memory");
  float rli[16];
#pragma unroll
  for (int r = 0; r < 16; ++r) rli[r] = __builtin_amdgcn_rcpf(li_l[crow(r, hi)]);
  bf16* Ow = Ob + (long)(wid * QBLK) * LDO;
#pragma unroll
  for (int r = 0; r < 16; ++r) { int orow = crow(r, hi);
    for (int d0 = 0; d0 < 4; ++d0) { const float v = o[d0][r] * rli[r]; unsigned u = __float_as_uint(v); u = (u + 0x7fffu + ((u >> 16) & 1u)) >> 16; Ow[(long)orow * LDO + d0 * 32 + r32] = (bf16)u; } }
  __syncthreads();
#undef RESC
}
#undef KSWZ
#undef SBAR
}
#define HD __device__ __forceinline__
#define HY_COSREV(x) __builtin_amdgcn_cosf(x)
#define HY_SINREV(x) __builtin_amdgcn_sinf(x)
#define HY_OPAQUE(x) asm volatile("" : "+v"(x))
#define HY_OPAQUE2(w) asm volatile("" : "+v"(w.x), "+v"(w.y))
#define HY_FENCE() asm volatile("" ::: "memory")
#define HY_SCHED() __builtin_amdgcn_sched_barrier(0)
#define HY_PIN2(w) asm volatile("" : "+v"(w.x), "+v"(w.y))
#ifndef HD
#define HD __device__ __forceinline__
#endif
typedef float f2 __attribute__((ext_vector_type(2)));
constexpr int HY_P = 8192, HY_L = 16384, HY_BUF = 8704;
HD int hy_pidx(int p) { return p + 2 * (p >> 5); }
HD f2 cmul(f2 a, f2 w) { return (f2){a.x * w.x - a.y * w.y, a.x * w.y + a.y * w.x}; }
HD f2 cmulc(f2 a, f2 w) { return (f2){a.x * w.x + a.y * w.y, a.y * w.x - a.x * w.y}; }
template <int DIR> HD f2 hy_mi(f2 a) { return DIR > 0 ? (f2){a.y, -a.x} : (f2){-a.y, a.x}; }
HD f2 hy_cis(float rev) { return (f2){HY_COSREV(rev), HY_SINREV(rev)}; }
HD float hy_bf(unsigned short u) { return __builtin_bit_cast(float, (unsigned)u << 16); }
HD unsigned hy_f2bf(float f) { unsigned u = __builtin_bit_cast(unsigned, f); return (u + 0x7fffu + ((u >> 16) & 1u)) >> 16; }
HD f2 hy_unpack(unsigned w) { return (f2){__builtin_bit_cast(float, w << 16), __builtin_bit_cast(float, w & 0xffff0000u)}; }
HD unsigned hy_pack(f2 v) { return hy_f2bf(v.x) | (hy_f2bf(v.y) << 16); }

template <int DIR> HD void hy_r4(f2& x0, f2& x1, f2& x2, f2& x3) {
    const f2 s02 = x0 + x2, d02 = x0 - x2, s13 = x1 + x3, d13 = hy_mi<DIR>(x1 - x3);
    x0 = s02 + s13; x1 = d02 + d13; x2 = s02 - s13; x3 = d02 - d13;
}
template <int DIR> HD void hy_dft16(f2 (&x)[16]) {
#pragma unroll
    for (int b = 0; b < 4; ++b) hy_r4<DIR>(x[b], x[4 + b], x[8 + b], x[12 + b]);
    constexpr float C1 = 0.92387953251128674f, S1 = 0.38268343236508977f, H = 0.70710678118654752f;
#define HY_TW(idx, cr, ci) x[idx] = cmul(x[idx], (f2){(cr), DIR > 0 ? (ci) : -(ci)})
    HY_TW(5, C1, -S1); HY_TW(9, H, -H); HY_TW(13, S1, -C1);
    HY_TW(6, H, -H); x[10] = hy_mi<DIR>(x[10]); HY_TW(14, -H, -H);
    HY_TW(7, S1, -C1); HY_TW(11, -H, -H); HY_TW(15, -C1, S1);
#undef HY_TW
#pragma unroll
    for (int c = 0; c < 4; ++c) hy_r4<DIR>(x[4 * c], x[4 * c + 1], x[4 * c + 2], x[4 * c + 3]);
}
#define HY_OUT(k) (4 * ((k) & 3) + ((k) >> 2))
template <int SL> HD constexpr int hy_koff(int k) { return SL >= 5 ? k * ((1 << SL) + (1 << (SL - 4))) : k * (1 << SL); }
template <int SL> HD int hy_pbase(int t) { const int blk = t >> SL, n0 = t & ((1 << SL) - 1); return hy_pidx((blk << (SL + 4)) + n0); }
template <int SL> HD void hy_fwd1(f2* X, int t, f2 w1) {
    HY_OPAQUE(t); HY_OPAQUE2(w1);
    const int pb = hy_pbase<SL>(t);
    f2 x[16];
#pragma unroll
    for (int k = 0; k < 16; ++k) x[k] = X[pb + hy_koff<SL>(k)];
    hy_dft16<1>(x);
    X[pb] = x[0];
    f2 w = w1;
#pragma unroll
    for (int k0 = 1; k0 < 16; ++k0) { X[pb + hy_koff<SL>(k0)] = cmul(x[HY_OUT(k0)], w); if (k0 < 15) w = cmul(w, w1); }
}
template <int SL> HD void hy_inv1(f2* X, int t, f2 w1) {
    HY_OPAQUE(t); HY_OPAQUE2(w1);
    const int pb = hy_pbase<SL>(t);
    f2 x[16];
    x[0] = X[pb];
    f2 w = w1;
#pragma unroll
    for (int k0 = 1; k0 < 16; ++k0) { x[k0] = cmulc(X[pb + hy_koff<SL>(k0)], w); if (k0 < 15) w = cmul(w, w1); }
    hy_dft16<-1>(x);
#pragma unroll
    for (int n1 = 0; n1 < 16; ++n1) X[pb + hy_koff<SL>(n1)] = x[HY_OUT(n1)];
}
HD f2 hy_cr(int R) { return R == 0 ? (f2){1.f, 0.f} : R == 1 ? (f2){0.f, -1.f} : R == 2 ? (f2){-1.f, 0.f} : (f2){0.f, 1.f}; }
HD void hy_s1_store(f2* X, int t, f2 (&x)[16], f2 w1) {
    const int pb = hy_pidx(t);
    X[pb] = x[0];
    f2 w = w1;
#pragma unroll
    for (int k0 = 1; k0 < 16; ++k0) { X[pb + hy_koff<9>(k0)] = cmul(x[HY_OUT(k0)], w); if (k0 < 15) w = cmul(w, w1); }
}
HD void hy_stage1A(f2* X, int t, int R, const unsigned short* hf, const unsigned short* hb, f2 w1) {
    HY_OPAQUE(t); HY_OPAQUE2(w1);
    const f2 cr = hy_cr(R); const float c2 = (R & 1) ? -1.f : 1.f;
    f2 x[16];
#pragma unroll
    for (int n1 = 0; n1 < 16; ++n1) {
        const int np = t + 512 * n1;
        const float g0 = hy_bf(hf[np]), g1 = hy_bf(hf[np + HY_P]), g2 = hy_bf(hb[np ? HY_L - np : 0]) * (np ? 1.f : 0.f), g3 = hy_bf(hb[HY_P - np]);
        x[n1] = cmul((f2){g0 + c2 * g2 + (g1 + g3) * cr.x, (g1 - g3) * cr.y}, hy_cis(-(float)(R * np) * (1.0f / 32768.0f)));
        if ((n1 & 3) == 3) HY_FENCE();
    }
    hy_dft16<1>(x);
    hy_s1_store(X, t, x, w1);
}
HD void hy_stage1B(f2* X, int t, int R, const unsigned* zp  , f2 w1) {
    HY_OPAQUE(t); HY_OPAQUE2(w1);
    const f2 cr = hy_cr(R);
    f2 x[16];
#pragma unroll
    for (int n1 = 0; n1 < 16; ++n1) {
        unsigned q0 = zp[(2 * n1) * 512 + t], q1 = zp[(2 * n1 + 1) * 512 + t];
        const f2 z0 = hy_unpack(q0), z1 = hy_unpack(q1);
        x[n1] = cmul(z0 + cmul(z1, cr), hy_cis(-(float)(R * (t + 512 * n1)) * (1.0f / 32768.0f)));
    }
    hy_dft16<1>(x);
    hy_s1_store(X, t, x, w1);
}
HD f2 hy_w32(int k) {
    constexpr float c[16] = {1.f, 0.98078528040323043f, 0.92387953251128674f, 0.83146961230254524f, 0.70710678118654752f, 0.55557023301960218f, 0.38268343236508977f, 0.19509032201612825f,
                             0.f, -0.19509032201612825f, -0.38268343236508977f, -0.55557023301960218f, -0.70710678118654752f, -0.83146961230254524f, -0.92387953251128674f, -0.98078528040323043f};
    constexpr float sn[16] = {0.f, 0.19509032201612825f, 0.38268343236508977f, 0.55557023301960218f, 0.70710678118654752f, 0.83146961230254524f, 0.92387953251128674f, 0.98078528040323043f,
                              1.f, 0.98078528040323043f, 0.92387953251128674f, 0.83146961230254524f, 0.70710678118654752f, 0.55557023301960218f, 0.38268343236508977f, 0.19509032201612825f};
    return (f2){c[k], -sn[k]}; }
HD void hy_fwd3(const f2* X, int t, f2 (&x)[16]) {
    const int pb = hy_pbase<1>(t), n0 = t & 1;
#pragma unroll
    for (int k = 0; k < 16; ++k) x[k] = X[pb + 2 * k];
    hy_dft16<1>(x);
#pragma unroll
    for (int k0 = 1; k0 < 16; ++k0) x[HY_OUT(k0)] = cmul(x[HY_OUT(k0)], n0 ? hy_w32(k0) : (f2){1.f, 0.f});
}
template <class XCH> HD void hy_s3_fin(f2* X, int t, f2 (&xb)[16], const unsigned (&gp)[16], const XCH& P) {
    const int n0 = t & 1; const float sg = n0 ? -1.f : 1.f; const int pb = hy_pbase<1>(t);
#pragma unroll
    for (int k0 = 0; k0 < 16; ++k0) {
        const f2 a = hy_unpack(gp[HY_OUT(k0)]), b = xb[HY_OUT(k0)], qa = hy_unpack(P.a(HY_OUT(k0))), qb = P.b(HY_OUT(k0));
        const f2 y0 = cmul(b + qb, a + qa), y1 = cmul(b - qb, a - qa);
        const f2 yy = y0 + y1 * sg;
        xb[HY_OUT(k0)] = k0 ? cmulc(yy, n0 ? hy_w32(k0) : (f2){1.f, 0.f}) : yy;
        HY_PIN2(xb[HY_OUT(k0)]);
    }
    f2 y[16];
#pragma unroll
    for (int k0 = 0; k0 < 16; ++k0) y[k0] = xb[HY_OUT(k0)];
    hy_dft16<-1>(y);
#pragma unroll
    for (int n1 = 0; n1 < 16; ++n1) X[pb + 2 * n1] = y[HY_OUT(n1)];
}
HD void hy_inv1_acc(const f2* X, int t, int R, f2 w1, f2 (&yacc)[16][2]) {
    HY_OPAQUE(t); HY_OPAQUE2(w1);
    const f2 cr = hy_cr(R);
    const int pb = hy_pidx(t);
    f2 x[16];
    x[0] = X[pb];
    f2 w = w1;
#pragma unroll
    for (int k0 = 1; k0 < 16; ++k0) { x[k0] = cmulc(X[pb + hy_koff<9>(k0)], w); if (k0 < 15) w = cmul(w, w1); }
    hy_dft16<-1>(x);
#pragma unroll
    for (int n1 = 0; n1 < 16; ++n1) {
        const f2 v = cmul(x[HY_OUT(n1)], hy_cis((float)(R * (t + 512 * n1)) * (1.0f / 32768.0f)));
        yacc[n1][0] += v;
        yacc[n1][1] += cmulc(v, cr);
        HY_PIN2(yacc[n1][0]); HY_PIN2(yacc[n1][1]);
    }
}
HD f2 hy_sconv(const unsigned short* row, int n, float w0, float w1, float w2, float cb) {
    const int nm = n > 0 ? n - 1 : 0, np = n < HY_L - 1 ? n + 1 : HY_L - 1;
    const float wm = n > 0 ? w0 : 0.f, wp = n < HY_L - 1 ? w2 : 0.f;
    const float a0 = hy_bf(row[nm]), a1 = hy_bf(row[n]), a2 = hy_bf(row[np]);
    const float b0 = hy_bf(row[HY_L + nm]), b1 = hy_bf(row[HY_L + n]), b2 = hy_bf(row[HY_L + np]);
    return (f2){wm * a0 + w1 * a1 + wp * a2 + cb, wm * b0 + w1 * b1 + wp * b2 + cb};
}
struct HyTw { f2 w8192, w512, w32; };
HD HyTw hy_tw(int t) { HyTw w; w.w8192 = hy_cis(-(float)t * (1.0f / 8192.0f)); w.w512 = hy_cis(-(float)(t & 31) * (1.0f / 512.0f)); w.w32 = hy_cis(-(float)(t & 1) * (1.0f / 32.0f)); return w; }
constexpr int NWAVES = 8;
#ifndef MK_N_LAUNCHES
#define MK_N_LAUNCHES 1
#endif
constexpr int N_PHASES = 12;
constexpr int N_LAUNCHES = MK_N_LAUNCHES;
constexpr int BATCH = 2, SEQ = 16384, DM = 2048, MTOK = BATCH * SEQ;
constexpr int HYW = 1024, NHY = 3072, NATT = 1536, INW = 4608;
constexpr int NE = 16, EFF = 1536, CAP = 2048, MOE_ROWS = NE * BATCH * CAP;
constexpr float LN_EPS = 1e-6f, DN_ALPHA = 1.189207115002721f;
typedef unsigned short bf16;
typedef unsigned v4u __attribute__((ext_vector_type(4)));
typedef float f32x4 __attribute__((ext_vector_type(4)));
typedef short bf16x8 __attribute__((ext_vector_type(8)));
#define LAS __attribute__((address_space(3)))
#define RLX_AGENT __ATOMIC_RELAXED, __HIP_MEMORY_SCOPE_AGENT
constexpr size_t MiB = 1u << 20;
constexpr size_t WS_CTL = 0, CTL_ZERO_BYTES = 1 * MiB;
constexpr size_t WS_H2 = 1 * MiB;
constexpr size_t WS_W3T = 9 * MiB;
constexpr size_t WS_AFF = 11 * MiB;
constexpr size_t WS_IDX = 13 * MiB;
constexpr size_t WS_GATE = 13 * MiB + 256 * 1024;
constexpr size_t WS_SLOT = 13 * MiB + 512 * 1024;
constexpr size_t WS_WIN = 16 * MiB;
constexpr size_t WS_WOUT = 34 * MiB;
constexpr size_t WS_WGU = 42 * MiB;
constexpr size_t WS_WD = 138 * MiB;
constexpr size_t WS_XB = 186 * MiB;
constexpr size_t WS_PT = 458 * MiB;
constexpr size_t WS_QKV = 650 * MiB;
constexpr size_t WS_FILT = 746 * MiB;
constexpr size_t WS_KP = 874 * MiB, WS_VP = 890 * MiB;
constexpr size_t WS_YHT = 906 * MiB;
constexpr size_t WS_ZPG = 330 * MiB;
constexpr size_t WS_YACC = 346 * MiB;
constexpr size_t WS_YATT = 330 * MiB;
constexpr size_t WS_MIX = 394 * MiB;
constexpr size_t WS_T = 522 * MiB;
constexpr size_t WS_X1 = 650 * MiB;
constexpr size_t WS_X8 = 330 * MiB;
constexpr size_t WS_XG = 330 * MiB;
constexpr size_t WS_HB = 778 * MiB;
constexpr size_t WS_Y = 330 * MiB;
constexpr size_t WS_END = 1024 * MiB;
constexpr int CW_TMO = 0, CW_BAR = 4096;
constexpr int RING_BYTES = 139264;
constexpr int LDSCTL_OFF = RING_BYTES, MISC_OFF = LDSCTL_OFF + 320;
constexpr int LDS_BYTES = 147456;
static_assert(HY_BUF * 8 + 65536 <= RING_BYTES && pg8::STAGE_BYTES <= RING_BYTES && (int)att::SHM_ATTN <= RING_BYTES && MISC_OFF + 128 <= LDS_BYTES, "LDS map");

__device__ __forceinline__ unsigned f2bf(float f) { unsigned u = __builtin_bit_cast(unsigned, f); return (u + 0x7fffu + ((u >> 16) & 1u)) >> 16; }
__device__ __forceinline__ unsigned pk2(float lo, float hi) { return f2bf(lo) | (f2bf(hi) << 16); }
__device__ __forceinline__ float bflo(unsigned w) { return __builtin_bit_cast(float, w << 16); }
__device__ __forceinline__ float bfhi(unsigned w) { return __builtin_bit_cast(float, w & 0xffff0000u); }
template <int CTRL> __device__ __forceinline__ float dpp_f(float v) { return __builtin_bit_cast(float, __builtin_amdgcn_mov_dpp(__builtin_bit_cast(int, v), CTRL, 0xF, 0xF, true)); }
__device__ __forceinline__ float row16_sum(float v) { v += dpp_f<0xB1>(v); v += dpp_f<0x4E>(v); v += dpp_f<0x141>(v); v += dpp_f<0x140>(v); return v; }
__device__ __forceinline__ float row16_max(float v) { v = fmaxf(v, dpp_f<0xB1>(v)); v = fmaxf(v, dpp_f<0x4E>(v)); v = fmaxf(v, dpp_f<0x141>(v)); v = fmaxf(v, dpp_f<0x140>(v)); return v; }
__device__ __forceinline__ float wave_sum(float v) {
    v = row16_sum(v);
    const float a = __builtin_bit_cast(float, __builtin_amdgcn_readlane(__builtin_bit_cast(int, v), 0)), b = __builtin_bit_cast(float, __builtin_amdgcn_readlane(__builtin_bit_cast(int, v), 16));
    const float c = __builtin_bit_cast(float, __builtin_amdgcn_readlane(__builtin_bit_cast(int, v), 32)), d = __builtin_bit_cast(float, __builtin_amdgcn_readlane(__builtin_bit_cast(int, v), 48));
    return (a + b) + (c + d);
}
#define LDS_WAIT() asm volatile("s_waitcnt lgkmcnt(0)" ::: "memory")
#define XB_TMO      128
#define XB_XCNT(j)  (256  + 64 * (j))
#define XB_XSUB(j)  (1280 + 64 * (j))
#define XB_XGEN(j)  (2304 + 64 * (j))
#define XB_TOP      3328
#define XB_TOPGEN   3392
#define XCD_BAR_WORDS 3456
#define XB_SPIN_CAP (1u << 18)

__device__ __forceinline__ unsigned xb_ld(unsigned* p)              { return __hip_atomic_load(p, __ATOMIC_RELAXED, __HIP_MEMORY_SCOPE_AGENT); }
__device__ __forceinline__ unsigned xb_add(unsigned* p, unsigned v) { return __hip_atomic_fetch_add(p, v, __ATOMIC_RELAXED, __HIP_MEMORY_SCOPE_AGENT); }
__device__ __forceinline__ unsigned xb_xcc_id() { return (unsigned)__builtin_amdgcn_s_getreg((3 << 11) | 20) & 0xFu; }
#define XB_SPIN(cond, bar) do { unsigned _sp = 0; while (cond) { __builtin_amdgcn_s_sleep(1); \
    if ((++_sp & 255u) == 0u) { if (xb_ld(&(bar)[XB_TMO])) break; if (_sp > XB_SPIN_CAP) { atomicAdd(&(bar)[XB_TMO], 1u); break; } } } } while (0)

struct XcdBarrier {
    unsigned* bar; unsigned x;
    volatile LAS unsigned* st;
};

__device__ __forceinline__ XcdBarrier xcd_barrier_post(unsigned* bar, volatile LAS unsigned* st) {
    XcdBarrier b; b.bar = bar; b.x = xb_xcc_id(); b.st = st;
    if (threadIdx.x == 0) (void)xb_add(&bar[XB_XCNT(b.x)], 1u);
    return b;
}
__device__ __forceinline__ void xcd_barrier_complete(unsigned* bar, unsigned x, unsigned& nloc, unsigned& nx) {
    const unsigned G = gridDim.x * gridDim.y * gridDim.z;
    unsigned sum, cnt, mine, sp = 0u;
    for (;;) {
        sum = 0u; cnt = 0u; mine = 0u;
#pragma unroll
        for (unsigned j = 0; j < 16; ++j) { const unsigned c = xb_ld(&bar[XB_XCNT(j)]); sum += c; cnt += (c > 0u) ? 1u : 0u; mine = (j == x) ? c : mine; }
        if (sum == G) break;
        __builtin_amdgcn_s_sleep(1);
        if ((++sp & 255u) == 0u) { if (xb_ld(&bar[XB_TMO])) break; if (sp > XB_SPIN_CAP) { atomicAdd(&bar[XB_TMO], 1u); break; } }
    }
    nloc = mine > 0u ? mine : 1u; nx = cnt > 0u ? cnt : 1u;
}

__device__ __forceinline__ void xcd_barrier(const XcdBarrier& b) {
    asm volatile("s_waitcnt vmcnt(0)" ::: "memory");
    __syncthreads();
    if (threadIdx.x == 0) {
        unsigned* bar = b.bar;
        __builtin_amdgcn_s_waitcnt(0);
        unsigned nloc = b.st[0], nx = b.st[1];
        if (nloc == 0u) { xcd_barrier_complete(bar, b.x, nloc, nx); b.st[0] = nloc; b.st[1] = nx; }
        const unsigned old = xb_add(&bar[XB_XSUB(b.x)], 1u);
        const unsigned gen = old / nloc;
        if (old + 1u == (gen + 1u) * nloc) {
            __builtin_amdgcn_fence(__ATOMIC_RELEASE, "agent");
            asm volatile("s_waitcnt vmcnt(0)" ::: "memory");
            const unsigned og = xb_add(&bar[XB_TOP], 1u);
            const unsigned tg = og / nx;
            if (og + 1u == (tg + 1u) * nx) xb_add(&bar[XB_TOPGEN], 1u);
            else XB_SPIN(xb_ld(&bar[XB_TOPGEN]) == tg, bar);
            __builtin_amdgcn_fence(__ATOMIC_ACQUIRE, "agent");
            xb_add(&bar[XB_XGEN(b.x)], 1u);
            asm volatile("s_waitcnt vmcnt(0)" ::: "memory");
        } else {
            XB_SPIN(xb_ld(&bar[XB_XGEN(b.x)]) == gen, bar);
            __builtin_amdgcn_fence(__ATOMIC_ACQUIRE, "agent");
            asm volatile("s_waitcnt vmcnt(0)" ::: "memory");
        }
    }
    __syncthreads();
}
#ifndef PROBE_SEC
#define PROBE_SEC 0
#endif
#define TSEC_B(id) do { if (PROBE_SEC == (id)) { asm volatile("s_waitcnt vmcnt(0) lgkmcnt(0)" ::: "memory"); t0_ = __builtin_amdgcn_s_memrealtime(); } } while (0)
#define TSEC_E(id) do { if (PROBE_SEC == (id)) { asm volatile("s_waitcnt vmcnt(0) lgkmcnt(0)" ::: "memory"); tacc_ += __builtin_amdgcn_s_memrealtime() - t0_; } } while (0)
struct Ctx { LAS unsigned char* lds; int tid, lane, wave, G, gw, NGW; };
#define COSREV(x) __builtin_amdgcn_cosf(x)
#define SINREV(x) __builtin_amdgcn_sinf(x)

__device__ __forceinline__ void transpose_item(const float* W, int ldw, int k0, int n0, bf16* dst, int ldk, LAS float* scr, int lane) {
    float tv[32];
#pragma unroll
    for (int i = 0; i < 32; ++i) tv[i] = W[(size_t)(k0 + 2 * i + (lane >> 5)) * ldw + n0 + (lane & 31)];
#pragma unroll
    for (int i = 0; i < 32; ++i) scr[(2 * i + (lane >> 5)) * 33 + (lane & 31)] = tv[i];
    LDS_WAIT(); asm volatile("" ::: "memory");
    const int c = lane & 7;
    if (ldk > 0) {
#pragma unroll
        for (int j = 0; j < 4; ++j) { const int n = (lane >> 3) + 8 * j; const LAS float* s = scr + (8 * c) * 33 + n;
            v4u o; o.x = pk2(s[0 * 33], s[1 * 33]); o.y = pk2(s[2 * 33], s[3 * 33]); o.z = pk2(s[4 * 33], s[5 * 33]); o.w = pk2(s[6 * 33], s[7 * 33]);
            *(v4u*)(dst + (size_t)n * ldk + 8 * c) = o; }
    } else {
#pragma unroll
        for (int j = 0; j < 4; ++j) { const int n = (lane >> 3) + 8 * j; const LAS float* s = scr + (8 * c) * 33 + n;
            int w0 = 0, w1 = 0;
            w0 = __builtin_amdgcn_cvt_pk_fp8_f32(32.f * s[0 * 33], 32.f * s[1 * 33], w0, false); w0 = __builtin_amdgcn_cvt_pk_fp8_f32(32.f * s[2 * 33], 32.f * s[3 * 33], w0, true);
            w1 = __builtin_amdgcn_cvt_pk_fp8_f32(32.f * s[4 * 33], 32.f * s[5 * 33], w1, false); w1 = __builtin_amdgcn_cvt_pk_fp8_f32(32.f * s[6 * 33], 32.f * s[7 * 33], w1, true);
            typedef int v2i_ __attribute__((ext_vector_type(2)));
            *(v2i_*)((unsigned char*)dst + (size_t)n * (size_t)(-ldk) + 8 * c) = (v2i_){w0, w1}; }
    }
    LDS_WAIT(); asm volatile("" ::: "memory");
}
constexpr int TI_IN = 32 * 144, TI_OUT = 32 * 64, TI_3 = 128, TI_G = 16 * 32 * 48, TI_D = 16 * 24 * 64, TI_TOTAL = TI_IN + TI_OUT + TI_3 + 2 * TI_G + TI_D;
#ifndef TI_SPLIT_V
#define TI_SPLIT_V (TI_TOTAL - 40960)
#endif
constexpr int TI_SPLIT = TI_SPLIT_V;
template <class KP> __device__ __forceinline__ void transpose_items(KP inp, unsigned char* ws, LAS float* scr, int lane, int first, int last, int w0, int nw) {
#define in(k) ((const float*)(__attribute__((address_space(1))) const float*)inp[k])
    bf16* WIN = (bf16*)(ws + WS_WIN); bf16* WOUT = (bf16*)(ws + WS_WOUT); bf16* WGU = (bf16*)(ws + WS_WGU); bf16* WD = (bf16*)(ws + WS_WD); bf16* W3T = (bf16*)(ws + WS_W3T);
#define P0_DECODE(it_, SRC, LDW, DST, LDK) do { int r = (it_); \
        if (r < TI_IN) { const int kb = r / 144, nb = r % 144; SRC = in(1) + (size_t)(64 * kb) * INW + 32 * nb; LDW = INW; DST = WIN + (size_t)(32 * nb) * DM + 64 * kb; LDK = DM; break; } r -= TI_IN; \
        if (r < TI_OUT) { const int kb = r / 64, nb = r % 64; SRC = in(18) + (size_t)(64 * kb) * DM + 32 * nb; LDW = DM; DST = WOUT + (size_t)(32 * nb) * DM + 64 * kb; LDK = DM; break; } r -= TI_OUT; \
        if (r < TI_3) { SRC = in(11) + 32 * r; LDW = 4096; DST = W3T + (size_t)(32 * r) * 256; LDK = 256; break; } r -= TI_3; \
        if (r < 2 * TI_G) { const int up = r >= TI_G; if (up) r -= TI_G; const int e = r / (32 * 48), q = r % (32 * 48), kb = q / 48, nb = q % 48, n0 = 32 * nb; \
            const size_t drow = (size_t)e * 3072 + (n0 >> 7) * 256 + (n0 & 127) + (up ? 128 : 0); \
            SRC = (up ? in(24) : in(23)) + (size_t)e * DM * EFF + (size_t)(64 * kb) * EFF + n0; LDW = EFF; DST = (bf16*)((unsigned char*)WGU + drow * DM + 64 * kb); LDK = -DM; break; } r -= 2 * TI_G; \
        { const int e = r / (24 * 64), q = r % (24 * 64), kb = q / 64, nb = q % 64; \
            SRC = in(25) + (size_t)e * EFF * DM + (size_t)(64 * kb) * DM + 32 * nb; LDW = DM; DST = (bf16*)((unsigned char*)WD + ((size_t)e * DM + 32 * nb) * EFF + 64 * kb); LDK = -EFF; } } while (0)
#define P0_LOAD(SRC, LDW, TV) do { _Pragma("unroll") for (int i = 0; i < 32; ++i) TV[i] = SRC[(size_t)(2 * i + (lane >> 5)) * LDW + (lane & 31)]; } while (0)
    { int it = first + w0; const float* src = nullptr; bf16* dst = nullptr; int ldw = 0, ldk = 0; float tv[32];
      if (it < last) { P0_DECODE(it, src, ldw, dst, ldk); P0_LOAD(src, ldw, tv); }
      while (it < last) {
          const int nx = it + nw; const float* nsrc = src; bf16* ndst = dst; int nldw = ldw, nldk = ldk; float tn[32];
          if (nx < last) { P0_DECODE(nx, nsrc, nldw, ndst, nldk); P0_LOAD(nsrc, nldw, tn); }
          else {
#pragma unroll
              for (int i = 0; i < 32; ++i) tn[i] = 0.f; }
#pragma unroll
          for (int i = 0; i < 32; ++i) scr[(2 * i + (lane >> 5)) * 33 + (lane & 31)] = tv[i];
          LDS_WAIT(); asm volatile("" ::: "memory");
          const int c = lane & 7;
          if (ldk > 0) {
#pragma unroll
              for (int j = 0; j < 4; ++j) { const int n = (lane >> 3) + 8 * j; const LAS float* s = scr + (8 * c) * 33 + n;
                  v4u o; o.x = pk2(s[0 * 33], s[1 * 33]); o.y = pk2(s[2 * 33], s[3 * 33]); o.z = pk2(s[4 * 33], s[5 * 33]); o.w = pk2(s[6 * 33], s[7 * 33]);
                  *(v4u*)(dst + (size_t)n * ldk + 8 * c) = o; }
          } else {
#pragma unroll
              for (int j = 0; j < 4; ++j) { const int n = (lane >> 3) + 8 * j; const LAS float* s = scr + (8 * c) * 33 + n;
                  int w0 = 0, w1 = 0;
                  w0 = __builtin_amdgcn_cvt_pk_fp8_f32(32.f * s[0 * 33], 32.f * s[1 * 33], w0, false); w0 = __builtin_amdgcn_cvt_pk_fp8_f32(32.f * s[2 * 33], 32.f * s[3 * 33], w0, true);
                  w1 = __builtin_amdgcn_cvt_pk_fp8_f32(32.f * s[4 * 33], 32.f * s[5 * 33], w1, false); w1 = __builtin_amdgcn_cvt_pk_fp8_f32(32.f * s[6 * 33], 32.f * s[7 * 33], w1, true);
                  typedef int v2i_ __attribute__((ext_vector_type(2)));
                  *(v2i_*)((unsigned char*)dst + (size_t)n * (size_t)(-ldk) + 8 * c) = (v2i_){w0, w1}; }
          }
          LDS_WAIT(); asm volatile("" ::: "memory");
#pragma unroll
          for (int i = 0; i < 32; ++i) tv[i] = tn[i];
          src = nsrc; dst = ndst; ldw = nldw; ldk = nldk; it = nx; } }
#undef P0_DECODE
#undef P0_LOAD
#undef in
}
template <class KP> __device__ __forceinline__ void p0_prologue(const Ctx& C, KP inp, unsigned char* ws) {
#define in(k) ((const float*)(__attribute__((address_space(1))) const float*)inp[k])
    LAS float* scr = (LAS float*)(C.lds + C.wave * 16384);
    const int lane = C.lane;
    bf16* WIN = (bf16*)(ws + WS_WIN); bf16* WOUT = (bf16*)(ws + WS_WOUT); bf16* WGU = (bf16*)(ws + WS_WGU); bf16* WD = (bf16*)(ws + WS_WD); bf16* W3T = (bf16*)(ws + WS_W3T);
    transpose_items(inp, ws, scr, lane, 0, TI_SPLIT, C.gw, C.NGW);
    for (int i = C.gw * 64 + lane; i < 4096 * 24; i += C.NGW * 64) { const int row = i / 24, ch = i % 24; *(v4u*)(W3T + (size_t)row * 256 + 64 + 8 * ch) = (v4u){0u, 0u, 0u, 0u}; }
    { const float* x = in(0); bf16* XB = (bf16*)(ws + WS_XB); const int NG = MTOK * DM / 8, STR = C.NGW * 64;
      for (int i = C.gw * 64 + lane; i < NG; i += 2 * STR) { const int j = i + STR; const bool h = j < NG;
          const f32x4 a0 = *(const f32x4*)(x + (size_t)i * 8), b0 = *(const f32x4*)(x + (size_t)i * 8 + 4);
          f32x4 a1 = a0, b1 = b0; if (h) { a1 = *(const f32x4*)(x + (size_t)j * 8); b1 = *(const f32x4*)(x + (size_t)j * 8 + 4); }
          v4u o; o.x = pk2(a0[0], a0[1]); o.y = pk2(a0[2], a0[3]); o.z = pk2(b0[0], b0[1]); o.w = pk2(b0[2], b0[3]); *(v4u*)(XB + (size_t)i * 8) = o;
          if (h) { v4u o1; o1.x = pk2(a1[0], a1[1]); o1.y = pk2(a1[2], a1[3]); o1.z = pk2(b1[0], b1[1]); o1.w = pk2(b1[2], b1[3]); *(v4u*)(XB + (size_t)j * 8) = o1; } } }
    { const float* w1 = in(5); const float* b1 = in(6); const float* f1 = in(7); const float* w2 = in(8); const float* b2 = in(9); const float* fq2 = in(10); bf16* H2 = (bf16*)(ws + WS_H2);
      const float b1k = b1[lane], f1k = f1[lane], b2k = b2[lane], f2k = fq2[lane];
      for (int t = C.gw; t < SEQ; t += C.NGW) {
          float acc = b1k + ((float)t * (1.0f / 16383.0f)) * w1[lane];
#pragma unroll
          for (int i = 0; i < 16; ++i) { const float fi = 1e-4f + (float)i * ((15.0f - 1e-4f) / 15.0f); const float rev = fi * (float)t * (1.0f / 16384.0f);
              acc += COSREV(rev) * w1[(1 + i) * 64 + lane] - SINREV(rev) * w1[(17 + i) * 64 + lane]; }
          const float h1 = SINREV(f1k * acc * 0.15915494309189535f);
          scr[lane] = h1; LDS_WAIT(); asm volatile("" ::: "memory");
          float a2 = b2k;
#pragma unroll 16
          for (int j = 0; j < 64; ++j) a2 += scr[j] * w2[j * 64 + lane];
          const float h2 = SINREV(f2k * a2 * 0.15915494309189535f);
          LDS_WAIT(); asm volatile("" ::: "memory");
          bf16* o = H2 + (size_t)t * 256; o[lane] = (bf16)f2bf(h2); o[64 + lane] = 0; o[128 + lane] = 0; o[192 + lane] = 0;
      } }
#undef in
}

__device__ __forceinline__ void p2_kpass(const Ctx& C, const float* kn, unsigned char* ws) {
    const bf16* QKV = (const bf16*)(ws + WS_QKV); unsigned char* KP8 = ws + WS_KP; unsigned char* VT8 = ws + WS_VP;
    const int lane = C.lane; const float g0 = kn[2 * lane], g1 = kn[2 * lane + 1];
    const float inv = __builtin_amdgcn_exp2f(-(float)(lane & 31) * (13.287712379549449f / 32.0f));
    for (int it = C.gw; it < MTOK / 2; it += C.NGW) {
        const int kvh = it & 1, m0 = 4 * (it >> 1), b = m0 >> 14, l0 = m0 & (SEQ - 1);
        unsigned pk[4], pv[4];
#pragma unroll
        for (int u = 0; u < 4; ++u) { pk[u] = *(const unsigned*)(QKV + (size_t)(m0 + u) * NATT + 1024 + kvh * 128 + 2 * lane); pv[u] = *(const unsigned*)(QKV + (size_t)(m0 + u) * NATT + 1280 + kvh * 128 + 2 * lane); }
        unsigned vlo = 0u, vhi = 0u;
#pragma unroll
        for (int u = 0; u < 4; ++u) { const int l = l0 + u;
            float x0 = bflo(pk[u]), x1 = bfhi(pk[u]);
            const float ss = wave_sum(x0 * x0 + x1 * x1), rs = 1.0f / sqrtf(ss * (1.0f / 128.0f) + LN_EPS);
            x0 *= rs * g0; x1 *= rs * g1;
            const float pos = (float)(lane < 32 ? (l >> 6) : (l & 63)), rev = pos * inv * 0.15915494309189535f, c = COSREV(rev), s = SINREV(rev);
            *(unsigned short*)(KP8 + (((size_t)(b * 2 + kvh) * SEQ + l) * 128) + 2 * lane) = (unsigned short)__builtin_amdgcn_cvt_pk_fp8_f32(x0 * c - x1 * s, x0 * s + x1 * c, 0, false);
            const unsigned w8 = (unsigned)__builtin_amdgcn_cvt_pk_fp8_f32(4.f * bflo(pv[u]), 4.f * bfhi(pv[u]), 0, false);
            vlo |= (w8 & 0xffu) << (8 * u); vhi |= ((w8 >> 8) & 0xffu) << (8 * u); }
        {
          const int kk = l0 & 63, hi_ = (kk >> 2) & 1, j_ = 16 * (kk >> 5) + 4 * ((kk & 31) >> 3), bp = 32 * hi_ + j_, q4 = bp >> 4;
          unsigned char* tb = VT8 + (((size_t)(b * 2 + kvh) * SEQ) + (size_t)(l0 & ~63)) * 128; const int c0 = 2 * lane, c1 = 2 * lane + 1;
          *(unsigned*)(tb + c0 * 64 + (((q4 ^ ((c0 >> 2) & 3)) << 4) | (bp & 15))) = vlo;
          *(unsigned*)(tb + c1 * 64 + (((q4 ^ ((c1 >> 2) & 3)) << 4) | (bp & 15))) = vhi; } }
}

__device__ __forceinline__ float hy_dppx(float v) { return __builtin_bit_cast(float, __builtin_amdgcn_mov_dpp(__builtin_bit_cast(int, v), 0xB1, 0xF, 0xF, true)); }
__device__ __forceinline__ void hy_bulk(unsigned char* dst, const bf16* src0, const bf16* src1, int t) {
    v4u v[8];
#pragma unroll
    for (int k = 0; k < 8; ++k) { const int ch = t + 512 * k; const bf16* s = (ch < 2048 ? src0 : src1) + (size_t)(ch & 2047) * 8; v[k] = *(const v4u*)s; }
#pragma unroll
    for (int k = 0; k < 8; ++k) *(v4u*)(dst + (size_t)(t + 512 * k) * 16) = v[k];
}
__device__ __forceinline__ void hy_unit(int c, const float* cw, const float* cbias, const float* skip, unsigned char* ws, unsigned char* lds, int t, unsigned long long& tacc_) {
    unsigned long long t0_ = 0; TSEC_B(7);
    const bf16* PT = (const bf16*)(ws + WS_PT); const bf16* FILT = (const bf16*)(ws + WS_FILT); bf16* YHT = (bf16*)(ws + WS_YHT);
    f2* X = (f2*)lds; unsigned char* TB = lds + HY_BUF * 8; const bf16* TAPS = (const bf16*)TB;
    const HyTw tw = hy_tw(t);
    unsigned* zp = (unsigned*)(ws + WS_ZPG) + (size_t)blockIdx.x * (32 * 512); f2* yg = (f2*)(ws + WS_YACC) + (size_t)blockIdx.x * (32 * 512);
    HY_OPAQUE(t);
    TSEC_B(6);
    { const bf16* row = PT + (size_t)c * MTOK; hy_bulk(TB, row, row + SEQ, t); __syncthreads();
      const float w0 = cw[c], w1 = cw[NHY + c], w2 = cw[2 * NHY + c], cb = cbias[c];
#pragma unroll
      for (int n1 = 0; n1 < 16; ++n1)
#pragma unroll
          for (int j = 0; j < 2; ++j) { zp[(2 * n1 + j) * 512 + t] = hy_pack(hy_sconv(TAPS, t + 512 * n1 + HY_P * j, w0, w1, w2, cb)); if (n1 & 1) HY_FENCE(); }
      __syncthreads(); }
    TSEC_E(6);
#pragma unroll 1
    for (int order = 0; order < 2; ++order) {
        TSEC_B(6);
        hy_bulk(TB, FILT + (size_t)(order * 1024 + c) * SEQ, FILT + (size_t)(2048 + order * 1024 + c) * SEQ, t); __syncthreads();
        TSEC_E(6);
        f2 yacc[16][2];
#pragma unroll
        for (int n1 = 0; n1 < 16; ++n1) { yacc[n1][0] = (f2){0.f, 0.f}; yacc[n1][1] = (f2){0.f, 0.f}; }
#pragma unroll 1
        for (int R = 0; R < 4; ++R) {
            unsigned Gp[16];
            TSEC_B(1); hy_stage1A(X, t, R, TAPS, TAPS + SEQ, tw.w8192); __syncthreads(); TSEC_E(1);
            TSEC_B(2); hy_fwd1<5>(X, t, tw.w512); __syncthreads(); TSEC_E(2);
            TSEC_B(3); { int t3 = t; HY_OPAQUE(t3); f2 G[16]; hy_fwd3(X, t3, G);
#pragma unroll
              for (int i = 0; i < 16; ++i) Gp[i] = hy_pack(G[i]); } __syncthreads(); TSEC_E(3);
            TSEC_B(1); hy_stage1B(X, t, R, zp, tw.w8192); __syncthreads(); TSEC_E(1);
            TSEC_B(2); hy_fwd1<5>(X, t, tw.w512); __syncthreads(); TSEC_E(2);
            TSEC_B(3);
            { int t3 = t; HY_OPAQUE(t3); f2 xb[16];
              hy_fwd3(X, t3, xb);
              struct XD { const unsigned (&g)[16]; const f2 (&xb)[16];
                  __device__ __forceinline__ unsigned a(int i) const { return (unsigned)__builtin_amdgcn_mov_dpp((int)g[i], 0xB1, 0xF, 0xF, true); }
                  __device__ __forceinline__ f2 b(int i) const { return (f2){hy_dppx(xb[i].x), hy_dppx(xb[i].y)}; } } P{Gp, xb};
              hy_s3_fin(X, t3, xb, Gp, P); }
            __syncthreads(); TSEC_E(3);
            TSEC_B(4); hy_inv1<5>(X, t, tw.w512); __syncthreads(); TSEC_E(4);
            TSEC_B(5); hy_inv1_acc(X, t, R, tw.w8192, yacc); TSEC_E(5);
            HY_SCHED();
        }
        TSEC_B(6);
        const int ch = (order + 1) * HYW + c;
        HY_OPAQUE(t);
        { const bf16* row = PT + (size_t)ch * MTOK; hy_bulk(TB, row, row + SEQ, t); __syncthreads(); }
        const float w0 = cw[ch], w1 = cw[NHY + ch], w2 = cw[2 * NHY + ch], cb = cbias[ch], d = skip[order * HYW + c];
        bf16* o0 = YHT + (size_t)c * SEQ; bf16* o1 = YHT + (size_t)(HYW + c) * SEQ;
#pragma unroll
        for (int hh = 0; hh < 2; ++hh) {
            unsigned zq[8][2];
#pragma unroll
            for (int q = 0; q < 8; ++q) { zq[q][0] = zp[(2 * (8 * hh + q)) * 512 + t]; zq[q][1] = zp[(2 * (8 * hh + q) + 1) * 512 + t]; }
#pragma unroll
            for (int q = 0; q < 8; ++q) { const int n1 = 8 * hh + q;
#pragma unroll
                for (int j = 0; j < 2; ++j) { const int n = t + 512 * n1 + HY_P * j; const f2 ux = hy_sconv(TAPS, n, w0, w1, w2, cb), zz = hy_unpack(zq[q][j]);
                    const f2 y = ux * (yacc[n1][j] * (1.0f / 32768.0f) + zz * d);
                    if (order == 0) zp[(2 * n1 + j) * 512 + t] = hy_pack(y); else { o0[n] = (bf16)hy_f2bf(y.x); o1[n] = (bf16)hy_f2bf(y.y); } }
                if (q & 1) HY_FENCE(); }
        }
        __syncthreads();
        TSEC_E(6);
    }
    TSEC_E(7);
}

__device__ __forceinline__ void p4_merge(const Ctx& C, const float* ghy, const float* gatt, unsigned char* ws) {
    const bf16* YHT = (const bf16*)(ws + WS_YHT); const bf16* YATT = (const bf16*)(ws + WS_YATT); bf16* MIX = (bf16*)(ws + WS_MIX);
    const int lane = C.lane, tid = C.tid;
    for (int m = C.gw; m < MTOK; m += C.NGW) { const bf16* r = YATT + (size_t)m * 1024;
        const v4u a = *(const v4u*)(r + 8 * lane), b = *(const v4u*)(r + 512 + 8 * lane);
        float v[16]; v[0] = bflo(a.x); v[1] = bfhi(a.x); v[2] = bflo(a.y); v[3] = bfhi(a.y); v[4] = bflo(a.z); v[5] = bfhi(a.z); v[6] = bflo(a.w); v[7] = bfhi(a.w);
        v[8] = bflo(b.x); v[9] = bfhi(b.x); v[10] = bflo(b.y); v[11] = bfhi(b.y); v[12] = bflo(b.z); v[13] = bfhi(b.z); v[14] = bflo(b.w); v[15] = bfhi(b.w);
        float ss = 0.f;
#pragma unroll
        for (int i = 0; i < 16; ++i) ss += v[i] * v[i];
        const float rs = 1.0f / sqrtf(wave_sum(ss) * (1.0f / 1024.0f) + LN_EPS);
        const f32x4 g0 = *(const f32x4*)(gatt + 8 * lane), g1 = *(const f32x4*)(gatt + 8 * lane + 4), g2 = *(const f32x4*)(gatt + 512 + 8 * lane), g3 = *(const f32x4*)(gatt + 512 + 8 * lane + 4);
        v4u o0, o1;
        o0.x = pk2(v[0] * rs * g0[0], v[1] * rs * g0[1]); o0.y = pk2(v[2] * rs * g0[2], v[3] * rs * g0[3]); o0.z = pk2(v[4] * rs * g1[0], v[5] * rs * g1[1]); o0.w = pk2(v[6] * rs * g1[2], v[7] * rs * g1[3]);
        o1.x = pk2(v[8] * rs * g2[0], v[9] * rs * g2[1]); o1.y = pk2(v[10] * rs * g2[2], v[11] * rs * g2[3]); o1.z = pk2(v[12] * rs * g3[0], v[13] * rs * g3[1]); o1.w = pk2(v[14] * rs * g3[2], v[15] * rs * g3[3]);
        bf16* d = MIX + (size_t)m * DM + 1024; *(v4u*)(d + 8 * lane) = o0; *(v4u*)(d + 512 + 8 * lane) = o1; }
    LAS unsigned short* tile = (LAS unsigned short*)C.lds; LAS float* red = (LAS float*)(C.lds + 512 * 136);
    const int tau = tid & 63, cg = tid >> 6;
    for (int u = blockIdx.x; u < MTOK / 64; u += C.G) { const int b = u >> 8, n0 = (u & 255) * 64;
        unsigned pk[2][32]; float ss = 0.f;
#pragma unroll
        for (int h = 0; h < 2; ++h) {
            __syncthreads();
#pragma unroll
            for (int i = 0; i < 8; ++i) { const int cl = i * 64 + (tid >> 3), seg = tid & 7;
                const v4u v = *(const v4u*)(YHT + ((size_t)(b * 1024 + h * 512 + cl)) * SEQ + n0 + 8 * seg);
                LAS unsigned* d = (LAS unsigned*)(tile + cl * 68 + 8 * seg); d[0] = v.x; d[1] = v.y; d[2] = v.z; d[3] = v.w; }
            __syncthreads();
#pragma unroll
            for (int k = 0; k < 32; ++k) { const unsigned lo = tile[(cg * 64 + 2 * k) * 68 + tau], hi2 = tile[(cg * 64 + 2 * k + 1) * 68 + tau];
                pk[h][k] = lo | (hi2 << 16); const float a = bflo(lo << 0), bb = __builtin_bit_cast(float, hi2 << 16); ss += a * a + bb * bb; }
        }
        __syncthreads();
        red[cg * 64 + tau] = ss; __syncthreads();
        float tot = 0.f;
#pragma unroll
        for (int g = 0; g < 8; ++g) tot += red[g * 64 + tau];
        const float rs = 1.0f / sqrtf(tot * (1.0f / 1024.0f) + LN_EPS);
        bf16* d = MIX + (size_t)(b * SEQ + n0 + tau) * DM;
#pragma unroll
        for (int h = 0; h < 2; ++h) { const int c0 = h * 512 + cg * 64;
#pragma unroll
            for (int q = 0; q < 8; ++q) { const f32x4 g0 = *(const f32x4*)(ghy + c0 + 8 * q), g1 = *(const f32x4*)(ghy + c0 + 8 * q + 4); v4u o;
                o.x = pk2(bflo(pk[h][4 * q]) * rs * g0[0], bfhi(pk[h][4 * q]) * rs * g0[1]); o.y = pk2(bflo(pk[h][4 * q + 1]) * rs * g0[2], bfhi(pk[h][4 * q + 1]) * rs * g0[3]);
                o.z = pk2(bflo(pk[h][4 * q + 2]) * rs * g1[0], bfhi(pk[h][4 * q + 2]) * rs * g1[1]); o.w = pk2(bflo(pk[h][4 * q + 3]) * rs * g1[2], bfhi(pk[h][4 * q + 3]) * rs * g1[3]);
                *(v4u*)(d + c0 + 8 * q) = o; } }
    }
}

__device__ __forceinline__ float p6_dot2(unsigned x, unsigned w, float acc) { typedef __bf16 bf2 __attribute__((ext_vector_type(2))); return __builtin_amdgcn_fdot2_f32_bf16(__builtin_bit_cast(bf2, x), __builtin_bit_cast(bf2, w), acc, false); }
__device__ __forceinline__ void p6_ln_router(const Ctx& C, const float* g, const float* be, const float* wr, const float* br, unsigned char* ws) {
    typedef __bf16 bf2 __attribute__((ext_vector_type(2)));
    const bf16* T = (const bf16*)(ws + WS_T); bf16* X1 = (bf16*)(ws + WS_X1); float* AFF = (float*)(ws + WS_AFF); unsigned char* X8 = ws + WS_X8;
    const int lane = C.lane; LAS v4u* wl = (LAS v4u*)C.lds;
    __syncthreads();
    for (int idx = C.tid; idx < 1024 * 4; idx += 512) { const int pp = idx >> 2, q = idx & 3, k = 2 * pp, ppos = (pp >> 8) * 256 + (pp & 3) * 64 + ((pp >> 2) & 63);
        const f32x4 a = *(const f32x4*)(wr + k * 16 + 4 * q), b = *(const f32x4*)(wr + (k + 1) * 16 + 4 * q);
        v4u o; o.x = pk2(a[0], b[0]); o.y = pk2(a[1], b[1]); o.z = pk2(a[2], b[2]); o.w = pk2(a[3], b[3]); wl[q * 1024 + ppos] = o; }
    __syncthreads();
    for (int m = C.gw; m < MTOK; m += C.NGW) {
        float v[4][8]; float s = 0.f;
#pragma unroll
        for (int j = 0; j < 4; ++j) { const v4u a = *(const v4u*)(T + (size_t)m * DM + 512 * j + 8 * lane);
            v[j][0] = bflo(a.x); v[j][1] = bfhi(a.x); v[j][2] = bflo(a.y); v[j][3] = bfhi(a.y); v[j][4] = bflo(a.z); v[j][5] = bfhi(a.z); v[j][6] = bflo(a.w); v[j][7] = bfhi(a.w);
#pragma unroll
            for (int e = 0; e < 8; ++e) s += v[j][e]; }
        const float mean = wave_sum(s) * (1.0f / DM); float q2 = 0.f;
#pragma unroll
        for (int j = 0; j < 4; ++j)
#pragma unroll
            for (int e = 0; e < 8; ++e) { v[j][e] -= mean; q2 += v[j][e] * v[j][e]; }
        const float rstd = 1.0f / sqrtf(wave_sum(q2) * (1.0f / DM) + LN_EPS);
        float acc[16];
#pragma unroll
        for (int e = 0; e < 16; ++e) acc[e] = 0.f;
#pragma unroll
        for (int j = 0; j < 4; ++j) { const int k0 = 512 * j + 8 * lane;
            const f32x4 ga = *(const f32x4*)(g + k0), gb = *(const f32x4*)(g + k0 + 4), ba = *(const f32x4*)(be + k0), bb = *(const f32x4*)(be + k0 + 4);
            unsigned o[4];
            o[0] = pk2(v[j][0] * rstd * ga[0] + ba[0], v[j][1] * rstd * ga[1] + ba[1]); o[1] = pk2(v[j][2] * rstd * ga[2] + ba[2], v[j][3] * rstd * ga[3] + ba[3]);
            o[2] = pk2(v[j][4] * rstd * gb[0] + bb[0], v[j][5] * rstd * gb[1] + bb[1]); o[3] = pk2(v[j][6] * rstd * gb[2] + bb[2], v[j][7] * rstd * gb[3] + bb[3]);
            *(v4u*)(X1 + (size_t)m * DM + k0) = (v4u){o[0], o[1], o[2], o[3]};
            { int w0 = 0, w1 = 0;
              w0 = __builtin_amdgcn_cvt_pk_fp8_f32(bflo(o[0]), bfhi(o[0]), w0, false); w0 = __builtin_amdgcn_cvt_pk_fp8_f32(bflo(o[1]), bfhi(o[1]), w0, true);
              w1 = __builtin_amdgcn_cvt_pk_fp8_f32(bflo(o[2]), bfhi(o[2]), w1, false); w1 = __builtin_amdgcn_cvt_pk_fp8_f32(bflo(o[3]), bfhi(o[3]), w1, true);
              typedef int v2i_ __attribute__((ext_vector_type(2)));
              *(v2i_*)(X8 + (size_t)m * DM + k0) = (v2i_){w0, w1}; }
#pragma unroll
            for (int pe = 0; pe < 4; ++pe) { const unsigned xp = o[pe]; const int ppos = j * 256 + pe * 64 + lane;
#pragma unroll
                for (int q = 0; q < 4; ++q) { const v4u w = wl[q * 1024 + ppos]; const unsigned w0 = w.x, w1 = w.y, w2 = w.z, w3 = w.w;
                    acc[4 * q] = p6_dot2(xp, w0, acc[4 * q]); acc[4 * q + 1] = p6_dot2(xp, w1, acc[4 * q + 1]); acc[4 * q + 2] = p6_dot2(xp, w2, acc[4 * q + 2]); acc[4 * q + 3] = p6_dot2(xp, w3, acc[4 * q + 3]); }
                if (pe & 1) asm volatile("" ::: "memory"); } }
        const bool b0 = lane & 1, b1 = lane & 2, b2 = lane & 4, b3 = lane & 8;
        float r8[8], r4[4], r2[2];
#pragma unroll
        for (int i = 0; i < 8; ++i) r8[i] = (b0 ? acc[8 + i] : acc[i]) + dpp_f<0xB1>(b0 ? acc[i] : acc[8 + i]);
#pragma unroll
        for (int i = 0; i < 4; ++i) r4[i] = (b1 ? r8[4 + i] : r8[i]) + dpp_f<0x4E>(b1 ? r8[i] : r8[4 + i]);
#pragma unroll
        for (int i = 0; i < 2; ++i) r2[i] = (b2 ? r4[2 + i] : r4[i]) + dpp_f<0x1B>(dpp_f<0x141>(b2 ? r4[i] : r4[2 + i]));
        float lg = (b3 ? r2[1] : r2[0]) + dpp_f<0x128>(b3 ? r2[0] : r2[1]);
        lg += __shfl_xor(lg, 16); lg += __shfl_xor(lg, 32);
        const int ex = (b0 ? 8 : 0) + (b1 ? 4 : 0) + (b2 ? 2 : 0) + (b3 ? 1 : 0);
        lg += br[ex];
        const float mx = row16_max(lg), pe_ = __expf(lg - mx), den = row16_sum(pe_);
        if (lane < 16) AFF[(size_t)((m >> 14) * 16 + ex) * SEQ + (m & (SEQ - 1))] = pe_ / den;
    }
    __syncthreads();
}

__device__ __forceinline__ void p7_topk(const Ctx& C, int be, unsigned char* ws) {
    const float* AFF = (const float*)(ws + WS_AFF); int* IDX = (int*)(ws + WS_IDX); float* GATE = (float*)(ws + WS_GATE); short* SLOT = (short*)(ws + WS_SLOT);
    LAS unsigned* keys = (LAS unsigned*)C.lds;
    LAS unsigned* hist = (LAS unsigned*)(C.lds + 67584); LAS unsigned* misc = hist + 256; LAS unsigned* wsum = misc + 8;
    const int tid = C.tid, lane = C.lane, b = be >> 4, e = be & 15;
    __syncthreads();
    for (int i = tid; i < SEQ; i += 512) keys[i + (i >> 5)] = __float_as_uint(AFF[(size_t)be * SEQ + i]);
    unsigned prefix = 0u, mask = 0u, remaining = CAP;
#pragma unroll 1
    for (int pass = 0; pass < 4; ++pass) { const int shift = 24 - 8 * pass;
        if (tid < 256) hist[tid] = 0u;
        __syncthreads();
        for (int i = tid; i < SEQ; i += 512) { const unsigned k = keys[i + (i >> 5)]; if ((k & mask) == prefix) atomicAdd((unsigned*)&hist[(k >> shift) & 255u], 1u); }
        __syncthreads();
        if (tid < 64) { const unsigned c0 = hist[4 * lane], c1 = hist[4 * lane + 1], c2 = hist[4 * lane + 2], c3 = hist[4 * lane + 3]; const unsigned s4 = c0 + c1 + c2 + c3;
            unsigned inc = s4;
#pragma unroll
            for (int o = 1; o < 64; o <<= 1) { const unsigned y = __shfl_up(inc, o); if (lane >= o) inc += y; }
            const unsigned total = __shfl(inc, 63); unsigned cum = total - inc;
            const unsigned cs[4] = {c0, c1, c2, c3};
#pragma unroll
            for (int q = 3; q >= 0; --q) { if (cum < remaining && cum + cs[q] >= remaining) { misc[0] = 4 * lane + q; misc[1] = remaining - cum; } cum += cs[q]; } }
        __syncthreads();
        prefix |= misc[0] << shift; mask |= 0xffu << shift; remaining = misc[1];
        __syncthreads();
    }
    const unsigned T = prefix, need_eq = remaining;
    unsigned cg = 0, ce = 0;
#pragma unroll 8
    for (int i = 0; i < 32; ++i) { const unsigned k = keys[33 * tid + i]; cg += (k > T); ce += (k == T); }
    unsigned inc = cg | (ce << 16);
#pragma unroll
    for (int o = 1; o < 64; o <<= 1) { const unsigned y = __shfl_up(inc, o); if (lane >= o) inc += y; }
    if (lane == 63) wsum[C.wave] = inc;
    __syncthreads();
    unsigned off = 0;
#pragma unroll
    for (int w = 0; w < 8; ++w) off += (w < C.wave) ? wsum[w] : 0u;
    const unsigned ex = inc - (cg | (ce << 16)) + off; unsigned pg = ex & 0xffffu, pe = ex >> 16;
    const size_t rbase = (size_t)(e * 2 + b) * CAP;
#pragma unroll 4
    for (int i = 0; i < 32; ++i) { const unsigned k = keys[33 * tid + i]; const int tok = 32 * tid + i; int slot = -1;
        if (k > T) { slot = (int)(pg + (pe < need_eq ? pe : need_eq)); ++pg; }
        else if (k == T) { if (pe < need_eq) slot = (int)(pg + pe); ++pe; }
        SLOT[((size_t)b * SEQ + tok) * 16 + e] = (short)slot;
        if (slot >= 0) { IDX[rbase + slot] = tok; GATE[rbase + slot] = __uint_as_float(k); } }
    __syncthreads();
}

__device__ __forceinline__ void p8_gather(const Ctx& C, unsigned char* ws) {
    const bf16* X1 = (const bf16*)(ws + WS_X1); bf16* XG = (bf16*)(ws + WS_XG); const int* IDX = (const int*)(ws + WS_IDX);
    for (int r0 = C.gw; r0 < MOE_ROWS; r0 += 4 * C.NGW) {
        int tok[4];
#pragma unroll
        for (int u = 0; u < 4; ++u) tok[u] = IDX[min(r0 + u * C.NGW, MOE_ROWS - 1)];
        v4u a[4][4];
#pragma unroll
        for (int u = 0; u < 4; ++u) { const int r = min(r0 + u * C.NGW, MOE_ROWS - 1), b = (r >> 11) & 1; const v4u* s = (const v4u*)(X1 + (size_t)(b * SEQ + tok[u]) * DM) + C.lane;
            a[u][0] = s[0]; a[u][1] = s[64]; a[u][2] = s[128]; a[u][3] = s[192]; }
#pragma unroll
        for (int u = 0; u < 4; ++u) { v4u* d = (v4u*)(XG + (size_t)min(r0 + u * C.NGW, MOE_ROWS - 1) * DM) + C.lane; d[0] = a[u][0]; d[64] = a[u][1]; d[128] = a[u][2]; d[192] = a[u][3]; } }
}

__device__ __forceinline__ void p11_final(const Ctx& C, const float* g, const float* be, float* out, unsigned char* ws) {
    const bf16* X1 = (const bf16*)(ws + WS_X1); const unsigned char* Y = ws + WS_Y; const short* SLOT = (const short*)(ws + WS_SLOT);
    const unsigned char* ZROW = ws + WS_CTL + 512 * 1024;
    const int lane = C.lane;
    for (int m = C.gw; m < MTOK; m += C.NGW) { const int b = m >> 14;
        float v[4][8];
#pragma unroll
        for (int j = 0; j < 4; ++j) { const v4u a = *(const v4u*)(X1 + (size_t)m * DM + 512 * j + 8 * lane);
            v[j][0] = bflo(a.x); v[j][1] = bfhi(a.x); v[j][2] = bflo(a.y); v[j][3] = bfhi(a.y); v[j][4] = bflo(a.z); v[j][5] = bfhi(a.z); v[j][6] = bflo(a.w); v[j][7] = bfhi(a.w);
#pragma unroll
            for (int e = 0; e < 8; ++e) v[j][e] *= DN_ALPHA; }
        const v4u s0 = *(const v4u*)(SLOT + (size_t)m * 16), s1 = *(const v4u*)(SLOT + (size_t)m * 16 + 8);
        const unsigned sw[8] = {s0.x, s0.y, s0.z, s0.w, s1.x, s1.y, s1.z, s1.w};
        int r0 = -1, r1 = -1, r2 = -1, r3 = -1, n = 0; unsigned rest = 0u;
#pragma unroll
        for (int e = 0; e < 16; ++e) { const int sl = __builtin_amdgcn_readfirstlane((int)(short)((e & 1) ? (sw[e >> 1] >> 16) : (sw[e >> 1] & 0xffffu)));
            if (sl >= 0) { const int row = (e * 2 + b) * CAP + sl; if (n == 0) r0 = row; else if (n == 1) r1 = row; else if (n == 2) r2 = row; else if (n == 3) r3 = row; else rest |= 1u << e; ++n; } }
        typedef int v2i_ __attribute__((ext_vector_type(2))); typedef float f2v_ __attribute__((ext_vector_type(2)));
#define ADD8(A) do { const int ax_ = A.x, ay_ = A.y; const f2v_ c0 = __builtin_amdgcn_cvt_pk_f32_fp8(ax_, false), c1 = __builtin_amdgcn_cvt_pk_f32_fp8(ax_, true), c2 = __builtin_amdgcn_cvt_pk_f32_fp8(ay_, false), c3 = __builtin_amdgcn_cvt_pk_f32_fp8(ay_, true); \
        v[j][0] += c0.x * (1.f / 64.f); v[j][1] += c0.y * (1.f / 64.f); v[j][2] += c1.x * (1.f / 64.f); v[j][3] += c1.y * (1.f / 64.f); v[j][4] += c2.x * (1.f / 64.f); v[j][5] += c2.y * (1.f / 64.f); v[j][6] += c3.x * (1.f / 64.f); v[j][7] += c3.y * (1.f / 64.f); } while (0)
        { const unsigned char* p0 = r0 >= 0 ? Y + (size_t)r0 * DM : ZROW; const unsigned char* p1 = r1 >= 0 ? Y + (size_t)r1 * DM : ZROW; const unsigned char* p2 = r2 >= 0 ? Y + (size_t)r2 * DM : ZROW; const unsigned char* p3 = r3 >= 0 ? Y + (size_t)r3 * DM : ZROW;
          v2i_ a0[4], a1[4], a2[4], a3[4];
#pragma unroll
          for (int j = 0; j < 4; ++j) { a0[j] = *(const v2i_*)(p0 + 512 * j + 8 * lane); a1[j] = *(const v2i_*)(p1 + 512 * j + 8 * lane); a2[j] = *(const v2i_*)(p2 + 512 * j + 8 * lane); a3[j] = *(const v2i_*)(p3 + 512 * j + 8 * lane); }
#pragma unroll
          for (int j = 0; j < 4; ++j) { ADD8(a0[j]); ADD8(a1[j]); ADD8(a2[j]); ADD8(a3[j]); } }
        while (rest) { const int e = __builtin_ctz(rest); rest &= rest - 1u;
            const int sl = __builtin_amdgcn_readfirstlane((int)*(const short*)(SLOT + (size_t)m * 16 + e));
            const unsigned char* yr = Y + ((size_t)(e * 2 + b) * CAP + sl) * DM;
#pragma unroll
            for (int j = 0; j < 4; ++j) { const v2i_ a = *(const v2i_*)(yr + 512 * j + 8 * lane); ADD8(a); } }
#undef ADD8
        float s = 0.f;
#pragma unroll
        for (int j = 0; j < 4; ++j)
#pragma unroll
            for (int e = 0; e < 8; ++e) s += v[j][e];
        const float mean = wave_sum(s) * (1.0f / DM); float q2 = 0.f;
#pragma unroll
        for (int j = 0; j < 4; ++j)
#pragma unroll
            for (int e = 0; e < 8; ++e) { v[j][e] -= mean; q2 += v[j][e] * v[j][e]; }
        const float rstd = 1.0f / sqrtf(wave_sum(q2) * (1.0f / DM) + LN_EPS);
#pragma unroll
        for (int j = 0; j < 4; ++j) { const int k0 = 512 * j + 8 * lane;
            const f32x4 ga = *(const f32x4*)(g + k0), gb = *(const f32x4*)(g + k0 + 4), ba = *(const f32x4*)(be + k0), bb = *(const f32x4*)(be + k0 + 4);
            f32x4 o0, o1;
#pragma unroll
            for (int e = 0; e < 4; ++e) { o0[e] = v[j][e] * rstd * ga[e] + ba[e]; o1[e] = v[j][4 + e] * rstd * gb[e] + bb[e]; }
            *(f32x4*)(out + (size_t)m * DM + k0) = o0; *(f32x4*)(out + (size_t)m * DM + k0 + 4) = o1; }
    }
}
struct Args { const float* in[28]; float* out; unsigned char* ws; int ph_lo, ph_hi; };
__global__ void __launch_bounds__(NWAVES * 64, 2) mega_fwd(Args args) {
    extern __shared__ __attribute__((aligned(16))) unsigned char lds[];
    Ctx C; C.lds = (LAS unsigned char*)lds; C.tid = threadIdx.x; C.lane = C.tid & 63; C.wave = __builtin_amdgcn_readfirstlane(C.tid >> 6);
    C.G = gridDim.x; C.gw = blockIdx.x * NWAVES + C.wave; C.NGW = C.G * NWAVES;
    unsigned char* ws = args.ws; unsigned* ctl = (unsigned*)(ws + WS_CTL);
    volatile LAS unsigned* MISC = (volatile LAS unsigned*)(C.lds + MISC_OFF);
    for (int u = C.tid; u < (LDS_BYTES - LDSCTL_OFF) / 4; u += NWAVES * 64) ((LAS unsigned*)(C.lds + LDSCTL_OFF))[u] = 0u;
    __syncthreads();
    XcdBarrier bar; bar.bar = ctl + CW_BAR; bar.x = 0; bar.st = nullptr;
    if (N_LAUNCHES == 1) bar = xcd_barrier_post(ctl + CW_BAR, MISC + 8);
    const int lo = args.ph_lo, hi = args.ph_hi;
    unsigned long long tacc_ = 0, t0_ = 0;
#ifndef REP_MASK
#define REP_MASK 0
#endif
#define REPS(k) _Pragma("unroll") for (int rep_ = 0; rep_ < 1 + ((REP_MASK >> (k)) & 1); ++rep_)
#ifndef GREP_MASK
#define GREP_MASK 0
#endif
#define GREPS(k) (1 + ((GREP_MASK >> (k)) & 1))
#ifndef PH_MASK
#define PH_MASK 0xfff
#endif
#define IN(k) (((PH_MASK >> (k)) & 1) && lo <= (k) && (k) < hi)
#define SEAM(k) do { if (IN(k) && IN((k) + 1)) xcd_barrier(bar); } while (0)
    typedef const float* __attribute__((address_space(4))) const* KPtr;
    KPtr in0 = (KPtr)__builtin_amdgcn_kernarg_segment_ptr();
#define LAUNDER_IN() KPtr in = in0; asm volatile("" : "+s"(in))
#define GIN(k) ((const float*)(__attribute__((address_space(1))) const float*)in[k])
    LAS unsigned char* ring = C.lds;

    TSEC_B(100);
    if (IN(0)) REPS(0) { LAUNDER_IN(); p0_prologue(C, in, ws); __syncthreads(); }
    SEAM(0); TSEC_E(100);
    TSEC_B(101);
    if (IN(1)) REPS(1) { LAUNDER_IN();
        { pg8::Gemm g{(const bf16*)(ws + WS_WIN), (const bf16*)(ws + WS_XB), NHY, MTOK, DM}; pg8::StaticOrder S; S.init(NHY, MTOK, C.G, (int)blockIdx.x); S.reps = GREPS(1);
          pg8::EpiRowBias E{(bf16*)(ws + WS_PT), MTOK, GIN(2)};
          pg8::gemm_phase<pg8::EpiRowBias, pg8::StaticOrder, true, true>(ring, g, S, E); }
        __syncthreads();
        { pg8::Gemm g{(const bf16*)(ws + WS_XB), (const bf16*)(ws + WS_WIN) + (size_t)NHY * DM, MTOK, NATT, DM}; pg8::StaticOrder S; S.init(MTOK, NATT, C.G, (int)blockIdx.x); S.reps = GREPS(1);
          pg8::EpiColBias E{(bf16*)(ws + WS_QKV), NATT, GIN(2) + NHY};
          pg8::gemm_phase<pg8::EpiColBias, pg8::StaticOrder, true, true>(ring, g, S, E); }
        __syncthreads();
        { pg8::Gemm g{(const bf16*)(ws + WS_W3T), (const bf16*)(ws + WS_H2), 4096, SEQ, 256}; pg8::StaticOrder S; S.init(4096, SEQ, C.G, (int)blockIdx.x); S.reps = GREPS(1);
          pg8::EpiFilt E{(bf16*)(ws + WS_FILT), SEQ, GIN(12)};
          pg8::gemm_phase<pg8::EpiFilt, pg8::StaticOrder, true, true>(ring, g, S, E); }
        __syncthreads();
    }
    SEAM(1); TSEC_E(101);
    TSEC_B(102);
    if (IN(2)) REPS(2) { LAUNDER_IN();
        p2_kpass(C, GIN(15), ws);
        for (int c = blockIdx.x; c < HYW; c += C.G) { hy_unit(c, GIN(3), GIN(4), GIN(13), ws, lds, (C.wave << 6) + (int)__builtin_amdgcn_mbcnt_hi(~0u, __builtin_amdgcn_mbcnt_lo(~0u, 0u)), tacc_); __syncthreads(); }
    }
    SEAM(2); TSEC_E(102);
    TSEC_B(103);
    if (IN(3)) REPS(3) { LAUNDER_IN();
        const bf16* QKV = (const bf16*)(ws + WS_QKV); const unsigned char* KP = ws + WS_KP; const unsigned char* VP = ws + WS_VP; bf16* YATT = (bf16*)(ws + WS_YATT);
        for (int rnd = 0; rnd * C.G < 1024; ++rnd) {
            int b, h, qb;
            if (C.G == 256) { const int xcd = blockIdx.x & 7, w = blockIdx.x >> 3, pair = xcd >> 1, idx = (xcd & 1) * 128 + rnd * 32 + w; b = pair >> 1; h = (pair & 1) * 4 + (idx >> 6); qb = idx & 63; }
            else { const int u = rnd * C.G + blockIdx.x; if (u >= 1024) break; b = u >> 9; h = (u >> 6) & 7; qb = u & 63; }
            const int kvh = h >> 2; const size_t m0 = (size_t)b * SEQ + qb * 256;
            att::attn_unit(QKV + m0 * NATT + h * 128, qb * 256, GIN(14), KP + (size_t)(b * 2 + kvh) * SEQ * 128, VP + (size_t)(b * 2 + kvh) * SEQ * 128, YATT + m0 * 1024 + h * 128, SEQ, (char*)lds);
        }
    }
    SEAM(3); TSEC_E(103);
    TSEC_B(104);
    if (IN(4)) REPS(4) { LAUNDER_IN(); p4_merge(C, GIN(16), GIN(17), ws); __syncthreads(); }
    SEAM(4); TSEC_E(104);
    TSEC_B(105);
    if (IN(5)) REPS(5) { LAUNDER_IN();
        pg8::Gemm g{(const bf16*)(ws + WS_MIX), (const bf16*)(ws + WS_WOUT), MTOK, DM, DM}; pg8::StaticOrder S; S.init(MTOK, DM, C.G, (int)blockIdx.x); S.reps = GREPS(5);
        pg8::EpiResid E{(bf16*)(ws + WS_T), DM, (const bf16*)(ws + WS_XB), DN_ALPHA};
        pg8::gemm_phase<pg8::EpiResid, pg8::StaticOrder, true, true>(ring, g, S, E);
        __syncthreads();
    }
    SEAM(5); TSEC_E(105);
    TSEC_B(106);
    if (IN(6)) REPS(6) { LAUNDER_IN(); p6_ln_router(C, GIN(19), GIN(20), GIN(21), GIN(22), ws); }
    SEAM(6); TSEC_E(106);
    TSEC_B(107);
    if (IN(7)) REPS(7) { LAUNDER_IN(); if (blockIdx.x >= 32) transpose_items(in, ws, (LAS float*)(C.lds + C.wave * 16384), C.lane, TI_SPLIT, TI_TOTAL, (int)(blockIdx.x - 32) * NWAVES + C.wave, (C.G - 32) * NWAVES); else { for (int be = blockIdx.x; be < BATCH * NE; be += C.G) p7_topk(C, be, ws); } }
    SEAM(7); TSEC_E(107);
    TSEC_B(109);
    if (IN(9)) REPS(9) { LAUNDER_IN();
        pg8::Gemm g{(const bf16*)(ws + WS_X8), (const bf16*)(ws + WS_WGU), MOE_ROWS, 3072, DM / 2}; pg8::GroupedOrder S; S.initg(12, C.G, (int)blockIdx.x); S.reps = GREPS(9);
        pg8::EpiSwiGLU8 E{ws + WS_HB, EFF, 12};
        struct MoeRows { const int* idx; __device__ __forceinline__ int row(int r) const { return ((r >> 11) & 1) * SEQ + idx[r]; } } Gt{(const int*)(ws + WS_IDX)};
        pg8::gemm_phase_g8<pg8::EpiSwiGLU8, pg8::GroupedOrder, MoeRows, true, true>(ring, g, S, E, Gt);
        __syncthreads();
    }
    SEAM(9); TSEC_E(109);
    TSEC_B(110);
    if (IN(10)) REPS(10) { LAUNDER_IN();
        pg8::Gemm g{(const bf16*)(ws + WS_HB), (const bf16*)(ws + WS_WD), MOE_ROWS, DM, EFF / 2}; pg8::GroupedOrder S; S.initg(8, C.G, (int)blockIdx.x); S.reps = GREPS(10);
        pg8::EpiRowScale E{ws + WS_Y, DM, (const float*)(ws + WS_GATE), 8};
        pg8::gemm_phase_8<pg8::EpiRowScale, pg8::GroupedOrder, 122, 124, true, true>(ring, g, S, E);
        __syncthreads();
    }
    SEAM(10); TSEC_E(110);
    TSEC_B(111);
    if (IN(11)) REPS(11) { LAUNDER_IN(); p11_final(C, GIN(26), GIN(27), args.out, ws); }
    TSEC_E(111);
    if (PROBE_SEC) { const unsigned long long te = __builtin_amdgcn_s_memrealtime(); while (__builtin_amdgcn_s_memrealtime() - te < tacc_) __builtin_amdgcn_s_sleep(8); }
#undef IN
#undef SEAM
}

extern "C" void kernel_launch(void* const* d_in, const int* in_sizes, int n_in, void* d_out, int out_size, void* d_ws, size_t ws_size, hipStream_t stream) {
    static int grid = 0;
    if (grid == 0) {
        if (n_in != 28 || in_sizes[0] != MTOK * DM || out_size != MTOK * DM || ws_size < WS_END) { fprintf(stderr, "kernel_launch: unexpected shapes (n_in %d, in0 %d, out %d, ws %zu < %zu)\n", n_in, n_in > 0 ? in_sizes[0] : -1, out_size, ws_size, (size_t)WS_END); grid = -1; return; }
        int dev = 0, cus = 0, per_cu = 0;
        if (hipGetDevice(&dev) != hipSuccess || hipDeviceGetAttribute(&cus, hipDeviceAttributeMultiprocessorCount, dev) != hipSuccess) { grid = -1; return; }
        if (hipFuncSetAttribute((const void*)mega_fwd, hipFuncAttributeMaxDynamicSharedMemorySize, LDS_BYTES) != hipSuccess) { fprintf(stderr, "kernel_launch: hipFuncSetAttribute failed\n"); grid = -1; return; }
        if (hipOccupancyMaxActiveBlocksPerMultiprocessor(&per_cu, (const void*)mega_fwd, NWAVES * 64, LDS_BYTES) != hipSuccess || per_cu < 1) { fprintf(stderr, "kernel_launch: occupancy query says %d\n", per_cu); }
        (void)hipGetLastError();
        grid = cus;
    }
    if (grid < 0) return;
    if (hipMemsetAsync((char*)d_ws + WS_CTL, 0, CTL_ZERO_BYTES, stream) != hipSuccess) return;
    Args a{};
    for (int i = 0; i < 28; ++i) a.in[i] = (const float*)d_in[i];
    a.out = (float*)d_out; a.ws = (unsigned char*)d_ws;
    for (int li = 0; li < N_LAUNCHES; ++li) {
        a.ph_lo = (N_LAUNCHES == 1) ? 0 : li; a.ph_hi = (N_LAUNCHES == 1) ? N_PHASES : li + 1;
        hipLaunchKernelGGL(mega_fwd, dim3(grid), dim3(NWAVES * 64), LDS_BYTES, stream, a);
    }
}
```

```cpp
#include <hip/hip_runtime.h>
#include <cstdio>
#include <cstdint>
namespace pg8 {
#define PG8_LAS __attribute__((address_space(3)))
typedef unsigned short bf16_t;
typedef short bf16x8 __attribute__((ext_vector_type(8)));
typedef float f32x4 __attribute__((ext_vector_type(4)));
typedef unsigned u32x4 __attribute__((ext_vector_type(4)));
constexpr int BM = 256, BK = 64, HALF = 128, HTB = HALF * BK * 2  , STAGE_BYTES = 8 * HTB, NXCD = 8, WGM = 8;

__host__ __device__ __forceinline__ int lds_byte(int r, int c) { const int st = (r >> 4) * 2 + (c >> 5), rr = r & 15, cc = c & 31, ob = rr * 64 + cc * 2; return st * 1024 + (ob ^ (((ob >> 9) & 1) << 5)); }
__host__ __device__ __forceinline__ void stage_rc(int b, int& R, int& C) { const int st = b / 1024, sb = b % 1024, swz = sb ^ (((sb >> 9) & 1) << 5); R = (st >> 1) * 16 + swz / 64; C = (st & 1) * 32 + (swz % 64) / 2; }
__host__ __device__ __forceinline__ int perm32(int rho) { const int n = rho >> 4, i = rho & 15; return 8 * (i >> 2) + 4 * n + (i & 3); }

struct Unit { int pm, pn; };
struct Gemm { const bf16_t* A; const bf16_t* Bt; int M, N, K; };

struct StaticOrder {
    int nM, nN, nwg, G, c, reps;
    __host__ __device__ void init(int M, int N, int G_, int c_) { nM = M / BM; nN = N / BM; nwg = nM * nN; G = G_; c = c_; reps = 1; }
    __host__ __device__ bool next(int i, Unit& u) const {
        long L = (long)i * G + c; if (L >= (long)nwg * reps) return false; L %= nwg;
        int wgid = (int)L; { const int q = nwg / NXCD, r = nwg % NXCD, xcd = wgid % NXCD, off = wgid / NXCD; wgid = (xcd < r ? xcd * (q + 1) : r * (q + 1) + (xcd - r) * q) + off; }
        const int nig = WGM * nN, gid = wgid / nig, fm = gid * WGM, gsz = (nM - fm) < WGM ? (nM - fm) : WGM;
        u.pm = fm + ((wgid % nig) % gsz); u.pn = (wgid % nig) / gsz; return true;
    }
    __device__ __forceinline__ void a_ready(const Unit&) const {}
    __device__ __forceinline__ void done(const Unit&) const {}
};

__device__ __forceinline__ unsigned cvt_pk_bf16(float lo, float hi) { unsigned r; asm volatile("v_cvt_pk_bf16_f32 %0, %1, %2" : "=v"(r) : "v"(lo), "v"(hi)); return r; }
template <class Epi, class Sched, bool ALIGN_EPI = false, bool SP2 = false>
__device__ __forceinline__ void gemm_phase(PG8_LAS unsigned char* lds, const Gemm g, const Sched& S, const Epi& E) {
    const int tid = threadIdx.x, wid = __builtin_amdgcn_readfirstlane(tid >> 6), lane = tid & 63, wr = wid >> 2, wc = wid & 3, fr = lane & 15, fq = lane >> 4;
    const int K = g.K, nt = K / BK;
    unsigned voffA[2], voffB[2];
#pragma unroll
    for (int i = 0; i < 2; ++i) { int R, C; stage_rc(tid * 16 + i * 8192, R, C); const int Rb = Epi::PERM ? ((R & ~31) + perm32(R & 31)) : R;
        voffA[i] = (unsigned)(R * K + C) * 2u; voffB[i] = (unsigned)(Rb * K + C) * 2u; }
    const size_t kstep = (size_t)(BK * 2);
    const size_t hstep = (size_t)HALF * K * 2;
    const size_t tstep = 2 * hstep;
    const unsigned ldsw = (unsigned)wid * 1024u;
    const int aoff = lds_byte(wr * 64 + fr, fq * 8), boff = lds_byte(wc * 32 + fr, fq * 8);
#define PG8_SA(b, h) (((b) * 2 + (h)) * HTB)
#define PG8_SB(b, h) ((4 + (b) * 2 + (h)) * HTB)
#define PG8_STAGE(bufoff, gbase, voff) do { _Pragma("unroll") for (int _i = 0; _i < 2; ++_i) \
        __builtin_amdgcn_global_load_lds((const unsigned*)((const char*)(gbase) + (voff)[_i]), (PG8_LAS unsigned*)(lds + (bufoff) + ldsw + _i * 8192), 16, 0, 0); } while (0)
#define PG8_LDA(dst, b, h) do { _Pragma("unroll") for (int m = 0; m < 4; ++m) _Pragma("unroll") for (int k = 0; k < 2; ++k) dst[m][k] = *(const PG8_LAS bf16x8*)(lds + PG8_SA(b, h) + aoff + m * 2048 + k * 1024); } while (0)
#define PG8_LDB(dst, b, h) do { _Pragma("unroll") for (int n = 0; n < 2; ++n) _Pragma("unroll") for (int k = 0; k < 2; ++k) dst[n][k] = *(const PG8_LAS bf16x8*)(lds + PG8_SB(b, h) + boff + n * 2048 + k * 1024); } while (0)
#define PG8_MMA(ai, bj, At, Bt) do { __builtin_amdgcn_s_setprio(1); _Pragma("unroll") for (int m = 0; m < 4; ++m) _Pragma("unroll") for (int n = 0; n < 2; ++n) _Pragma("unroll") for (int k = 0; k < 2; ++k) \
        acc[ai][bj][m][n] = __builtin_amdgcn_mfma_f32_16x16x32_bf16(Bt[n][k], At[m][k], acc[ai][bj][m][n], 0, 0, 0); __builtin_amdgcn_s_setprio(0); } while (0)
#define PG8_WAIT_V(n) asm volatile("s_waitcnt vmcnt(" #n ")" ::: "memory")
#define PG8_WAIT_L(n) asm volatile("s_waitcnt lgkmcnt(" #n ")" ::: "memory")
#define PG8_BAR __builtin_amdgcn_s_barrier()
#define PG8_SCHED __builtin_amdgcn_sched_barrier(0)
    Unit cur, nxt; int ui = 0;
    if (!S.next(0, cur)) return;
    f32x4 acc[2][2][4][2];
#pragma unroll
    for (int a = 0; a < 2; ++a)
#pragma unroll
        for (int b = 0; b < 2; ++b)
#pragma unroll
            for (int m = 0; m < 4; ++m)
#pragma unroll
                for (int n = 0; n < 2; ++n) acc[a][b][m][n] = (f32x4){0.f, 0.f, 0.f, 0.f};
    bf16x8 At[4][2], B0[2][2], B1[2][2];
    const char* cA = (const char*)g.A + (size_t)cur.pm * tstep; const char* cB = (const char*)g.Bt + (size_t)cur.pn * tstep;
    S.a_ready(cur);
    if constexpr (SP2) {
        PG8_STAGE(PG8_SB(0, 0), cB, voffB); PG8_STAGE(PG8_SB(0, 1), cB + hstep, voffB); PG8_STAGE(PG8_SA(0, 0), cA, voffA); PG8_STAGE(PG8_SA(0, 1), cA + hstep, voffA);
        if (wr == 1) PG8_BAR;
        PG8_WAIT_V(2); PG8_BAR;
        PG8_STAGE(PG8_SB(1, 0), cB + kstep, voffB); PG8_STAGE(PG8_SA(1, 0), cA + kstep, voffA); PG8_STAGE(PG8_SB(1, 1), cB + hstep + kstep, voffB);
        PG8_WAIT_V(6); PG8_BAR;
    } else {
        PG8_STAGE(PG8_SB(0, 0), cB, voffB); PG8_STAGE(PG8_SA(0, 0), cA, voffA); PG8_STAGE(PG8_SB(0, 1), cB + hstep, voffB); PG8_STAGE(PG8_SA(0, 1), cA + hstep, voffA);
        if (wr == 1) PG8_BAR;
        PG8_WAIT_V(4); PG8_BAR;
        PG8_STAGE(PG8_SB(1, 0), cB + kstep, voffB); PG8_STAGE(PG8_SA(1, 0), cA + kstep, voffA); PG8_STAGE(PG8_SB(1, 1), cB + hstep + kstep, voffB);
        PG8_WAIT_V(6); PG8_BAR;
    }
    for (;;) {
        const bool has_next = S.next(ui + 1, nxt);
        const char* nA = has_next ? (const char*)g.A + (size_t)nxt.pm * tstep : cA; const char* nB = has_next ? (const char*)g.Bt + (size_t)nxt.pn * tstep : cB;
        for (int t = 0; t < nt; t += 2) {
            const bool last = (t == nt - 2);
            const char* a1 = cA + (size_t)(t + 1) * kstep;
            const char* a2 = last ? nA : cA + (size_t)(t + 2) * kstep; const char* b2 = last ? nB : cB + (size_t)(t + 2) * kstep;
            const char* a3 = a2 + kstep; const char* b3 = b2 + kstep;
            if (last && has_next) S.a_ready(nxt);
            if constexpr (SP2) {
            PG8_LDB(B0, 0, 0); PG8_LDB(B1, 0, 1); PG8_SCHED; PG8_LDA(At, 0, 0); PG8_STAGE(PG8_SA(1, 1), a1 + hstep, voffA);
            PG8_WAIT_V(8); PG8_WAIT_L(0); PG8_BAR; PG8_MMA(0, 0, At, B0); PG8_MMA(0, 1, At, B1); PG8_BAR; PG8_SCHED;
            PG8_LDA(At, 0, 1); PG8_STAGE(PG8_SB(0, 0), b2, voffB); PG8_STAGE(PG8_SB(0, 1), b2 + hstep, voffB); PG8_STAGE(PG8_SA(0, 0), a2, voffA);
            PG8_WAIT_V(8); PG8_WAIT_L(0); PG8_BAR; PG8_MMA(1, 0, At, B0); PG8_MMA(1, 1, At, B1); PG8_BAR; PG8_SCHED;
            PG8_LDB(B0, 1, 0); PG8_LDB(B1, 1, 1); PG8_SCHED; PG8_LDA(At, 1, 0); PG8_STAGE(PG8_SA(0, 1), a2 + hstep, voffA);
            PG8_WAIT_V(8); PG8_WAIT_L(0); PG8_BAR; PG8_MMA(0, 0, At, B0); PG8_MMA(0, 1, At, B1); PG8_BAR; PG8_SCHED;
            PG8_LDA(At, 1, 1); PG8_STAGE(PG8_SB(1, 0), b3, voffB); PG8_STAGE(PG8_SB(1, 1), b3 + hstep, voffB); PG8_STAGE(PG8_SA(1, 0), a3, voffA);
            PG8_WAIT_V(8); PG8_WAIT_L(0); PG8_BAR; PG8_MMA(1, 0, At, B0); PG8_MMA(1, 1, At, B1); PG8_BAR; PG8_SCHED;
            } else {
            PG8_LDB(B0, 0, 0); PG8_SCHED; PG8_LDA(At, 0, 0); PG8_STAGE(PG8_SA(1, 1), a1 + hstep, voffA);
            PG8_WAIT_L(8); PG8_BAR; PG8_WAIT_L(0); PG8_MMA(0, 0, At, B0); PG8_BAR; PG8_SCHED;
            PG8_LDB(B1, 0, 1); PG8_STAGE(PG8_SB(0, 0), b2, voffB);
            PG8_BAR; PG8_WAIT_L(0); PG8_MMA(0, 1, At, B1); PG8_BAR;
            PG8_LDA(At, 0, 1); PG8_STAGE(PG8_SA(0, 0), a2, voffA);
            PG8_BAR; PG8_WAIT_L(0); PG8_MMA(1, 0, At, B0); PG8_BAR; PG8_SCHED;
            PG8_STAGE(PG8_SB(0, 1), b2 + hstep, voffB);
            PG8_WAIT_V(6); PG8_BAR; PG8_MMA(1, 1, At, B1); PG8_BAR;
            PG8_LDB(B0, 1, 0); PG8_SCHED; PG8_LDA(At, 1, 0); PG8_STAGE(PG8_SA(0, 1), a2 + hstep, voffA);
            PG8_WAIT_L(8); PG8_BAR; PG8_WAIT_L(0); PG8_MMA(0, 0, At, B0); PG8_BAR; PG8_SCHED;
            PG8_LDB(B1, 1, 1); PG8_STAGE(PG8_SB(1, 0), b3, voffB);
            PG8_BAR; PG8_WAIT_L(0); PG8_MMA(0, 1, At, B1); PG8_BAR;
            PG8_LDA(At, 1, 1); PG8_STAGE(PG8_SA(1, 0), a3, voffA);
            PG8_BAR; PG8_WAIT_L(0); PG8_MMA(1, 0, At, B0); PG8_BAR; PG8_SCHED;
            PG8_STAGE(PG8_SB(1, 1), b3 + hstep, voffB);
            PG8_WAIT_V(6); PG8_BAR; PG8_MMA(1, 1, At, B1); PG8_BAR;
            }
        }
        if constexpr (ALIGN_EPI) { if (wr == 0) PG8_BAR; }
        if constexpr (!Epi::AFTER_DRAIN) { E(acc, cur, wr, wc, fr, fq); S.done(cur); }
        if (!has_next) break;
#pragma unroll
        for (int a = 0; a < 2; ++a)
#pragma unroll
            for (int b = 0; b < 2; ++b)
#pragma unroll
                for (int m = 0; m < 4; ++m)
#pragma unroll
                    for (int n = 0; n < 2; ++n) acc[a][b][m][n] = (f32x4){0.f, 0.f, 0.f, 0.f};
        cur = nxt; cA = nA; cB = nB; ++ui;
        if constexpr (ALIGN_EPI) { if (wr == 1) PG8_BAR; }
    }
    PG8_WAIT_V(0);
    if constexpr (!ALIGN_EPI) { if (wr == 0) PG8_BAR; }
    PG8_BAR;
    if constexpr (Epi::AFTER_DRAIN) { E.fused(acc, cur, wr, wc, fr, fq, lds, wid, lane); S.done(cur); }
#undef PG8_SA
#undef PG8_SB
#undef PG8_STAGE
#undef PG8_LDA
#undef PG8_LDB
#undef PG8_MMA
#undef PG8_WAIT_V
#undef PG8_WAIT_L
#undef PG8_BAR
#undef PG8_SCHED
}
}
namespace pg8 {
typedef int v4i_t __attribute__((ext_vector_type(4)));
typedef int v8i_t __attribute__((ext_vector_type(8)));
__device__ __forceinline__ v8i_t cat32(bf16x8 lo, bf16x8 hi) { const v4i_t a = __builtin_bit_cast(v4i_t, lo), b = __builtin_bit_cast(v4i_t, hi); return __builtin_shufflevector(a, b, 0, 1, 2, 3, 4, 5, 6, 7); }
template <class Epi, class Sched, class Gth, bool ALIGN_EPI = false, bool SP2 = true>
__device__ __forceinline__ void gemm_phase_g8(PG8_LAS unsigned char* lds, const Gemm g, const Sched& S, const Epi& E, const Gth& Gt) {
    static_assert(SP2, "gemm_phase_g8: SP2 loop only");
    const int tid = threadIdx.x, wid = __builtin_amdgcn_readfirstlane(tid >> 6), lane = tid & 63, wr = wid >> 2, wc = wid & 3, fr = lane & 15, fq = lane >> 4;
    const int K = g.K, nt = K / BK;
    unsigned voffA[2], voffB[2]; int Rr[2], Cc[2];
#pragma unroll
    for (int i = 0; i < 2; ++i) { int R, C; stage_rc(tid * 16 + i * 8192, R, C); const int Rb = Epi::PERM ? ((R & ~31) + perm32(R & 31)) : R;
        voffA[i] = (unsigned)(R * K + C) * 2u; voffB[i] = (unsigned)(Rb * K + C) * 2u; Rr[i] = R; Cc[i] = C; }
    (void)voffA;
    unsigned gC[2][2], gN[2][2];
#define PG8_GFILL(dst, pm_) do { _Pragma("unroll") for (int h_ = 0; h_ < 2; ++h_) _Pragma("unroll") for (int i_ = 0; i_ < 2; ++i_) dst[h_][i_] = (unsigned)Gt.row((pm_) * BM + h_ * HALF + Rr[i_]) * (unsigned)(K * 2) + (unsigned)(Cc[i_] * 2); } while (0)
    const size_t kstep = (size_t)(BK * 2);
    const size_t hstep = (size_t)HALF * K * 2;
    const size_t tstep = 2 * hstep;
    const unsigned ldsw = (unsigned)wid * 1024u;
    const int aoff = lds_byte(wr * 64 + fr, fq * 8), boff = lds_byte(wc * 32 + fr, fq * 8);
#define PG8_SA(b, h) (((b) * 2 + (h)) * HTB)
#define PG8_SB(b, h) ((4 + (b) * 2 + (h)) * HTB)
#define PG8_STAGE(bufoff, gbase, voff) do { _Pragma("unroll") for (int _i = 0; _i < 2; ++_i) \
        __builtin_amdgcn_global_load_lds((const unsigned*)((const char*)(gbase) + (voff)[_i]), (PG8_LAS unsigned*)(lds + (bufoff) + ldsw + _i * 8192), 16, 0, 0); } while (0)
#define PG8_LDA(dst, b, h) do { _Pragma("unroll") for (int m = 0; m < 4; ++m) dst[m] = cat32(*(const PG8_LAS bf16x8*)(lds + PG8_SA(b, h) + aoff + m * 2048), *(const PG8_LAS bf16x8*)(lds + PG8_SA(b, h) + aoff + m * 2048 + 1024)); } while (0)
#define PG8_LDB(dst, b, h) do { _Pragma("unroll") for (int n = 0; n < 2; ++n) dst[n] = cat32(*(const PG8_LAS bf16x8*)(lds + PG8_SB(b, h) + boff + n * 2048), *(const PG8_LAS bf16x8*)(lds + PG8_SB(b, h) + boff + n * 2048 + 1024)); } while (0)
#define PG8_MMA(ai, bj, At, Bt) do { __builtin_amdgcn_s_setprio(1); _Pragma("unroll") for (int m = 0; m < 4; ++m) _Pragma("unroll") for (int n = 0; n < 2; ++n) \
        asm volatile("v_mfma_scale_f32_16x16x128_f8f6f4 %0, %1, %2, %0, %3, %4 op_sel_hi:[0,0,0]" : "+v"(acc[ai][bj][m][n]) : "v"(Bt[n]), "v"(At[m]), "v"(scw), "v"(sca)); __builtin_amdgcn_s_setprio(0); } while (0)
#define PG8_WAIT_V(n) asm volatile("s_waitcnt vmcnt(" #n ")" ::: "memory")
#define PG8_WAIT_L(n) asm volatile("s_waitcnt lgkmcnt(" #n ")" ::: "memory")
#define PG8_BAR __builtin_amdgcn_s_barrier()
#define PG8_SCHED __builtin_amdgcn_sched_barrier(0)
    Unit cur, nxt; int ui = 0;
    if (!S.next(0, cur)) return;
    f32x4 acc[2][2][4][2];
#pragma unroll
    for (int a = 0; a < 2; ++a)
#pragma unroll
        for (int b = 0; b < 2; ++b)
#pragma unroll
            for (int m = 0; m < 4; ++m)
#pragma unroll
                for (int n = 0; n < 2; ++n) acc[a][b][m][n] = (f32x4){0.f, 0.f, 0.f, 0.f};
    v8i_t At[4], B0[2], B1[2]; const int scw = 0x7a7a7a7a, sca = 0x7f7f7f7f;
    const char* Ab = (const char*)g.A; const char* cB = (const char*)g.Bt + (size_t)cur.pn * tstep;
    PG8_GFILL(gC, cur.pm);
    S.a_ready(cur);
    if constexpr (SP2) {
        PG8_STAGE(PG8_SB(0, 0), cB, voffB); PG8_STAGE(PG8_SB(0, 1), cB + hstep, voffB); PG8_STAGE(PG8_SA(0, 0), Ab, gC[0]); PG8_STAGE(PG8_SA(0, 1), Ab, gC[1]);
        if (wr == 1) PG8_BAR;
        PG8_WAIT_V(2); PG8_BAR;
        PG8_STAGE(PG8_SB(1, 0), cB + kstep, voffB); PG8_STAGE(PG8_SA(1, 0), Ab + kstep, gC[0]); PG8_STAGE(PG8_SB(1, 1), cB + hstep + kstep, voffB);
        PG8_WAIT_V(6); PG8_BAR;
    }
    for (;;) {
        const bool has_next = S.next(ui + 1, nxt);
        const char* nB = has_next ? (const char*)g.Bt + (size_t)nxt.pn * tstep : cB;
        if (has_next) PG8_GFILL(gN, nxt.pm); else { gN[0][0] = gC[0][0]; gN[0][1] = gC[0][1]; gN[1][0] = gC[1][0]; gN[1][1] = gC[1][1]; }
        for (int t = 0; t < nt; t += 2) {
            const bool last = (t == nt - 2);
            const char* a1 = Ab + (size_t)(t + 1) * kstep;
            const char* a2 = last ? Ab : Ab + (size_t)(t + 2) * kstep; const char* b2 = last ? nB : cB + (size_t)(t + 2) * kstep;
            unsigned g2[2][2];
#pragma unroll
            for (int h_ = 0; h_ < 2; ++h_)
#pragma unroll
                for (int i_ = 0; i_ < 2; ++i_) g2[h_][i_] = last ? gN[h_][i_] : gC[h_][i_];
            const char* a3 = a2 + kstep; const char* b3 = b2 + kstep;
            if (last && has_next) S.a_ready(nxt);
            if constexpr (SP2) {
            PG8_LDB(B0, 0, 0); PG8_LDB(B1, 0, 1); PG8_SCHED; PG8_LDA(At, 0, 0); PG8_STAGE(PG8_SA(1, 1), a1, gC[1]);
            PG8_WAIT_V(8); PG8_WAIT_L(0); PG8_BAR; PG8_MMA(0, 0, At, B0); PG8_MMA(0, 1, At, B1); PG8_BAR; PG8_SCHED;
            PG8_LDA(At, 0, 1); PG8_STAGE(PG8_SB(0, 0), b2, voffB); PG8_STAGE(PG8_SB(0, 1), b2 + hstep, voffB); PG8_STAGE(PG8_SA(0, 0), a2, g2[0]);
            PG8_WAIT_V(8); PG8_WAIT_L(0); PG8_BAR; PG8_MMA(1, 0, At, B0); PG8_MMA(1, 1, At, B1); PG8_BAR; PG8_SCHED;
            PG8_LDB(B0, 1, 0); PG8_LDB(B1, 1, 1); PG8_SCHED; PG8_LDA(At, 1, 0); PG8_STAGE(PG8_SA(0, 1), a2, g2[1]);
            PG8_WAIT_V(8); PG8_WAIT_L(0); PG8_BAR; PG8_MMA(0, 0, At, B0); PG8_MMA(0, 1, At, B1); PG8_BAR; PG8_SCHED;
            PG8_LDA(At, 1, 1); PG8_STAGE(PG8_SB(1, 0), b3, voffB); PG8_STAGE(PG8_SB(1, 1), b3 + hstep, voffB); PG8_STAGE(PG8_SA(1, 0), a3, g2[0]);
            PG8_WAIT_V(8); PG8_WAIT_L(0); PG8_BAR; PG8_MMA(1, 0, At, B0); PG8_MMA(1, 1, At, B1); PG8_BAR; PG8_SCHED;
            }
        }
        asm volatile("s_nop 15\n\ts_nop 15\n\ts_nop 15" ::: "memory");
        if constexpr (ALIGN_EPI) { if (wr == 0) PG8_BAR; }
        if constexpr (!Epi::AFTER_DRAIN) { E(acc, cur, wr, wc, fr, fq); S.done(cur); }
        if (!has_next) break;
#pragma unroll
        for (int a = 0; a < 2; ++a)
#pragma unroll
            for (int b = 0; b < 2; ++b)
#pragma unroll
                for (int m = 0; m < 4; ++m)
#pragma unroll
                    for (int n = 0; n < 2; ++n) acc[a][b][m][n] = (f32x4){0.f, 0.f, 0.f, 0.f};
        cur = nxt; cB = nB; ++ui; gC[0][0] = gN[0][0]; gC[0][1] = gN[0][1]; gC[1][0] = gN[1][0]; gC[1][1] = gN[1][1];
        if constexpr (ALIGN_EPI) { if (wr == 1) PG8_BAR; }
    }
    PG8_WAIT_V(0);
    if constexpr (!ALIGN_EPI) { if (wr == 0) PG8_BAR; }
    PG8_BAR;
    if constexpr (Epi::AFTER_DRAIN) { E.fused(acc, cur, wr, wc, fr, fq, lds, wid, lane); S.done(cur); }
#undef PG8_SA
#undef PG8_SB
#undef PG8_STAGE
#undef PG8_LDA
#undef PG8_LDB
#undef PG8_MMA
#undef PG8_WAIT_V
#undef PG8_WAIT_L
#undef PG8_BAR
#undef PG8_SCHED
#undef PG8_GFILL
}


}
namespace pg8 {
template <class Epi, class Sched, int SCW, int SCA, bool ALIGN_EPI = false, bool SP2 = true>
__device__ __forceinline__ void gemm_phase_8(PG8_LAS unsigned char* lds, const Gemm g, const Sched& S, const Epi& E) {
    static_assert(SP2, "gemm_phase_8: SP2 loop only");
    const int tid = threadIdx.x, wid = __builtin_amdgcn_readfirstlane(tid >> 6), lane = tid & 63, wr = wid >> 2, wc = wid & 3, fr = lane & 15, fq = lane >> 4;
    const int K = g.K, nt = K / BK;
    unsigned voffA[2], voffB[2];
#pragma unroll
    for (int i = 0; i < 2; ++i) { int R, C; stage_rc(tid * 16 + i * 8192, R, C); const int Rb = Epi::PERM ? ((R & ~31) + perm32(R & 31)) : R;
        voffA[i] = (unsigned)(R * K + C) * 2u; voffB[i] = (unsigned)(Rb * K + C) * 2u; }
    const size_t kstep = (size_t)(BK * 2);
    const size_t hstep = (size_t)HALF * K * 2;
    const size_t tstep = 2 * hstep;
    const unsigned ldsw = (unsigned)wid * 1024u;
    const int aoff = lds_byte(wr * 64 + fr, fq * 8), boff = lds_byte(wc * 32 + fr, fq * 8);
#define PG8_SA(b, h) (((b) * 2 + (h)) * HTB)
#define PG8_SB(b, h) ((4 + (b) * 2 + (h)) * HTB)
#define PG8_STAGE(bufoff, gbase, voff) do { _Pragma("unroll") for (int _i = 0; _i < 2; ++_i) \
        __builtin_amdgcn_global_load_lds((const unsigned*)((const char*)(gbase) + (voff)[_i]), (PG8_LAS unsigned*)(lds + (bufoff) + ldsw + _i * 8192), 16, 0, 0); } while (0)
#define PG8_LDA(dst, b, h) do { _Pragma("unroll") for (int m = 0; m < 4; ++m) dst[m] = cat32(*(const PG8_LAS bf16x8*)(lds + PG8_SA(b, h) + aoff + m * 2048), *(const PG8_LAS bf16x8*)(lds + PG8_SA(b, h) + aoff + m * 2048 + 1024)); } while (0)
#define PG8_LDB(dst, b, h) do { _Pragma("unroll") for (int n = 0; n < 2; ++n) dst[n] = cat32(*(const PG8_LAS bf16x8*)(lds + PG8_SB(b, h) + boff + n * 2048), *(const PG8_LAS bf16x8*)(lds + PG8_SB(b, h) + boff + n * 2048 + 1024)); } while (0)
#define PG8_MMA(ai, bj, At, Bt) do { __builtin_amdgcn_s_setprio(1); _Pragma("unroll") for (int m = 0; m < 4; ++m) _Pragma("unroll") for (int n = 0; n < 2; ++n) \
        asm volatile("v_mfma_scale_f32_16x16x128_f8f6f4 %0, %1, %2, %0, %3, %4 op_sel_hi:[0,0,0]" : "+v"(acc[ai][bj][m][n]) : "v"(Bt[n]), "v"(At[m]), "v"(scw), "v"(sca)); __builtin_amdgcn_s_setprio(0); } while (0)
#define PG8_WAIT_V(n) asm volatile("s_waitcnt vmcnt(" #n ")" ::: "memory")
#define PG8_WAIT_L(n) asm volatile("s_waitcnt lgkmcnt(" #n ")" ::: "memory")
#define PG8_BAR __builtin_amdgcn_s_barrier()
#define PG8_SCHED __builtin_amdgcn_sched_barrier(0)
    Unit cur, nxt; int ui = 0;
    if (!S.next(0, cur)) return;
    f32x4 acc[2][2][4][2];
#pragma unroll
    for (int a = 0; a < 2; ++a)
#pragma unroll
        for (int b = 0; b < 2; ++b)
#pragma unroll
            for (int m = 0; m < 4; ++m)
#pragma unroll
                for (int n = 0; n < 2; ++n) acc[a][b][m][n] = (f32x4){0.f, 0.f, 0.f, 0.f};
    v8i_t At[4], B0[2], B1[2]; const int scw = SCW * 0x01010101, sca = SCA * 0x01010101;
    const char* cA = (const char*)g.A + (size_t)cur.pm * tstep; const char* cB = (const char*)g.Bt + (size_t)cur.pn * tstep;
    S.a_ready(cur);
    if constexpr (SP2) {
        PG8_STAGE(PG8_SB(0, 0), cB, voffB); PG8_STAGE(PG8_SB(0, 1), cB + hstep, voffB); PG8_STAGE(PG8_SA(0, 0), cA, voffA); PG8_STAGE(PG8_SA(0, 1), cA + hstep, voffA);
        if (wr == 1) PG8_BAR;
        PG8_WAIT_V(2); PG8_BAR;
        PG8_STAGE(PG8_SB(1, 0), cB + kstep, voffB); PG8_STAGE(PG8_SA(1, 0), cA + kstep, voffA); PG8_STAGE(PG8_SB(1, 1), cB + hstep + kstep, voffB);
        PG8_WAIT_V(6); PG8_BAR;
    }
    for (;;) {
        const bool has_next = S.next(ui + 1, nxt);
        const char* nA = has_next ? (const char*)g.A + (size_t)nxt.pm * tstep : cA; const char* nB = has_next ? (const char*)g.Bt + (size_t)nxt.pn * tstep : cB;
        for (int t = 0; t < nt; t += 2) {
            const bool last = (t == nt - 2);
            const char* a1 = cA + (size_t)(t + 1) * kstep;
            const char* a2 = last ? nA : cA + (size_t)(t + 2) * kstep; const char* b2 = last ? nB : cB + (size_t)(t + 2) * kstep;
            const char* a3 = a2 + kstep; const char* b3 = b2 + kstep;
            if (last && has_next) S.a_ready(nxt);
            if constexpr (SP2) {
            PG8_LDB(B0, 0, 0); PG8_LDB(B1, 0, 1); PG8_SCHED; PG8_LDA(At, 0, 0); PG8_STAGE(PG8_SA(1, 1), a1 + hstep, voffA);
            PG8_WAIT_V(8); PG8_WAIT_L(0); PG8_BAR; PG8_MMA(0, 0, At, B0); PG8_MMA(0, 1, At, B1); PG8_BAR; PG8_SCHED;
            PG8_LDA(At, 0, 1); PG8_STAGE(PG8_SB(0, 0), b2, voffB); PG8_STAGE(PG8_SB(0, 1), b2 + hstep, voffB); PG8_STAGE(PG8_SA(0, 0), a2, voffA);
            PG8_WAIT_V(8); PG8_WAIT_L(0); PG8_BAR; PG8_MMA(1, 0, At, B0); PG8_MMA(1, 1, At, B1); PG8_BAR; PG8_SCHED;
            PG8_LDB(B0, 1, 0); PG8_LDB(B1, 1, 1); PG8_SCHED; PG8_LDA(At, 1, 0); PG8_STAGE(PG8_SA(0, 1), a2 + hstep, voffA);
            PG8_WAIT_V(8); PG8_WAIT_L(0); PG8_BAR; PG8_MMA(0, 0, At, B0); PG8_MMA(0, 1, At, B1); PG8_BAR; PG8_SCHED;
            PG8_LDA(At, 1, 1); PG8_STAGE(PG8_SB(1, 0), b3, voffB); PG8_STAGE(PG8_SB(1, 1), b3 + hstep, voffB); PG8_STAGE(PG8_SA(1, 0), a3, voffA);
            PG8_WAIT_V(8); PG8_WAIT_L(0); PG8_BAR; PG8_MMA(1, 0, At, B0); PG8_MMA(1, 1, At, B1); PG8_BAR; PG8_SCHED;
            }
        }
        asm volatile("s_nop 15\n\ts_nop 15\n\ts_nop 15" ::: "memory");
        if constexpr (ALIGN_EPI) { if (wr == 0) PG8_BAR; }
        if constexpr (!Epi::AFTER_DRAIN) { E(acc, cur, wr, wc, fr, fq); S.done(cur); }
        if (!has_next) break;
#pragma unroll
        for (int a = 0; a < 2; ++a)
#pragma unroll
            for (int b = 0; b < 2; ++b)
#pragma unroll
                for (int m = 0; m < 4; ++m)
#pragma unroll
                    for (int n = 0; n < 2; ++n) acc[a][b][m][n] = (f32x4){0.f, 0.f, 0.f, 0.f};
        cur = nxt; cA = nA; cB = nB; ++ui;
        if constexpr (ALIGN_EPI) { if (wr == 1) PG8_BAR; }
    }
    PG8_WAIT_V(0);
    if constexpr (!ALIGN_EPI) { if (wr == 0) PG8_BAR; }
    PG8_BAR;
    if constexpr (Epi::AFTER_DRAIN) { E.fused(acc, cur, wr, wc, fr, fq, lds, wid, lane); S.done(cur); }
#undef PG8_SA
#undef PG8_SB
#undef PG8_STAGE
#undef PG8_LDA
#undef PG8_LDB
#undef PG8_MMA
#undef PG8_WAIT_V
#undef PG8_WAIT_L
#undef PG8_BAR
#undef PG8_SCHED
}


}
namespace pg8 {
__device__ __forceinline__ u32x4 pack8(f32x4 v0, f32x4 v1) { u32x4 w; w.x = cvt_pk_bf16(v0[0], v0[1]); w.y = cvt_pk_bf16(v0[2], v0[3]); w.z = cvt_pk_bf16(v1[0], v1[1]); w.w = cvt_pk_bf16(v1[2], v1[3]); return w; }
struct EpiColBias {
    static constexpr bool PERM = true, AFTER_DRAIN = false;
    bf16_t* O; int ldc; const float* bias;
    __device__ __forceinline__ void operator()(const f32x4 (&acc)[2][2][4][2], const Unit& u, int wr, int wc, int fr, int fq) const {
        const int row0 = u.pm * BM + wr * 64 + fr, col0 = u.pn * BM + wc * 32 + 8 * fq;
        f32x4 bv[2][2];
#pragma unroll
        for (int bj = 0; bj < 2; ++bj)
#pragma unroll
            for (int n = 0; n < 2; ++n) bv[bj][n] = *(const f32x4*)(bias + col0 + bj * HALF + 4 * n);
#pragma unroll
        for (int ai = 0; ai < 2; ++ai)
#pragma unroll
            for (int m = 0; m < 4; ++m) { bf16_t* rowp = O + (size_t)(row0 + ai * HALF + m * 16) * ldc + col0;
#pragma unroll
                for (int bj = 0; bj < 2; ++bj) *(u32x4*)(rowp + bj * HALF) = pack8(acc[ai][bj][m][0] + bv[bj][0], acc[ai][bj][m][1] + bv[bj][1]); }
    }
};
struct EpiRowBias {
    static constexpr bool PERM = true, AFTER_DRAIN = false;
    bf16_t* O; int ldc; const float* bias;
    __device__ __forceinline__ void operator()(const f32x4 (&acc)[2][2][4][2], const Unit& u, int wr, int wc, int fr, int fq) const {
        const int row0 = u.pm * BM + wr * 64 + fr, col0 = u.pn * BM + wc * 32 + 8 * fq;
#pragma unroll
        for (int ai = 0; ai < 2; ++ai)
#pragma unroll
            for (int m = 0; m < 4; ++m) { const int row = row0 + ai * HALF + m * 16; const float b = bias[row]; bf16_t* rowp = O + (size_t)row * ldc + col0;
#pragma unroll
                for (int bj = 0; bj < 2; ++bj) *(u32x4*)(rowp + bj * HALF) = pack8(acc[ai][bj][m][0] + b, acc[ai][bj][m][1] + b); }
    }
};
struct EpiFilt {
    static constexpr bool PERM = true, AFTER_DRAIN = false;
    bf16_t* O; int ldc; const float* decay;
    __device__ __forceinline__ void operator()(const f32x4 (&acc)[2][2][4][2], const Unit& u, int wr, int wc, int fr, int fq) const {
        const int row0 = u.pm * BM + wr * 64 + fr, col0 = u.pn * BM + wc * 32 + 8 * fq;
#pragma unroll
        for (int ai = 0; ai < 2; ++ai)
#pragma unroll
            for (int m = 0; m < 4; ++m) { const int row = row0 + ai * HALF + m * 16; const float dk = -fabsf(decay[row]) * (1.4426950408889634f / 16383.0f); bf16_t* rowp = O + (size_t)row * ldc + col0;
#pragma unroll
                for (int bj = 0; bj < 2; ++bj) { const float c0 = (float)(col0 + bj * HALF); f32x4 w0, w1;
#pragma unroll
                    for (int e = 0; e < 4; ++e) { w0[e] = __builtin_amdgcn_exp2f((c0 + (float)e) * dk); w1[e] = __builtin_amdgcn_exp2f((c0 + (float)(4 + e)) * dk); }
                    *(u32x4*)(rowp + bj * HALF) = pack8(acc[ai][bj][m][0] * w0, acc[ai][bj][m][1] * w1); } }
    }
};
struct EpiResid {
    static constexpr bool PERM = true, AFTER_DRAIN = false;
    bf16_t* O; int ldc; const bf16_t* x; float alpha;
    __device__ __forceinline__ void operator()(const f32x4 (&acc)[2][2][4][2], const Unit& u, int wr, int wc, int fr, int fq) const {
        const int row0 = u.pm * BM + wr * 64 + fr, col0 = u.pn * BM + wc * 32 + 8 * fq;
#pragma unroll
        for (int ai = 0; ai < 2; ++ai)
#pragma unroll
            for (int m = 0; m < 4; ++m) { const size_t off = (size_t)(row0 + ai * HALF + m * 16) * ldc + col0;
#pragma unroll
                for (int bj = 0; bj < 2; ++bj) { const u32x4 xv = *(const u32x4*)(x + off + bj * HALF);
                    const f32x4 x0 = {__builtin_bit_cast(float, xv.x << 16), __builtin_bit_cast(float, xv.x & 0xffff0000u), __builtin_bit_cast(float, xv.y << 16), __builtin_bit_cast(float, xv.y & 0xffff0000u)};
                    const f32x4 x1 = {__builtin_bit_cast(float, xv.z << 16), __builtin_bit_cast(float, xv.z & 0xffff0000u), __builtin_bit_cast(float, xv.w << 16), __builtin_bit_cast(float, xv.w & 0xffff0000u)};
                    *(u32x4*)(O + off + bj * HALF) = pack8(x0 * alpha + acc[ai][bj][m][0], x1 * alpha + acc[ai][bj][m][1]); } }
    }
};
__device__ __forceinline__ float silu_f(float v) { return v * __builtin_amdgcn_rcpf(1.0f + __builtin_amdgcn_exp2f(-1.4426950408889634f * v)); }
struct EpiSwiGLU {
    static constexpr bool PERM = true, AFTER_DRAIN = false;
    bf16_t* O; int ldc; int nNe;
    __device__ __forceinline__ void operator()(const f32x4 (&acc)[2][2][4][2], const Unit& u, int wr, int wc, int fr, int fq) const {
        const int row0 = u.pm * BM + wr * 64 + fr, pl = u.pn - (u.pm >> 4) * nNe, col0 = pl * HALF + wc * 32 + 8 * fq;
#pragma unroll
        for (int ai = 0; ai < 2; ++ai)
#pragma unroll
            for (int m = 0; m < 4; ++m) { f32x4 h0, h1;
#pragma unroll
                for (int e = 0; e < 4; ++e) { h0[e] = silu_f(acc[ai][0][m][0][e]) * acc[ai][1][m][0][e]; h1[e] = silu_f(acc[ai][0][m][1][e]) * acc[ai][1][m][1][e]; }
                *(u32x4*)(O + (size_t)(row0 + ai * HALF + m * 16) * ldc + col0) = pack8(h0, h1); }
    }
};
struct EpiSwiGLU8 {
    static constexpr bool PERM = true, AFTER_DRAIN = false;
    unsigned char* O; int ldc; int nNe;
    __device__ __forceinline__ void operator()(const f32x4 (&acc)[2][2][4][2], const Unit& u, int wr, int wc, int fr, int fq) const {
        typedef int v2i_ __attribute__((ext_vector_type(2)));
        const int row0 = u.pm * BM + wr * 64 + fr, pl = u.pn - (u.pm >> 4) * nNe, col0 = pl * HALF + wc * 32 + 8 * fq;
#pragma unroll
        for (int ai = 0; ai < 2; ++ai)
#pragma unroll
            for (int m = 0; m < 4; ++m) { float h[8];
#pragma unroll
                for (int e = 0; e < 4; ++e) { h[e] = 8.f * silu_f(acc[ai][0][m][0][e]) * acc[ai][1][m][0][e]; h[4 + e] = 8.f * silu_f(acc[ai][0][m][1][e]) * acc[ai][1][m][1][e]; }
                int w0 = 0, w1 = 0;
                w0 = __builtin_amdgcn_cvt_pk_fp8_f32(h[0], h[1], w0, false); w0 = __builtin_amdgcn_cvt_pk_fp8_f32(h[2], h[3], w0, true);
                w1 = __builtin_amdgcn_cvt_pk_fp8_f32(h[4], h[5], w1, false); w1 = __builtin_amdgcn_cvt_pk_fp8_f32(h[6], h[7], w1, true);
                *(v2i_*)(O + (size_t)(row0 + ai * HALF + m * 16) * ldc + col0) = (v2i_){w0, w1}; }
    }
};
struct EpiRowScale {
    static constexpr bool PERM = true, AFTER_DRAIN = false;
    unsigned char* O; int ldc; const float* gate; int nNe;
    __device__ __forceinline__ void operator()(const f32x4 (&acc)[2][2][4][2], const Unit& u, int wr, int wc, int fr, int fq) const {
        typedef int v2i_ __attribute__((ext_vector_type(2)));
        const int row0 = u.pm * BM + wr * 64 + fr, pl = u.pn - (u.pm >> 4) * nNe, col0 = pl * BM + wc * 32 + 8 * fq;
#pragma unroll
        for (int ai = 0; ai < 2; ++ai)
#pragma unroll
            for (int m = 0; m < 4; ++m) { const int row = row0 + ai * HALF + m * 16; const float g = 64.f * gate[row]; unsigned char* rowp = O + (size_t)row * ldc + col0;
#pragma unroll
                for (int bj = 0; bj < 2; ++bj) { const f32x4 v0 = acc[ai][bj][m][0] * g, v1 = acc[ai][bj][m][1] * g; int w0 = 0, w1 = 0;
                    w0 = __builtin_amdgcn_cvt_pk_fp8_f32(v0[0], v0[1], w0, false); w0 = __builtin_amdgcn_cvt_pk_fp8_f32(v0[2], v0[3], w0, true);
                    w1 = __builtin_amdgcn_cvt_pk_fp8_f32(v1[0], v1[1], w1, false); w1 = __builtin_amdgcn_cvt_pk_fp8_f32(v1[2], v1[3], w1, true);
                    *(v2i_*)(rowp + bj * HALF) = (v2i_){w0, w1}; } }
    }
};
struct GroupedOrder : StaticOrder {
    int nNe;
    __host__ __device__ void initg(int nNe_, int G_, int c_) { nNe = nNe_; init(65536, nNe_ * BM, G_, c_); }
    __host__ __device__ bool next(int i, Unit& u) const { if (!StaticOrder::next(i, u)) return false; u.pn += (u.pm >> 4) * nNe; return true; }
};
}
#ifndef PROBE_SEC
#define PROBE_SEC 0
#endif
#define ATSEC_B(id) do { if (PROBE_SEC == (id)) { t0_ = __builtin_amdgcn_s_memrealtime(); } } while (0)
#define ATSEC_E(id) do { if (PROBE_SEC == (id)) { tacc_ += __builtin_amdgcn_s_memrealtime() - t0_; } } while (0)
namespace att {
using bf16 = unsigned short;
constexpr int D = 128, NW = 8, QBLK = 32, KVBLK = 64; constexpr float SCALE = 0.088388347648318440f; constexpr float THR = 1.f; constexpr int SDEPTH = 2;
constexpr int LDQ = 1536, LDK = 128, LDO = 1024;
constexpr size_t SHM_V = KVBLK * D * 2, SHM_K = KVBLK * D * 2, SHM_ATTN = 8 * (KVBLK * D) + NW * 64 * 4;
using bf16x8 = __attribute__((ext_vector_type(8))) short;
using s16x4  = __attribute__((ext_vector_type(4))) short;
using f32x16 = __attribute__((ext_vector_type(16))) float;
using f32x8  = __attribute__((ext_vector_type(8))) float;
using u32x4  = __attribute__((ext_vector_type(4))) unsigned;
#define KSWZ(row, colB) ((row) * 256 + ((colB) ^ (((row) & 7) << 4)))
#define SBAR() __builtin_amdgcn_sched_barrier(0)
__device__ __forceinline__ int crow(int r, int hi) { return (r & 3) + 8 * (r >> 2) + 4 * hi; }
__device__ __forceinline__ unsigned cvtpk(float lo, float hi) {
  unsigned r; asm volatile("v_cvt_pk_bf16_f32 %0, %1, %2" : "=v"(r) : "v"(lo), "v"(hi)); return r;
}
__device__ __forceinline__ void partialSM(f32x16& p0, f32x16& p1, float& m_reg, float& mn, float& alpha) {
  constexpr float C = SCALE * 1.4426950408889634f;
  float pmax = p0[0]; for (int r = 1; r < 16; ++r) pmax = fmaxf(pmax, p0[r]); for (int r = 0; r < 16; ++r) pmax = fmaxf(pmax, p1[r]);
  { auto rr = __builtin_amdgcn_permlane32_swap(__float_as_uint(pmax), __float_as_uint(pmax), false, false);
    pmax = fmaxf(__uint_as_float(rr[0]), __uint_as_float(rr[1])); }
  if (__builtin_expect(__all(pmax - m_reg <= THR / SCALE), 1)) { mn = m_reg; alpha = 1.f; }
  else { mn = fmaxf(m_reg, pmax); alpha = __builtin_amdgcn_exp2f((m_reg - mn) * C); m_reg = mn; }
  float mnC = 7.0f - mn * C;
  for (int r = 0; r < 16; ++r) p0[r] = fmaf(p0[r], C, mnC); for (int r = 0; r < 16; ++r) p1[r] = fmaf(p1[r], C, mnC);
  for (int r = 0; r < 16; ++r) p0[r] = __builtin_amdgcn_exp2f(p0[r]);
}
__device__ __forceinline__ void finishSM(f32x16& p0, f32x16& p1, float alpha, float& l_reg, bf16x8& pa0, bf16x8& pa1, bf16x8& pa2, bf16x8& pa3) {
  for (int r = 0; r < 16; ++r) p1[r] = __builtin_amdgcn_exp2f(p1[r]);
  float ps = 0; for (int r = 0; r < 16; ++r) ps += p0[r]; for (int r = 0; r < 16; ++r) ps += p1[r];
  { auto rr = __builtin_amdgcn_permlane32_swap(__float_as_uint(ps), __float_as_uint(ps), false, false);
    ps = __uint_as_float(rr[0]) + __uint_as_float(rr[1]); }
  l_reg = l_reg * alpha + ps;
#define PK4(P, BASE, OUT) do { unsigned a0 = cvtpk(P[BASE + 0], P[BASE + 1]), a1 = cvtpk(P[BASE + 2], P[BASE + 3]);   \
    unsigned b0 = cvtpk(P[BASE + 4], P[BASE + 5]), b1 = cvtpk(P[BASE + 6], P[BASE + 7]);                              \
    auto r0 = __builtin_amdgcn_permlane32_swap(a0, b0, false, false); auto r1 = __builtin_amdgcn_permlane32_swap(a1, b1, false, false); \
    u32x4 w = {r0[0], r1[0], r0[1], r1[1]}; OUT = *reinterpret_cast<bf16x8*>(&w); } while (0)
  PK4(p0, 0, pa0); PK4(p0, 8, pa1); PK4(p1, 0, pa2); PK4(p1, 8, pa3);
#undef PK4
}
__device__ __forceinline__ void qkt(f32x16& p0, f32x16& p1, const bf16* Ks, const bf16x8* qr, int r32, int hi) {
  p0 = f32x16{}; p1 = f32x16{};
  __builtin_amdgcn_s_setprio(1);
  for (int d0 = 0; d0 < 8; ++d0) { int cb = (d0 * 16 + hi * 8) * 2;
    bf16x8 b0 = *reinterpret_cast<const bf16x8*>((const char*)Ks + KSWZ(r32, cb));
    bf16x8 b1 = *reinterpret_cast<const bf16x8*>((const char*)Ks + KSWZ(32 + r32, cb));
    p0 = __builtin_amdgcn_mfma_f32_32x32x16_bf16(b0, qr[d0], p0, 0, 0, 0);
    p1 = __builtin_amdgcn_mfma_f32_32x32x16_bf16(b1, qr[d0], p1, 0, 0, 0); }
  __builtin_amdgcn_s_setprio(0);
}
using v8i = __attribute__((ext_vector_type(8))) int;
using v4i = __attribute__((ext_vector_type(4))) int;
constexpr size_t SHM_K8 = KVBLK * D;
__device__ __forceinline__ int k8img(int r, int c) { return r * 128 + ((c ^ ((r >> 1) & 7)) << 4); }
__device__ __forceinline__ v8i ld32(const char* p0, const char* p1) { const v4i a = *reinterpret_cast<const v4i*>(p0), b = *reinterpret_cast<const v4i*>(p1); return __builtin_shufflevector(a, b, 0, 1, 2, 3, 4, 5, 6, 7); }
__device__ __forceinline__ void qkt8(f32x16& p0, f32x16& p1, const char* Ks, const v8i* q8, int r32, int hi, float init) {
#pragma unroll
  for (int r = 0; r < 16; ++r) { p0[r] = init; p1[r] = init; }
  __builtin_amdgcn_s_setprio(1);
#pragma unroll
  for (int s = 0; s < 2; ++s) { const int c = 4 * s + 2 * hi;
    const v8i a0 = ld32(Ks + k8img(r32, c), Ks + k8img(r32, c + 1)), a1 = ld32(Ks + k8img(32 + r32, c), Ks + k8img(32 + r32, c + 1));
    p0 = __builtin_amdgcn_mfma_scale_f32_32x32x64_f8f6f4(a0, q8[s], p0, 0, 0, 0, 0x7f7f7f7f, 0, 0x7c7c7c7c);
    p1 = __builtin_amdgcn_mfma_scale_f32_32x32x64_f8f6f4(a1, q8[s], p1, 0, 0, 0, 0x7f7f7f7f, 0, 0x7c7c7c7c); }
  __builtin_amdgcn_s_setprio(0);
}
template <bool FIRST> __device__ __forceinline__ void partialSM8(f32x16& p0, f32x16& p1, float& m2, float& alpha) {
  constexpr float THR2 = THR * 1.4426950408889634f;
  float pmax = p0[0]; for (int r = 1; r < 16; ++r) pmax = fmaxf(pmax, p0[r]); for (int r = 0; r < 16; ++r) pmax = fmaxf(pmax, p1[r]);
  { auto rr = __builtin_amdgcn_permlane32_swap(__float_as_uint(pmax), __float_as_uint(pmax), false, false);
    pmax = fmaxf(__uint_as_float(rr[0]), __uint_as_float(rr[1])); }
  if (!FIRST && __builtin_expect(__all(pmax <= 7.0f + THR2), 1)) { alpha = 1.f; }
  else { const float d = FIRST ? pmax - 7.0f : fmaxf(pmax - 7.0f, 0.f); alpha = FIRST ? 0.f : __builtin_amdgcn_exp2f(-d); m2 += d;
    for (int r = 0; r < 16; ++r) p0[r] -= d; for (int r = 0; r < 16; ++r) p1[r] -= d; }
  for (int r = 0; r < 16; ++r) p0[r] = __builtin_amdgcn_exp2f(p0[r]);
}
__device__ __forceinline__ int v8img(int c, int q) { return c * 64 + ((q ^ ((c >> 2) & 3)) << 4); }
__device__ __forceinline__ void finishSM8(f32x16& p0, f32x16& p1, v8i& pa) {
  for (int r = 0; r < 16; ++r) p1[r] = __builtin_amdgcn_exp2f(p1[r]);
  int w[8];
#pragma unroll
  for (int i = 0; i < 4; ++i) { int a = 0, b = 0;
    a = __builtin_amdgcn_cvt_pk_fp8_f32(p0[4 * i], p0[4 * i + 1], a, false); a = __builtin_amdgcn_cvt_pk_fp8_f32(p0[4 * i + 2], p0[4 * i + 3], a, true);
    b = __builtin_amdgcn_cvt_pk_fp8_f32(p1[4 * i], p1[4 * i + 1], b, false); b = __builtin_amdgcn_cvt_pk_fp8_f32(p1[4 * i + 2], p1[4 * i + 3], b, true);
    w[i] = a; w[4 + i] = b; }
  pa = (v8i){w[0], w[1], w[2], w[3], w[4], w[5], w[6], w[7]};
}
using f32x4_ = __attribute__((ext_vector_type(4))) float;
__device__ __forceinline__ void pv8(f32x16* o, f32x4_& l4, const char* Vs, const v8i& pa, const v8i& bsel, int r32, int hi) {
  l4 = __builtin_amdgcn_mfma_scale_f32_16x16x128_f8f6f4(pa, bsel, l4, 0, 0, 0, 0x7f7f7f7f, 0, 0x7f7f7f7f);
#pragma unroll
  for (int d0 = 0; d0 < 4; ++d0) { const int c = 32 * d0 + r32;
    const v8i b = ld32(Vs + v8img(c, 2 * hi), Vs + v8img(c, 2 * hi + 1));
    o[d0] = __builtin_amdgcn_mfma_scale_f32_32x32x64_f8f6f4(pa, b, o[d0], 0, 0, 0, 0x7f7f7f7f, 0, 0x7d7d7d7d); }
}
#define ATT_SB() __builtin_amdgcn_sched_barrier(0)
#define ATT_CVT4(P, I) ({ int a_; asm volatile("" : "=v"(a_)); a_ = __builtin_amdgcn_cvt_pk_fp8_f32(P[4 * (I)], P[4 * (I) + 1], a_, false); a_ = __builtin_amdgcn_cvt_pk_fp8_f32(P[4 * (I) + 2], P[4 * (I) + 3], a_, true); a_; })
#define ATT_EXP4(P, I) do { P[4 * (I)] = __builtin_amdgcn_exp2f(P[4 * (I)]); P[4 * (I) + 1] = __builtin_amdgcn_exp2f(P[4 * (I) + 1]); P[4 * (I) + 2] = __builtin_amdgcn_exp2f(P[4 * (I) + 2]); P[4 * (I) + 3] = __builtin_amdgcn_exp2f(P[4 * (I) + 3]); } while (0)
__device__ __forceinline__ float att_max3(float a, float b, float c) { float r; asm("v_max3_f32 %0, %1, %2, %3" : "=v"(r) : "v"(a), "v"(b), "v"(c)); return r; }
#define ATT_MAX16(P, MA, MB) do { MA = att_max3(P[0], P[1], P[2]); MB = att_max3(P[9], P[10], P[11]); MA = att_max3(MA, P[3], P[4]); MB = att_max3(MB, P[12], P[13]); MA = att_max3(MA, P[5], P[6]); MB = att_max3(MB, P[14], P[15]); MA = att_max3(MA, P[7], P[8]); } while (0)
#define ATT_MF "v_mfma_scale_f32_32x32x64_f8f6f4 %[acc], %[a], %[b], %[acc], %[sa], %[sb] op_sel_hi:[0,0,0]"
template <bool PREF, bool DK, bool DV>
__device__ __forceinline__ void att_step(f32x16& c0, f32x16& c1, f32x16& q0, f32x16& q1, float& m2, float& alpha, f32x16& ci, f32x16* o, f32x4_& l4, v8i& ka0, v8i& ka1,
                                         const char* Ks, const char* Vs, const char* Kn, const v8i* q8, const v8i& bsel, const int (&kofs)[4], const int (&vofs)[2],
                                         const unsigned char* kg, const unsigned char* vg, unsigned kd, unsigned vd, unsigned koff, unsigned voff) {
  constexpr float THR2 = THR * 1.4426950408889634f;
  const int s1 = 0x7f7f7f7f, sq = 0x7c7c7c7c, sv = 0x7d7d7d7d;
  const v8i a0 = ka0, a1 = ka1;
  asm volatile("v_mfma_scale_f32_32x32x64_f8f6f4 %[d], %[a], %[b], %[c], %[sa], %[sb] op_sel_hi:[0,0,0]"
               : [d] "=&v"(c0), "+v"(q0), "+v"(q1) : [a] "v"(a0), [b] "v"(q8[0]), [c] "v"(ci), [sa] "v"(s1), [sb] "v"(sq) : "memory"); ATT_SB();
  if constexpr (DK) asm volatile("s_mov_b32 m0, %2\n\ts_nop 0\n\tglobal_load_lds_dwordx4 %0, %1" :: "v"(koff), "s"(kg), "s"(kd) : "memory");
  if constexpr (DV) asm volatile("s_mov_b32 m0, %2\n\ts_nop 0\n\tglobal_load_lds_dwordx4 %0, %1" :: "v"(voff), "s"(vg), "s"(vd) : "memory");
  const v8i b0 = ld32(Ks + kofs[2], Ks + kofs[3]), b1 = ld32(Ks + kofs[2] + 4096, Ks + kofs[3] + 4096);
  ATT_EXP4(q1, 0); int w0 = ATT_CVT4(q0, 0);
  asm volatile("v_mfma_scale_f32_32x32x64_f8f6f4 %[d], %[a], %[b], %[c], %[sa], %[sb] op_sel_hi:[0,0,0]"
               : [d] "=&v"(c1), "+v"(q0), "+v"(q1), "+v"(w0) : [a] "v"(a1), [b] "v"(q8[0]), [c] "v"(ci), [sa] "v"(s1), [sb] "v"(sq) : "memory"); ATT_SB();
  ATT_EXP4(q1, 1); int w1 = ATT_CVT4(q0, 1), w2 = ATT_CVT4(q0, 2);
  asm volatile(ATT_MF : [acc] "+v"(c0), "+v"(q0), "+v"(q1), "+v"(w1), "+v"(w2) : [a] "v"(b0), [b] "v"(q8[1]), [sa] "v"(s1), [sb] "v"(sq) : "memory"); ATT_SB();
  const v8i v0 = ld32(Vs + vofs[0], Vs + vofs[1]), v1 = ld32(Vs + vofs[0] + 2048, Vs + vofs[1] + 2048);
  ATT_EXP4(q1, 2); int w3 = ATT_CVT4(q0, 3), w4 = ATT_CVT4(q1, 0);
  asm volatile(ATT_MF : [acc] "+v"(c1), "+v"(q1), "+v"(w3), "+v"(w4) : [a] "v"(b1), [b] "v"(q8[1]), [sa] "v"(s1), [sb] "v"(sq) : "memory"); ATT_SB();
  ATT_EXP4(q1, 3); const int w5 = ATT_CVT4(q1, 1), w6 = ATT_CVT4(q1, 2), w7 = ATT_CVT4(q1, 3);
  v8i pa = (v8i){w0, w1, w2, w3, w4, w5, w6, w7};
  asm volatile("s_nop 1\n\tv_mfma_scale_f32_16x16x128_f8f6f4 %[acc], %[a], %[b], %[acc], %[sa], %[sb] op_sel_hi:[0,0,0]"
               : [acc] "+v"(l4), "+v"(c0) : [a] "v"(pa), [b] "v"(bsel), [sa] "v"(s1), [sb] "v"(s1) : "memory"); ATT_SB();
  const v8i v2 = ld32(Vs + vofs[0] + 4096, Vs + vofs[1] + 4096);
  float pm0, pm0b; ATT_MAX16(c0, pm0, pm0b);
  asm volatile(ATT_MF : [acc] "+v"(o[0]), "+v"(pm0), "+v"(pm0b), "+v"(c1) : [a] "v"(pa), [b] "v"(v0), [sa] "v"(s1), [sb] "v"(sv) : "memory"); ATT_SB();
  const v8i v3 = ld32(Vs + vofs[0] + 6144, Vs + vofs[1] + 6144);
  float pm1, pm1b; ATT_MAX16(c1, pm1, pm1b);
  asm volatile(ATT_MF : [acc] "+v"(o[1]), "+v"(pm1), "+v"(pm1b) : [a] "v"(pa), [b] "v"(v1), [sa] "v"(s1), [sb] "v"(sv) : "memory"); ATT_SB();
  float pmax = fmaxf(att_max3(pm0, pm0b, pm1), pm1b);
  { auto rr = __builtin_amdgcn_permlane32_swap(__float_as_uint(pmax), __float_as_uint(pmax), false, false); pmax = fmaxf(__uint_as_float(rr[0]), __uint_as_float(rr[1])); }
  if (__builtin_expect(__all(pmax <= 7.0f + THR2), 1)) { alpha = 1.f; }
  else { const float d = fmaxf(pmax - 7.0f, 0.f); alpha = __builtin_amdgcn_exp2f(-d); m2 += d; const float init = 7.0f - m2;
#pragma unroll
    for (int r = 0; r < 16; ++r) { c0[r] -= d; c1[r] -= d; ci[r] = init; } }
  asm volatile(ATT_MF : [acc] "+v"(o[2]), "+v"(c0) : [a] "v"(pa), [b] "v"(v2), [sa] "v"(s1), [sb] "v"(sv) : "memory"); ATT_SB();
  if constexpr (PREF) { ka0 = ld32(Kn + kofs[0], Kn + kofs[1]); ka1 = ld32(Kn + kofs[0] + 4096, Kn + kofs[1] + 4096); }
  ATT_EXP4(c0, 0); ATT_EXP4(c0, 1);
  asm volatile(ATT_MF : [acc] "+v"(o[3]), "+v"(c0) : [a] "v"(pa), [b] "v"(v3), [sa] "v"(s1), [sb] "v"(sv) : "memory"); ATT_SB();
  ATT_EXP4(c0, 2); ATT_EXP4(c0, 3);
  asm volatile("" : "+v"(c0)); ATT_SB();
}
__device__ __forceinline__ int v_st(int k, int c) { const int kk = (k & ~0xC) | ((k & 4) << 1) | ((k & 8) >> 1); return ((kk >> 3) * 4 + (c >> 5)) * 512 + ((kk & 7) * 32 + (c & 31)) * 2; }
__device__ __forceinline__ int v_rd_base(int lane) { return ((lane & 3) << 3) | (((lane >> 2) & 3) << 6) | (((lane >> 4) & 1) << 5) | (((lane >> 5) & 1) << 8); }
constexpr int v_rd_off(int d0, int ks, int half) { return d0 * 512 + ks * 4096 + half * 2048; }
template <int OFF> __device__ __forceinline__ s16x4 tr_read(int vb) {
  s16x4 r; asm volatile("ds_read_b64_tr_b16 %0, %1 offset:%2" : "=&v"(r) : "v"(vb), "i"(OFF) : "memory"); return r;
}
template <int D0> __device__ __forceinline__ void pv_one(f32x16& od, int vb, bf16x8 pa0, bf16x8 pa1, bf16x8 pa2, bf16x8 pa3) {
  const s16x4 l0 = tr_read<v_rd_off(D0, 0, 0)>(vb), h0 = tr_read<v_rd_off(D0, 0, 1)>(vb), l1 = tr_read<v_rd_off(D0, 1, 0)>(vb), h1 = tr_read<v_rd_off(D0, 1, 1)>(vb);
  const s16x4 l2 = tr_read<v_rd_off(D0, 2, 0)>(vb), h2 = tr_read<v_rd_off(D0, 2, 1)>(vb), l3 = tr_read<v_rd_off(D0, 3, 0)>(vb), h3 = tr_read<v_rd_off(D0, 3, 1)>(vb);
  asm volatile("s_waitcnt lgkmcnt(0)" ::: "memory"); SBAR();
#define PK(L, H) (bf16x8){L[0], L[1], L[2], L[3], H[0], H[1], H[2], H[3]}
  od = __builtin_amdgcn_mfma_f32_32x32x16_bf16(pa0, PK(l0, h0), od, 0, 0, 0);
  od = __builtin_amdgcn_mfma_f32_32x32x16_bf16(pa1, PK(l1, h1), od, 0, 0, 0);
  od = __builtin_amdgcn_mfma_f32_32x32x16_bf16(pa2, PK(l2, h2), od, 0, 0, 0);
  od = __builtin_amdgcn_mfma_f32_32x32x16_bf16(pa3, PK(l3, h3), od, 0, 0, 0);
#undef PK
}
__device__ __forceinline__ void pv_d0(f32x16* o, int vb, bf16x8 pa0, bf16x8 pa1, bf16x8 pa2, bf16x8 pa3) {
  pv_one<0>(o[0], vb, pa0, pa1, pa2, pa3); pv_one<1>(o[1], vb, pa0, pa1, pa2, pa3); pv_one<2>(o[2], vb, pa0, pa1, pa2, pa3); pv_one<3>(o[3], vb, pa0, pa1, pa2, pa3);
}
__device__ __forceinline__ void attn_unit(const bf16* __restrict__ Qb, int l0, const float* __restrict__ qn, const unsigned char* __restrict__ Kh, const unsigned char* __restrict__ Vh,
                                          bf16* __restrict__ Ob, int seq, char* lds) {
  int tid_ = threadIdx.x; asm volatile("" : "+v"(tid_));
  const int tid = tid_, wid = tid >> 6, lane = tid & 63, r32 = lane & 31, hi = lane >> 5;
  char* V_lds = lds; char* K_lds = lds + 4 * SHM_K8;
  float* ws = (float*)(lds + 8 * SHM_K8) + wid * 64; float* li_l = ws; float* al_l = ws + 32;
  float m_reg = 0.f; f32x4_ l4 = {0.f, 0.f, 0.f, 0.f}; f32x16 o[4] = {}; v8i q8[2];
  {
    const bf16* Qw = Qb + (long)(wid * QBLK + r32) * LDQ + hi * 32;
    const int lpos = l0 + wid * QBLK + r32; const float prow = (float)(lpos >> 6), pcol = (float)(lpos & 63);
    bf16x8 qraw[2][4]; float ss = 0.f;
#pragma unroll
    for (int s_ = 0; s_ < 2; ++s_)
#pragma unroll
      for (int c = 0; c < 4; ++c) { qraw[s_][c] = *reinterpret_cast<const bf16x8*>(Qw + 64 * s_ + 8 * c);
#pragma unroll
        for (int e = 0; e < 8; ++e) { const float v = __uint_as_float(((unsigned)(unsigned short)qraw[s_][c][e]) << 16); ss += v * v; } }
    ss += __shfl_xor(ss, 32);
    const float rs = 1.0201391f / sqrtf(ss * (1.0f / 128.0f) + 1e-6f);
#pragma unroll
    for (int s_ = 0; s_ < 2; ++s_) { int w[8];
#pragma unroll
      for (int c = 0; c < 4; ++c) { const int d = 64 * s_ + 32 * hi + 8 * c;
        const float4 g0 = *reinterpret_cast<const float4*>(qn + d), g1 = *reinterpret_cast<const float4*>(qn + d + 4);
        const float gg[8] = {g0.x, g0.y, g0.z, g0.w, g1.x, g1.y, g1.z, g1.w}; float r8[8];
#pragma unroll
        for (int e2 = 0; e2 < 4; ++e2) {
          const float x0 = __uint_as_float(((unsigned)(unsigned short)qraw[s_][c][2 * e2]) << 16) * rs * gg[2 * e2], x1 = __uint_as_float(((unsigned)(unsigned short)qraw[s_][c][2 * e2 + 1]) << 16) * rs * gg[2 * e2 + 1];
          const int i = 32 * s_ + 16 * hi + 4 * c + e2, j = i & 31;
          const float inv = __builtin_amdgcn_exp2f(-(float)j * (13.287712379549449f / 32.0f));
          const float rev = (s_ == 0 ? prow : pcol) * inv * 0.15915494309189535f;
          const float cc = __builtin_amdgcn_cosf(rev), sn_ = __builtin_amdgcn_sinf(rev);
          r8[2 * e2] = x0 * cc - x1 * sn_; r8[2 * e2 + 1] = x0 * sn_ + x1 * cc; }
        int w0 = 0, w1 = 0;
        w0 = __builtin_amdgcn_cvt_pk_fp8_f32(r8[0], r8[1], w0, false); w0 = __builtin_amdgcn_cvt_pk_fp8_f32(r8[2], r8[3], w0, true);
        w1 = __builtin_amdgcn_cvt_pk_fp8_f32(r8[4], r8[5], w1, false); w1 = __builtin_amdgcn_cvt_pk_fp8_f32(r8[6], r8[7], w1, true);
        w[2 * c] = w0; w[2 * c + 1] = w1; }
      q8[s_] = (v8i){w[0], w[1], w[2], w[3], w[4], w[5], w[6], w[7]}; }
  }
  const int wu = __builtin_amdgcn_readfirstlane(wid);
  const int lrow = (16 * (lane & 15) + 4 * (lane >> 4)) & 31;
  v8i bsel; { const int c_ = ((lane & 15) < 2 && ((lane >> 4) & 1) == (lane & 15)) ? 0x38383838 : 0; bsel = (v8i){c_, c_, c_, c_, c_, c_, c_, c_}; asm volatile("" : "+v"(bsel)); }
  unsigned koff; const unsigned voff = (unsigned)(wu * 1024 + 16 * lane);
  { const int row = 8 * wu + (lane >> 3), pos = lane & 7; koff = (unsigned)(row * 128 + ((pos ^ ((row >> 1) & 7)) << 4)); }
  const unsigned kdst = (unsigned)(size_t)K_lds + (unsigned)(wu * 1024), vdst = (unsigned)(size_t)V_lds + (unsigned)(wu * 1024);
#define DMA_K(slot, key0) asm volatile("s_mov_b32 m0, %2\n\ts_nop 0\n\tglobal_load_lds_dwordx4 %0, %1" :: "v"(koff), "s"(Kh + (size_t)(key0) * 128), "s"(kdst + (unsigned)((slot) * SHM_K8)) : "memory")
#define DMA_V(slot, key0) asm volatile("s_mov_b32 m0, %2\n\ts_nop 0\n\tglobal_load_lds_dwordx4 %0, %1" :: "v"(voff), "s"(Vh + (size_t)(key0) * 128), "s"(vdst + (unsigned)((slot) * SHM_K8)) : "memory")
#define DMA_BAR(n) asm volatile("s_waitcnt vmcnt(" #n ") lgkmcnt(0)\n\ts_barrier" ::: "memory")
#define RESC(a) do { if (__any((a) < 1.f)) { if (hi == 0) al_l[r32] = (a); asm volatile("s_nop 15\n\ts_nop 15\n\ts_nop 15\n\ts_waitcnt lgkmcnt(0)" ::: "memory"); \
    for (int d = 0; d < 4; ++d) for (int r = 0; r < 16; ++r) o[d][r] *= al_l[crow(r, hi)]; l4 *= *reinterpret_cast<const f32x4_*>(al_l + lrow); } } while (0)
#define KSLOT(s) (K_lds + (s) * SHM_K8)
#define VSLOT(s) (V_lds + (s) * SHM_K8)
  f32x16 pA0, pA1, pB0, pB1; float mnA, mnB, alA, alB; v8i pa; const int NT = seq / KVBLK;
  DMA_K(0, 0); DMA_K(1, KVBLK); DMA_V(0, 0); DMA_K(2, 2 * KVBLK); DMA_V(1, KVBLK); DMA_K(3, 3 * KVBLK);
  DMA_BAR(3);
  qkt8(pA0, pA1, KSLOT(0), q8, r32, hi, 7.0f); partialSM8<true>(pA0, pA1, m_reg, alA);
  f32x16 ci; const int kofs[4] = {k8img(r32, 2 * hi), k8img(r32, 2 * hi + 1), k8img(r32, 4 + 2 * hi), k8img(r32, 5 + 2 * hi)}, vofs[2] = {v8img(r32, 2 * hi), v8img(r32, 2 * hi + 1)};
  v8i ka0 = ld32(KSLOT(1) + kofs[0], KSLOT(1) + kofs[1]), ka1 = ld32(KSLOT(1) + kofs[0] + 4096, KSLOT(1) + kofs[1] + 4096);
  DMA_BAR(2);
#pragma unroll
  for (int r = 0; r < 16; ++r) ci[r] = 7.0f - m_reg;
#define ATT_STEP(t_, S_, CUR0, CUR1, PRV0, PRV1, ALC, PREF_, DK_, DV_, WAITN) do { SBAR(); \
    att_step<PREF_, DK_, DV_>(CUR0, CUR1, PRV0, PRV1, m_reg, ALC, ci, o, l4, ka0, ka1, KSLOT(S_), VSLOT(((S_) + 3) & 3), KSLOT(((S_) + 1) & 3), q8, bsel, kofs, vofs, \
        Kh + (size_t)((t_) + 3) * (KVBLK * 128), Vh + (size_t)((t_) + 1) * (KVBLK * 128), kdst + (unsigned)((((S_) + 3) & 3) * SHM_K8), vdst + (unsigned)((((S_) + 1) & 3) * SHM_K8), koff, voff); \
    RESC(ALC); DMA_BAR(WAITN); } while (0)
  int j = 1;
  for (; j + 3 < NT - 2; j += 4) {
    ATT_STEP(j,     1, pB0, pB1, pA0, pA1, alB, true, true, true, 2);
    ATT_STEP(j + 1, 2, pA0, pA1, pB0, pB1, alA, true, true, true, 2);
    ATT_STEP(j + 2, 3, pB0, pB1, pA0, pA1, alB, true, true, true, 2);
    ATT_STEP(j + 3, 0, pA0, pA1, pB0, pB1, alA, true, true, true, 2);
  }
  ATT_STEP(j,     1, pB0, pB1, pA0, pA1, alB, true, false, true, 0);
  ATT_STEP(j + 1, 2, pA0, pA1, pB0, pB1, alA, false, false, true, 0);
#undef ATT_STEP
  SBAR(); qkt8(pB0, pB1, KSLOT((NT - 1) & 3), q8, r32, hi, 7.0f - m_reg);
  finishSM8(pA0, pA1, pa); SBAR();
  pv8(o, l4, VSLOT((NT - 2) & 3), pa, bsel, r32, hi); partialSM8<false>(pB0, pB1, m_reg, alB);
  RESC(alB);
  finishSM8(pB0, pB1, pa); SBAR();
  pv8(o, l4, VSLOT((NT - 1) & 3), pa, bsel, r32, hi);
#undef KSLOT
#undef VSLOT
#undef DMA_K
#undef DMA_V
#undef DMA_BAR
  if ((lane & 15) < 2) *reinterpret_cast<f32x4_*>(li_l + lrow) = l4; asm volatile("s_waitcnt lgkmcnt(0)" ::: "memory");
  float rli[16];
#pragma unroll
  for (int r = 0; r < 16; ++r) rli[r] = __builtin_amdgcn_rcpf(li_l[crow(r, hi)]);
  bf16* Ow = Ob + (long)(wid * QBLK) * LDO;
#pragma unroll
  for (int r = 0; r < 16; ++r) { int orow = crow(r, hi);
    for (int d0 = 0; d0 < 4; ++d0) { const float v = o[d0][r] * rli[r]; unsigned u = __float_as_uint(v); u = (u + 0x7fffu + ((u >> 16) & 1u)) >> 16; Ow[(long)orow * LDO + d0 * 32 + r32] = (bf16)u; } }
  __syncthreads();
#undef RESC
}
#undef KSWZ
#undef SBAR
}
#define HD __device__ __forceinline__
#define HY_COSREV(x) __builtin_amdgcn_cosf(x)
#define HY_SINREV(x) __builtin_amdgcn_sinf(x)
#define HY_OPAQUE(x) asm volatile("" : "+v"(x))
#define HY_OPAQUE2(w) asm volatile("" : "+v"(w.x), "+v"(w.y))
#define HY_FENCE() asm volatile("" ::: "memory")
#define HY_SCHED() __builtin_amdgcn_sched_barrier(0)
#define HY_PIN2(w) asm volatile("" : "+v"(w.x), "+v"(w.y))
#ifndef HD
#define HD __device__ __forceinline__
#endif
typedef float f2 __attribute__((ext_vector_type(2)));
constexpr int HY_P = 8192, HY_L = 16384, HY_BUF = 8704;
HD int hy_pidx(int p) { return p + 2 * (p >> 5); }
HD f2 cmul(f2 a, f2 w) { return (f2){a.x * w.x - a.y * w.y, a.x * w.y + a.y * w.x}; }
HD f2 cmulc(f2 a, f2 w) { return (f2){a.x * w.x + a.y * w.y, a.y * w.x - a.x * w.y}; }
template <int DIR> HD f2 hy_mi(f2 a) { return DIR > 0 ? (f2){a.y, -a.x} : (f2){-a.y, a.x}; }
HD f2 hy_cis(float rev) { return (f2){HY_COSREV(rev), HY_SINREV(rev)}; }
HD float hy_bf(unsigned short u) { return __builtin_bit_cast(float, (unsigned)u << 16); }
HD unsigned hy_f2bf(float f) { unsigned u = __builtin_bit_cast(unsigned, f); return (u + 0x7fffu + ((u >> 16) & 1u)) >> 16; }
HD f2 hy_unpack(unsigned w) { return (f2){__builtin_bit_cast(float, w << 16), __builtin_bit_cast(float, w & 0xffff0000u)}; }
HD unsigned hy_pack(f2 v) { return hy_f2bf(v.x) | (hy_f2bf(v.y) << 16); }

template <int DIR> HD void hy_r4(f2& x0, f2& x1, f2& x2, f2& x3) {
    const f2 s02 = x0 + x2, d02 = x0 - x2, s13 = x1 + x3, d13 = hy_mi<DIR>(x1 - x3);
    x0 = s02 + s13; x1 = d02 + d13; x2 = s02 - s13; x3 = d02 - d13;
}
template <int DIR> HD void hy_dft16(f2 (&x)[16]) {
#pragma unroll
    for (int b = 0; b < 4; ++b) hy_r4<DIR>(x[b], x[4 + b], x[8 + b], x[12 + b]);
    constexpr float C1 = 0.92387953251128674f, S1 = 0.38268343236508977f, H = 0.70710678118654752f;
#define HY_TW(idx, cr, ci) x[idx] = cmul(x[idx], (f2){(cr), DIR > 0 ? (ci) : -(ci)})
    HY_TW(5, C1, -S1); HY_TW(9, H, -H); HY_TW(13, S1, -C1);
    HY_TW(6, H, -H); x[10] = hy_mi<DIR>(x[10]); HY_TW(14, -H, -H);
    HY_TW(7, S1, -C1); HY_TW(11, -H, -H); HY_TW(15, -C1, S1);
#undef HY_TW
#pragma unroll
    for (int c = 0; c < 4; ++c) hy_r4<DIR>(x[4 * c], x[4 * c + 1], x[4 * c + 2], x[4 * c + 3]);
}
#define HY_OUT(k) (4 * ((k) & 3) + ((k) >> 2))
template <int SL> HD constexpr int hy_koff(int k) { return SL >= 5 ? k * ((1 << SL) + (1 << (SL - 4))) : k * (1 << SL); }
template <int SL> HD int hy_pbase(int t) { const int blk = t >> SL, n0 = t & ((1 << SL) - 1); return hy_pidx((blk << (SL + 4)) + n0); }
template <int SL> HD void hy_fwd1(f2* X, int t, f2 w1) {
    HY_OPAQUE(t); HY_OPAQUE2(w1);
    const int pb = hy_pbase<SL>(t);
    f2 x[16];
#pragma unroll
    for (int k = 0; k < 16; ++k) x[k] = X[pb + hy_koff<SL>(k)];
    hy_dft16<1>(x);
    X[pb] = x[0];
    f2 w = w1;
#pragma unroll
    for (int k0 = 1; k0 < 16; ++k0) { X[pb + hy_koff<SL>(k0)] = cmul(x[HY_OUT(k0)], w); if (k0 < 15) w = cmul(w, w1); }
}
template <int SL> HD void hy_inv1(f2* X, int t, f2 w1) {
    HY_OPAQUE(t); HY_OPAQUE2(w1);
    const int pb = hy_pbase<SL>(t);
    f2 x[16];
    x[0] = X[pb];
    f2 w = w1;
#pragma unroll
    for (int k0 = 1; k0 < 16; ++k0) { x[k0] = cmulc(X[pb + hy_koff<SL>(k0)], w); if (k0 < 15) w = cmul(w, w1); }
    hy_dft16<-1>(x);
#pragma unroll
    for (int n1 = 0; n1 < 16; ++n1) X[pb + hy_koff<SL>(n1)] = x[HY_OUT(n1)];
}
HD f2 hy_cr(int R) { return R == 0 ? (f2){1.f, 0.f} : R == 1 ? (f2){0.f, -1.f} : R == 2 ? (f2){-1.f, 0.f} : (f2){0.f, 1.f}; }
HD void hy_s1_store(f2* X, int t, f2 (&x)[16], f2 w1) {
    const int pb = hy_pidx(t);
    X[pb] = x[0];
    f2 w = w1;
#pragma unroll
    for (int k0 = 1; k0 < 16; ++k0) { X[pb + hy_koff<9>(k0)] = cmul(x[HY_OUT(k0)], w); if (k0 < 15) w = cmul(w, w1); }
}
HD void hy_stage1A(f2* X, int t, int R, const unsigned short* hf, const unsigned short* hb, f2 w1) {
    HY_OPAQUE(t); HY_OPAQUE2(w1);
    const f2 cr = hy_cr(R); const float c2 = (R & 1) ? -1.f : 1.f;
    f2 x[16];
#pragma unroll
    for (int n1 = 0; n1 < 16; ++n1) {
        const int np = t + 512 * n1;
        const float g0 = hy_bf(hf[np]), g1 = hy_bf(hf[np + HY_P]), g2 = hy_bf(hb[np ? HY_L - np : 0]) * (np ? 1.f : 0.f), g3 = hy_bf(hb[HY_P - np]);
        x[n1] = cmul((f2){g0 + c2 * g2 + (g1 + g3) * cr.x, (g1 - g3) * cr.y}, hy_cis(-(float)(R * np) * (1.0f / 32768.0f)));
        if ((n1 & 3) == 3) HY_FENCE();
    }
    hy_dft16<1>(x);
    hy_s1_store(X, t, x, w1);
}
HD void hy_stage1B(f2* X, int t, int R, const unsigned* zp  , f2 w1) {
    HY_OPAQUE(t); HY_OPAQUE2(w1);
    const f2 cr = hy_cr(R);
    f2 x[16];
#pragma unroll
    for (int n1 = 0; n1 < 16; ++n1) {
        unsigned q0 = zp[(2 * n1) * 512 + t], q1 = zp[(2 * n1 + 1) * 512 + t];
        const f2 z0 = hy_unpack(q0), z1 = hy_unpack(q1);
        x[n1] = cmul(z0 + cmul(z1, cr), hy_cis(-(float)(R * (t + 512 * n1)) * (1.0f / 32768.0f)));
    }
    hy_dft16<1>(x);
    hy_s1_store(X, t, x, w1);
}
HD f2 hy_w32(int k) {
    constexpr float c[16] = {1.f, 0.98078528040323043f, 0.92387953251128674f, 0.83146961230254524f, 0.70710678118654752f, 0.55557023301960218f, 0.38268343236508977f, 0.19509032201612825f,
                             0.f, -0.19509032201612825f, -0.38268343236508977f, -0.55557023301960218f, -0.70710678118654752f, -0.83146961230254524f, -0.92387953251128674f, -0.98078528040323043f};
    constexpr float sn[16] = {0.f, 0.19509032201612825f, 0.38268343236508977f, 0.55557023301960218f, 0.70710678118654752f, 0.83146961230254524f, 0.92387953251128674f, 0.98078528040323043f,
                              1.f, 0.98078528040323043f, 0.92387953251128674f, 0.83146961230254524f, 0.70710678118654752f, 0.55557023301960218f, 0.38268343236508977f, 0.19509032201612825f};
    return (f2){c[k], -sn[k]}; }
HD void hy_fwd3(const f2* X, int t, f2 (&x)[16]) {
    const int pb = hy_pbase<1>(t), n0 = t & 1;
#pragma unroll
    for (int k = 0; k < 16; ++k) x[k] = X[pb + 2 * k];
    hy_dft16<1>(x);
#pragma unroll
    for (int k0 = 1; k0 < 16; ++k0) x[HY_OUT(k0)] = cmul(x[HY_OUT(k0)], n0 ? hy_w32(k0) : (f2){1.f, 0.f});
}
template <class XCH> HD void hy_s3_fin(f2* X, int t, f2 (&xb)[16], const unsigned (&gp)[16], const XCH& P) {
    const int n0 = t & 1; const float sg = n0 ? -1.f : 1.f; const int pb = hy_pbase<1>(t);
#pragma unroll
    for (int k0 = 0; k0 < 16; ++k0) {
        const f2 a = hy_unpack(gp[HY_OUT(k0)]), b = xb[HY_OUT(k0)], qa = hy_unpack(P.a(HY_OUT(k0))), qb = P.b(HY_OUT(k0));
        const f2 y0 = cmul(b + qb, a + qa), y1 = cmul(b - qb, a - qa);
        const f2 yy = y0 + y1 * sg;
        xb[HY_OUT(k0)] = k0 ? cmulc(yy, n0 ? hy_w32(k0) : (f2){1.f, 0.f}) : yy;
        HY_PIN2(xb[HY_OUT(k0)]);
    }
    f2 y[16];
#pragma unroll
    for (int k0 = 0; k0 < 16; ++k0) y[k0] = xb[HY_OUT(k0)];
    hy_dft16<-1>(y);
#pragma unroll
    for (int n1 = 0; n1 < 16; ++n1) X[pb + 2 * n1] = y[HY_OUT(n1)];
}
HD void hy_inv1_acc(const f2* X, int t, int R, f2 w1, f2 (&yacc)[16][2]) {
    HY_OPAQUE(t); HY_OPAQUE2(w1);
    const f2 cr = hy_cr(R);
    const int pb = hy_pidx(t);
    f2 x[16];
    x[0] = X[pb];
    f2 w = w1;
#pragma unroll
    for (int k0 = 1; k0 < 16; ++k0) { x[k0] = cmulc(X[pb + hy_koff<9>(k0)], w); if (k0 < 15) w = cmul(w, w1); }
    hy_dft16<-1>(x);
#pragma unroll
    for (int n1 = 0; n1 < 16; ++n1) {
        const f2 v = cmul(x[HY_OUT(n1)], hy_cis((float)(R * (t + 512 * n1)) * (1.0f / 32768.0f)));
        yacc[n1][0] += v;
        yacc[n1][1] += cmulc(v, cr);
        HY_PIN2(yacc[n1][0]); HY_PIN2(yacc[n1][1]);
    }
}
HD f2 hy_sconv(const unsigned short* row, int n, float w0, float w1, float w2, float cb) {
    const int nm = n > 0 ? n - 1 : 0, np = n < HY_L - 1 ? n + 1 : HY_L - 1;
    const float wm = n > 0 ? w0 : 0.f, wp = n < HY_L - 1 ? w2 : 0.f;
    const float a0 = hy_bf(row[nm]), a1 = hy_bf(row[n]), a2 = hy_bf(row[np]);
    const float b0 = hy_bf(row[HY_L + nm]), b1 = hy_bf(row[HY_L + n]), b2 = hy_bf(row[HY_L + np]);
    return (f2){wm * a0 + w1 * a1 + wp * a2 + cb, wm * b0 + w1 * b1 + wp * b2 + cb};
}
struct HyTw { f2 w8192, w512, w32; };
HD HyTw hy_tw(int t) { HyTw w; w.w8192 = hy_cis(-(float)t * (1.0f / 8192.0f)); w.w512 = hy_cis(-(float)(t & 31) * (1.0f / 512.0f)); w.w32 = hy_cis(-(float)(t & 1) * (1.0f / 32.0f)); return w; }
constexpr int NWAVES = 8;
#ifndef MK_N_LAUNCHES
#define MK_N_LAUNCHES 1
#endif
constexpr int N_PHASES = 12;
constexpr int N_LAUNCHES = MK_N_LAUNCHES;
constexpr int BATCH = 2, SEQ = 16384, DM = 2048, MTOK = BATCH * SEQ;
constexpr int HYW = 1024, NHY = 3072, NATT = 1536, INW = 4608;
constexpr int NE = 16, EFF = 1536, CAP = 2048, MOE_ROWS = NE * BATCH * CAP;
constexpr float LN_EPS = 1e-6f, DN_ALPHA = 1.189207115002721f;
typedef unsigned short bf16;
typedef unsigned v4u __attribute__((ext_vector_type(4)));
typedef float f32x4 __attribute__((ext_vector_type(4)));
typedef short bf16x8 __attribute__((ext_vector_type(8)));
#define LAS __attribute__((address_space(3)))
#define RLX_AGENT __ATOMIC_RELAXED, __HIP_MEMORY_SCOPE_AGENT
constexpr size_t MiB = 1u << 20;
constexpr size_t WS_CTL = 0, CTL_ZERO_BYTES = 1 * MiB;
constexpr size_t WS_H2 = 1 * MiB;
constexpr size_t WS_W3T = 9 * MiB;
constexpr size_t WS_AFF = 11 * MiB;
constexpr size_t WS_IDX = 13 * MiB;
constexpr size_t WS_GATE = 13 * MiB + 256 * 1024;
constexpr size_t WS_SLOT = 13 * MiB + 512 * 1024;
constexpr size_t WS_WIN = 16 * MiB;
constexpr size_t WS_WOUT = 34 * MiB;
constexpr size_t WS_WGU = 42 * MiB;
constexpr size_t WS_WD = 138 * MiB;
constexpr size_t WS_XB = 186 * MiB;
constexpr size_t WS_PT = 458 * MiB;
constexpr size_t WS_QKV = 650 * MiB;
constexpr size_t WS_FILT = 746 * MiB;
constexpr size_t WS_KP = 874 * MiB, WS_VP = 890 * MiB;
constexpr size_t WS_YHT = 906 * MiB;
constexpr size_t WS_ZPG = 330 * MiB;
constexpr size_t WS_YACC = 346 * MiB;
constexpr size_t WS_YATT = 330 * MiB;
constexpr size_t WS_MIX = 394 * MiB;
constexpr size_t WS_T = 522 * MiB;
constexpr size_t WS_X1 = 650 * MiB;
constexpr size_t WS_XQ8 = 330 * MiB;
constexpr size_t WS_X8 = 330 * MiB;
constexpr size_t WS_XG = 330 * MiB;
constexpr size_t WS_HB = 778 * MiB;
constexpr size_t WS_Y = 330 * MiB;
constexpr size_t WS_END = 1024 * MiB;
constexpr int CW_TMO = 0, CW_BAR = 4096;
constexpr int RING_BYTES = 139264;
constexpr int LDSCTL_OFF = RING_BYTES, MISC_OFF = LDSCTL_OFF + 320;
constexpr int LDS_BYTES = 147456;
static_assert(HY_BUF * 8 + 65536 <= RING_BYTES && pg8::STAGE_BYTES <= RING_BYTES && (int)att::SHM_ATTN <= RING_BYTES && MISC_OFF + 128 <= LDS_BYTES, "LDS map");

__device__ __forceinline__ unsigned f2bf(float f) { unsigned u = __builtin_bit_cast(unsigned, f); return (u + 0x7fffu + ((u >> 16) & 1u)) >> 16; }
__device__ __forceinline__ unsigned pk2(float lo, float hi) { return f2bf(lo) | (f2bf(hi) << 16); }
__device__ __forceinline__ float bflo(unsigned w) { return __builtin_bit_cast(float, w << 16); }
__device__ __forceinline__ float bfhi(unsigned w) { return __builtin_bit_cast(float, w & 0xffff0000u); }
template <int CTRL> __device__ __forceinline__ float dpp_f(float v) { return __builtin_bit_cast(float, __builtin_amdgcn_mov_dpp(__builtin_bit_cast(int, v), CTRL, 0xF, 0xF, true)); }
__device__ __forceinline__ float row16_sum(float v) { v += dpp_f<0xB1>(v); v += dpp_f<0x4E>(v); v += dpp_f<0x141>(v); v += dpp_f<0x140>(v); return v; }
__device__ __forceinline__ float row16_max(float v) { v = fmaxf(v, dpp_f<0xB1>(v)); v = fmaxf(v, dpp_f<0x4E>(v)); v = fmaxf(v, dpp_f<0x141>(v)); v = fmaxf(v, dpp_f<0x140>(v)); return v; }
__device__ __forceinline__ float wave_sum(float v) {
    v = row16_sum(v);
    const float a = __builtin_bit_cast(float, __builtin_amdgcn_readlane(__builtin_bit_cast(int, v), 0)), b = __builtin_bit_cast(float, __builtin_amdgcn_readlane(__builtin_bit_cast(int, v), 16));
    const float c = __builtin_bit_cast(float, __builtin_amdgcn_readlane(__builtin_bit_cast(int, v), 32)), d = __builtin_bit_cast(float, __builtin_amdgcn_readlane(__builtin_bit_cast(int, v), 48));
    return (a + b) + (c + d);
}
#define LDS_WAIT() asm volatile("s_waitcnt lgkmcnt(0)" ::: "memory")
#define XB_TMO      128
#define XB_XCNT(j)  (256  + 64 * (j))
#define XB_XSUB(j)  (1280 + 64 * (j))
#define XB_XGEN(j)  (2304 + 64 * (j))
#define XB_TOP      3328
#define XB_TOPGEN   3392
#define XCD_BAR_WORDS 3456
#define XB_SPIN_CAP (1u << 18)

__device__ __forceinline__ unsigned xb_ld(unsigned* p)              { return __hip_atomic_load(p, __ATOMIC_RELAXED, __HIP_MEMORY_SCOPE_AGENT); }
__device__ __forceinline__ unsigned xb_add(unsigned* p, unsigned v) { return __hip_atomic_fetch_add(p, v, __ATOMIC_RELAXED, __HIP_MEMORY_SCOPE_AGENT); }
__device__ __forceinline__ unsigned xb_xcc_id() { return (unsigned)__builtin_amdgcn_s_getreg((3 << 11) | 20) & 0xFu; }
#define XB_SPIN(cond, bar) do { unsigned _sp = 0; while (cond) { __builtin_amdgcn_s_sleep(1); \
    if ((++_sp & 255u) == 0u) { if (xb_ld(&(bar)[XB_TMO])) break; if (_sp > XB_SPIN_CAP) { atomicAdd(&(bar)[XB_TMO], 1u); break; } } } } while (0)

struct XcdBarrier {
    unsigned* bar; unsigned x;
    volatile LAS unsigned* st;
};

__device__ __forceinline__ XcdBarrier xcd_barrier_post(unsigned* bar, volatile LAS unsigned* st) {
    XcdBarrier b; b.bar = bar; b.x = xb_xcc_id(); b.st = st;
    if (threadIdx.x == 0) (void)xb_add(&bar[XB_XCNT(b.x)], 1u);
    return b;
}
__device__ __forceinline__ void xcd_barrier_complete(unsigned* bar, unsigned x, unsigned& nloc, unsigned& nx) {
    const unsigned G = gridDim.x * gridDim.y * gridDim.z;
    unsigned sum, cnt, mine, sp = 0u;
    for (;;) {
        sum = 0u; cnt = 0u; mine = 0u;
#pragma unroll
        for (unsigned j = 0; j < 16; ++j) { const unsigned c = xb_ld(&bar[XB_XCNT(j)]); sum += c; cnt += (c > 0u) ? 1u : 0u; mine = (j == x) ? c : mine; }
        if (sum == G) break;
        __builtin_amdgcn_s_sleep(1);
        if ((++sp & 255u) == 0u) { if (xb_ld(&bar[XB_TMO])) break; if (sp > XB_SPIN_CAP) { atomicAdd(&bar[XB_TMO], 1u); break; } }
    }
    nloc = mine > 0u ? mine : 1u; nx = cnt > 0u ? cnt : 1u;
}

__device__ __forceinline__ void xcd_barrier(const XcdBarrier& b) {
    asm volatile("s_waitcnt vmcnt(0)" ::: "memory");
    __syncthreads();
    if (threadIdx.x == 0) {
        unsigned* bar = b.bar;
        __builtin_amdgcn_s_waitcnt(0);
        unsigned nloc = b.st[0], nx = b.st[1];
        if (nloc == 0u) { xcd_barrier_complete(bar, b.x, nloc, nx); b.st[0] = nloc; b.st[1] = nx; }
        const unsigned old = xb_add(&bar[XB_XSUB(b.x)], 1u);
        const unsigned gen = old / nloc;
        if (old + 1u == (gen + 1u) * nloc) {
            __builtin_amdgcn_fence(__ATOMIC_RELEASE, "agent");
            asm volatile("s_waitcnt vmcnt(0)" ::: "memory");
            const unsigned og = xb_add(&bar[XB_TOP], 1u);
            const unsigned tg = og / nx;
            if (og + 1u == (tg + 1u) * nx) xb_add(&bar[XB_TOPGEN], 1u);
            else XB_SPIN(xb_ld(&bar[XB_TOPGEN]) == tg, bar);
            __builtin_amdgcn_fence(__ATOMIC_ACQUIRE, "agent");
            xb_add(&bar[XB_XGEN(b.x)], 1u);
            asm volatile("s_waitcnt vmcnt(0)" ::: "memory");
        } else {
            XB_SPIN(xb_ld(&bar[XB_XGEN(b.x)]) == gen, bar);
            __builtin_amdgcn_fence(__ATOMIC_ACQUIRE, "agent");
            asm volatile("s_waitcnt vmcnt(0)" ::: "memory");
        }
    }
    __syncthreads();
}
#ifndef PROBE_SEC
#define PROBE_SEC 0
#endif
#define TSEC_B(id) do { if (PROBE_SEC == (id)) { asm volatile("s_waitcnt vmcnt(0) lgkmcnt(0)" ::: "memory"); t0_ = __builtin_amdgcn_s_memrealtime(); } } while (0)
#define TSEC_E(id) do { if (PROBE_SEC == (id)) { asm volatile("s_waitcnt vmcnt(0) lgkmcnt(0)" ::: "memory"); tacc_ += __builtin_amdgcn_s_memrealtime() - t0_; } } while (0)
struct Ctx { LAS unsigned char* lds; int tid, lane, wave, G, gw, NGW; };
#define COSREV(x) __builtin_amdgcn_cosf(x)
#define SINREV(x) __builtin_amdgcn_sinf(x)

__device__ __forceinline__ void transpose_item(const float* W, int ldw, int k0, int n0, bf16* dst, int ldk, LAS float* scr, int lane) {
    float tv[32];
#pragma unroll
    for (int i = 0; i < 32; ++i) tv[i] = W[(size_t)(k0 + 2 * i + (lane >> 5)) * ldw + n0 + (lane & 31)];
#pragma unroll
    for (int i = 0; i < 32; ++i) scr[(2 * i + (lane >> 5)) * 33 + (lane & 31)] = tv[i];
    LDS_WAIT(); asm volatile("" ::: "memory");
    const int c = lane & 7;
    if (ldk > 0) {
#pragma unroll
        for (int j = 0; j < 4; ++j) { const int n = (lane >> 3) + 8 * j; const LAS float* s = scr + (8 * c) * 33 + n;
            v4u o; o.x = pk2(s[0 * 33], s[1 * 33]); o.y = pk2(s[2 * 33], s[3 * 33]); o.z = pk2(s[4 * 33], s[5 * 33]); o.w = pk2(s[6 * 33], s[7 * 33]);
            *(v4u*)(dst + (size_t)n * ldk + 8 * c) = o; }
    } else {
#pragma unroll
        for (int j = 0; j < 4; ++j) { const int n = (lane >> 3) + 8 * j; const LAS float* s = scr + (8 * c) * 33 + n;
            int w0 = 0, w1 = 0;
            w0 = __builtin_amdgcn_cvt_pk_fp8_f32(32.f * s[0 * 33], 32.f * s[1 * 33], w0, false); w0 = __builtin_amdgcn_cvt_pk_fp8_f32(32.f * s[2 * 33], 32.f * s[3 * 33], w0, true);
            w1 = __builtin_amdgcn_cvt_pk_fp8_f32(32.f * s[4 * 33], 32.f * s[5 * 33], w1, false); w1 = __builtin_amdgcn_cvt_pk_fp8_f32(32.f * s[6 * 33], 32.f * s[7 * 33], w1, true);
            typedef int v2i_ __attribute__((ext_vector_type(2)));
            *(v2i_*)((unsigned char*)dst + (size_t)n * (size_t)(-ldk) + 8 * c) = (v2i_){w0, w1}; }
    }
    LDS_WAIT(); asm volatile("" ::: "memory");
}
constexpr int P7_MOVE = 20480;
template <class KP> __device__ __forceinline__ void p0_prologue(const Ctx& C, KP inp, unsigned char* ws) {
#define in(k) ((const float*)(__attribute__((address_space(1))) const float*)inp[k])
    LAS float* scr = (LAS float*)(C.lds + C.wave * 16384);
    const int lane = C.lane;
    bf16* WIN = (bf16*)(ws + WS_WIN); bf16* WOUT = (bf16*)(ws + WS_WOUT); bf16* WGU = (bf16*)(ws + WS_WGU); bf16* WD = (bf16*)(ws + WS_WD); bf16* W3T = (bf16*)(ws + WS_W3T);
    constexpr int I_IN = 32 * 144, I_OUT = 32 * 64, I_G = 16 * 32 * 48, I_D = 16 * 24 * 64 - P7_MOVE, I_3 = 128;
    constexpr int NITEMS = I_IN + I_OUT + 2 * I_G + I_D + I_3;
#define P0_DECODE(it_, SRC, LDW, DST, LDK) do { int r = (it_); \
        if (r < I_IN) { const int kb = r / 144, nb = r % 144; SRC = in(1) + (size_t)(64 * kb) * INW + 32 * nb; LDW = INW; \
            if (nb < 96) { DST = WIN + (size_t)(32 * nb) * DM + 64 * kb; LDK = DM; } else { DST = (bf16*)((unsigned char*)(WIN + (size_t)NHY * DM) + (size_t)(32 * (nb - 96)) * DM + 64 * kb); LDK = -DM; } break; } r -= I_IN; \
        if (r < I_OUT) { const int kb = r / 64, nb = r % 64; SRC = in(18) + (size_t)(64 * kb) * DM + 32 * nb; LDW = DM; DST = WOUT + (size_t)(32 * nb) * DM + 64 * kb; LDK = DM; break; } r -= I_OUT; \
        if (r < 2 * I_G) { const int up = r >= I_G; if (up) r -= I_G; const int e = r / (32 * 48), q = r % (32 * 48), kb = q / 48, nb = q % 48, n0 = 32 * nb; \
            const size_t drow = (size_t)e * 3072 + (n0 >> 7) * 256 + (n0 & 127) + (up ? 128 : 0); \
            SRC = (up ? in(24) : in(23)) + (size_t)e * DM * EFF + (size_t)(64 * kb) * EFF + n0; LDW = EFF; DST = (bf16*)((unsigned char*)WGU + drow * DM + 64 * kb); LDK = -DM; break; } r -= 2 * I_G; \
        if (r < I_D) { r += P7_MOVE; const int e = r / (24 * 64), q = r % (24 * 64), kb = q / 64, nb = q % 64; \
            SRC = in(25) + (size_t)e * EFF * DM + (size_t)(64 * kb) * DM + 32 * nb; LDW = DM; DST = (bf16*)((unsigned char*)WD + ((size_t)e * DM + 32 * nb) * EFF + 64 * kb); LDK = -EFF; break; } r -= I_D; \
        SRC = in(11) + 32 * r; LDW = 4096; DST = W3T + (size_t)(32 * r) * 256; LDK = 256; } while (0)
#define P0_LOAD(SRC, LDW, TV) do { _Pragma("unroll") for (int i = 0; i < 32; ++i) TV[i] = SRC[(size_t)(2 * i + (lane >> 5)) * LDW + (lane & 31)]; } while (0)
    { int it = C.gw; const float* src = nullptr; bf16* dst = nullptr; int ldw = 0, ldk = 0; float tv[32];
      if (it < NITEMS) { P0_DECODE(it, src, ldw, dst, ldk); P0_LOAD(src, ldw, tv); }
      while (it < NITEMS) {
          const int nx = it + C.NGW; const float* nsrc = src; bf16* ndst = dst; int nldw = ldw, nldk = ldk; float tn[32];
          if (nx < NITEMS) { P0_DECODE(nx, nsrc, nldw, ndst, nldk); P0_LOAD(nsrc, nldw, tn); }
          else {
#pragma unroll
              for (int i = 0; i < 32; ++i) tn[i] = 0.f; }
#pragma unroll
          for (int i = 0; i < 32; ++i) scr[(2 * i + (lane >> 5)) * 33 + (lane & 31)] = tv[i];
          LDS_WAIT(); asm volatile("" ::: "memory");
          const int c = lane & 7;
          if (ldk > 0) {
#pragma unroll
              for (int j = 0; j < 4; ++j) { const int n = (lane >> 3) + 8 * j; const LAS float* s = scr + (8 * c) * 33 + n;
                  v4u o; o.x = pk2(s[0 * 33], s[1 * 33]); o.y = pk2(s[2 * 33], s[3 * 33]); o.z = pk2(s[4 * 33], s[5 * 33]); o.w = pk2(s[6 * 33], s[7 * 33]);
                  *(v4u*)(dst + (size_t)n * ldk + 8 * c) = o; }
          } else {
#pragma unroll
              for (int j = 0; j < 4; ++j) { const int n = (lane >> 3) + 8 * j; const LAS float* s = scr + (8 * c) * 33 + n;
                  int w0 = 0, w1 = 0;
                  w0 = __builtin_amdgcn_cvt_pk_fp8_f32(32.f * s[0 * 33], 32.f * s[1 * 33], w0, false); w0 = __builtin_amdgcn_cvt_pk_fp8_f32(32.f * s[2 * 33], 32.f * s[3 * 33], w0, true);
                  w1 = __builtin_amdgcn_cvt_pk_fp8_f32(32.f * s[4 * 33], 32.f * s[5 * 33], w1, false); w1 = __builtin_amdgcn_cvt_pk_fp8_f32(32.f * s[6 * 33], 32.f * s[7 * 33], w1, true);
                  typedef int v2i_ __attribute__((ext_vector_type(2)));
                  *(v2i_*)((unsigned char*)dst + (size_t)n * (size_t)(-ldk) + 8 * c) = (v2i_){w0, w1}; }
          }
          LDS_WAIT(); asm volatile("" ::: "memory");
#pragma unroll
          for (int i = 0; i < 32; ++i) tv[i] = tn[i];
          src = nsrc; dst = ndst; ldw = nldw; ldk = nldk; it = nx; } }
#undef P0_DECODE
#undef P0_LOAD
    for (int i = C.gw * 64 + lane; i < 4096 * 24; i += C.NGW * 64) { const int row = i / 24, ch = i % 24; *(v4u*)(W3T + (size_t)row * 256 + 64 + 8 * ch) = (v4u){0u, 0u, 0u, 0u}; }
    { const float* x = in(0); bf16* XB = (bf16*)(ws + WS_XB); unsigned char* XQ8 = ws + WS_XQ8; const int NG = MTOK * DM / 8, STR = C.NGW * 64;
      for (int i = C.gw * 64 + lane; i < NG; i += 2 * STR) { const int j = i + STR; const bool h = j < NG;
          const f32x4 a0 = *(const f32x4*)(x + (size_t)i * 8), b0 = *(const f32x4*)(x + (size_t)i * 8 + 4);
          f32x4 a1 = a0, b1 = b0; if (h) { a1 = *(const f32x4*)(x + (size_t)j * 8); b1 = *(const f32x4*)(x + (size_t)j * 8 + 4); }
          v4u o; o.x = pk2(a0[0], a0[1]); o.y = pk2(a0[2], a0[3]); o.z = pk2(b0[0], b0[1]); o.w = pk2(b0[2], b0[3]); *(v4u*)(XB + (size_t)i * 8) = o;
          { int w0 = 0, w1 = 0; typedef int v2i_ __attribute__((ext_vector_type(2)));
            w0 = __builtin_amdgcn_cvt_pk_fp8_f32(8.f * a0[0], 8.f * a0[1], w0, false); w0 = __builtin_amdgcn_cvt_pk_fp8_f32(8.f * a0[2], 8.f * a0[3], w0, true);
            w1 = __builtin_amdgcn_cvt_pk_fp8_f32(8.f * b0[0], 8.f * b0[1], w1, false); w1 = __builtin_amdgcn_cvt_pk_fp8_f32(8.f * b0[2], 8.f * b0[3], w1, true);
            *(v2i_*)(XQ8 + (size_t)i * 8) = (v2i_){w0, w1}; }
          if (h) { v4u o1; o1.x = pk2(a1[0], a1[1]); o1.y = pk2(a1[2], a1[3]); o1.z = pk2(b1[0], b1[1]); o1.w = pk2(b1[2], b1[3]); *(v4u*)(XB + (size_t)j * 8) = o1;
            int w0 = 0, w1 = 0; typedef int v2i_ __attribute__((ext_vector_type(2)));
            w0 = __builtin_amdgcn_cvt_pk_fp8_f32(8.f * a1[0], 8.f * a1[1], w0, false); w0 = __builtin_amdgcn_cvt_pk_fp8_f32(8.f * a1[2], 8.f * a1[3], w0, true);
            w1 = __builtin_amdgcn_cvt_pk_fp8_f32(8.f * b1[0], 8.f * b1[1], w1, false); w1 = __builtin_amdgcn_cvt_pk_fp8_f32(8.f * b1[2], 8.f * b1[3], w1, true);
            *(v2i_*)(XQ8 + (size_t)j * 8) = (v2i_){w0, w1}; } } }
    { const float* w1 = in(5); const float* b1 = in(6); const float* f1 = in(7); const float* w2 = in(8); const float* b2 = in(9); const float* fq2 = in(10); bf16* H2 = (bf16*)(ws + WS_H2);
      const float b1k = b1[lane], f1k = f1[lane], b2k = b2[lane], f2k = fq2[lane];
      for (int t = C.gw; t < SEQ; t += C.NGW) {
          float acc = b1k + ((float)t * (1.0f / 16383.0f)) * w1[lane];
#pragma unroll
          for (int i = 0; i < 16; ++i) { const float fi = 1e-4f + (float)i * ((15.0f - 1e-4f) / 15.0f); const float rev = fi * (float)t * (1.0f / 16384.0f);
              acc += COSREV(rev) * w1[(1 + i) * 64 + lane] - SINREV(rev) * w1[(17 + i) * 64 + lane]; }
          const float h1 = SINREV(f1k * acc * 0.15915494309189535f);
          scr[lane] = h1; LDS_WAIT(); asm volatile("" ::: "memory");
          float a2 = b2k;
#pragma unroll 16
          for (int j = 0; j < 64; ++j) a2 += scr[j] * w2[j * 64 + lane];
          const float h2 = SINREV(f2k * a2 * 0.15915494309189535f);
          LDS_WAIT(); asm volatile("" ::: "memory");
          bf16* o = H2 + (size_t)t * 256; o[lane] = (bf16)f2bf(h2); o[64 + lane] = 0; o[128 + lane] = 0; o[192 + lane] = 0;
      } }
#undef in
}

__device__ __forceinline__ void p7_side_transposes(const Ctx& C, const float* wdown, unsigned char* ws) {
    LAS float* scr = (LAS float*)(C.lds + C.wave * 16384); bf16* WD = (bf16*)(ws + WS_WD);
    const int nw = (C.G - 32) * NWAVES, w0 = (blockIdx.x - 32) * NWAVES + C.wave;
    for (int r = w0; r < P7_MOVE; r += nw) { const int e = r / (24 * 64), q = r % (24 * 64), kb = q / 64, nb = q % 64;
        transpose_item(wdown + (size_t)e * EFF * DM, DM, 64 * kb, 32 * nb, (bf16*)((unsigned char*)WD + ((size_t)e * DM + 32 * nb) * EFF + 64 * kb), -EFF, scr, C.lane); }
}
__device__ __forceinline__ void p2_kpass(const Ctx& C, const float* kn, unsigned char* ws) {
    const bf16* QKV = (const bf16*)(ws + WS_QKV); unsigned char* KP8 = ws + WS_KP; unsigned char* VT8 = ws + WS_VP;
    const int lane = C.lane; const float g0 = kn[2 * lane], g1 = kn[2 * lane + 1];
    const float inv = __builtin_amdgcn_exp2f(-(float)(lane & 31) * (13.287712379549449f / 32.0f));
    for (int it = C.gw; it < MTOK / 2; it += C.NGW) {
        const int kvh = it & 1, m0 = 4 * (it >> 1), b = m0 >> 14, l0 = m0 & (SEQ - 1);
        unsigned pk[4], pv[4];
#pragma unroll
        for (int u = 0; u < 4; ++u) { pk[u] = *(const unsigned*)(QKV + (size_t)(m0 + u) * NATT + 1024 + kvh * 128 + 2 * lane); pv[u] = *(const unsigned*)(QKV + (size_t)(m0 + u) * NATT + 1280 + kvh * 128 + 2 * lane); }
        unsigned vlo = 0u, vhi = 0u;
#pragma unroll
        for (int u = 0; u < 4; ++u) { const int l = l0 + u;
            float x0 = bflo(pk[u]), x1 = bfhi(pk[u]);
            const float ss = wave_sum(x0 * x0 + x1 * x1), rs = 1.0f / sqrtf(ss * (1.0f / 128.0f) + LN_EPS);
            x0 *= rs * g0; x1 *= rs * g1;
            const float pos = (float)(lane < 32 ? (l >> 6) : (l & 63)), rev = pos * inv * 0.15915494309189535f, c = COSREV(rev), s = SINREV(rev);
            *(unsigned short*)(KP8 + (((size_t)(b * 2 + kvh) * SEQ + l) * 128) + 2 * lane) = (unsigned short)__builtin_amdgcn_cvt_pk_fp8_f32(x0 * c - x1 * s, x0 * s + x1 * c, 0, false);
            const unsigned w8 = (unsigned)__builtin_amdgcn_cvt_pk_fp8_f32(4.f * bflo(pv[u]), 4.f * bfhi(pv[u]), 0, false);
            vlo |= (w8 & 0xffu) << (8 * u); vhi |= ((w8 >> 8) & 0xffu) << (8 * u); }
        {
          const int kk = l0 & 63, hi_ = (kk >> 2) & 1, j_ = 16 * (kk >> 5) + 4 * ((kk & 31) >> 3), bp = 32 * hi_ + j_, q4 = bp >> 4;
          unsigned char* tb = VT8 + (((size_t)(b * 2 + kvh) * SEQ) + (size_t)(l0 & ~63)) * 128; const int c0 = 2 * lane, c1 = 2 * lane + 1;
          *(unsigned*)(tb + c0 * 64 + (((q4 ^ ((c0 >> 2) & 3)) << 4) | (bp & 15))) = vlo;
          *(unsigned*)(tb + c1 * 64 + (((q4 ^ ((c1 >> 2) & 3)) << 4) | (bp & 15))) = vhi; } }
}

__device__ __forceinline__ float hy_dppx(float v) { return __builtin_bit_cast(float, __builtin_amdgcn_mov_dpp(__builtin_bit_cast(int, v), 0xB1, 0xF, 0xF, true)); }
__device__ __forceinline__ void hy_bulk(unsigned char* dst, const bf16* src0, const bf16* src1, int t) {
    v4u v[8];
#pragma unroll
    for (int k = 0; k < 8; ++k) { const int ch = t + 512 * k; const bf16* s = (ch < 2048 ? src0 : src1) + (size_t)(ch & 2047) * 8; v[k] = *(const v4u*)s; }
#pragma unroll
    for (int k = 0; k < 8; ++k) *(v4u*)(dst + (size_t)(t + 512 * k) * 16) = v[k];
}
__device__ __forceinline__ void hy_unit(int c, const float* cw, const float* cbias, const float* skip, unsigned char* ws, unsigned char* lds, int t, unsigned long long& tacc_) {
    unsigned long long t0_ = 0; TSEC_B(7);
    const bf16* PT = (const bf16*)(ws + WS_PT); const bf16* FILT = (const bf16*)(ws + WS_FILT); bf16* YHT = (bf16*)(ws + WS_YHT);
    f2* X = (f2*)lds; unsigned char* TB = lds + HY_BUF * 8; const bf16* TAPS = (const bf16*)TB;
    const HyTw tw = hy_tw(t);
    unsigned* zp = (unsigned*)(ws + WS_ZPG) + (size_t)blockIdx.x * (32 * 512); f2* yg = (f2*)(ws + WS_YACC) + (size_t)blockIdx.x * (32 * 512);
    HY_OPAQUE(t);
    TSEC_B(6);
    { const bf16* row = PT + (size_t)c * MTOK; hy_bulk(TB, row, row + SEQ, t); __syncthreads();
      const float w0 = cw[c], w1 = cw[NHY + c], w2 = cw[2 * NHY + c], cb = cbias[c];
#pragma unroll
      for (int n1 = 0; n1 < 16; ++n1)
#pragma unroll
          for (int j = 0; j < 2; ++j) { zp[(2 * n1 + j) * 512 + t] = hy_pack(hy_sconv(TAPS, t + 512 * n1 + HY_P * j, w0, w1, w2, cb)); if (n1 & 1) HY_FENCE(); }
      __syncthreads(); }
    TSEC_E(6);
#pragma unroll 1
    for (int order = 0; order < 2; ++order) {
        TSEC_B(6);
        hy_bulk(TB, FILT + (size_t)(order * 1024 + c) * SEQ, FILT + (size_t)(2048 + order * 1024 + c) * SEQ, t); __syncthreads();
        TSEC_E(6);
        f2 yacc[16][2];
#pragma unroll
        for (int n1 = 0; n1 < 16; ++n1) { yacc[n1][0] = (f2){0.f, 0.f}; yacc[n1][1] = (f2){0.f, 0.f}; }
#pragma unroll 1
        for (int R = 0; R < 4; ++R) {
            unsigned Gp[16];
            TSEC_B(1); hy_stage1A(X, t, R, TAPS, TAPS + SEQ, tw.w8192); __syncthreads(); TSEC_E(1);
            TSEC_B(2); hy_fwd1<5>(X, t, tw.w512); __syncthreads(); TSEC_E(2);
            TSEC_B(3); { int t3 = t; HY_OPAQUE(t3); f2 G[16]; hy_fwd3(X, t3, G);
#pragma unroll
              for (int i = 0; i < 16; ++i) Gp[i] = hy_pack(G[i]); } __syncthreads(); TSEC_E(3);
            TSEC_B(1); hy_stage1B(X, t, R, zp, tw.w8192); __syncthreads(); TSEC_E(1);
            TSEC_B(2); hy_fwd1<5>(X, t, tw.w512); __syncthreads(); TSEC_E(2);
            TSEC_B(3);
            { int t3 = t; HY_OPAQUE(t3); f2 xb[16];
              hy_fwd3(X, t3, xb);
              struct XD { const unsigned (&g)[16]; const f2 (&xb)[16];
                  __device__ __forceinline__ unsigned a(int i) const { return (unsigned)__builtin_amdgcn_mov_dpp((int)g[i], 0xB1, 0xF, 0xF, true); }
                  __device__ __forceinline__ f2 b(int i) const { return (f2){hy_dppx(xb[i].x), hy_dppx(xb[i].y)}; } } P{Gp, xb};
              hy_s3_fin(X, t3, xb, Gp, P); }
            __syncthreads(); TSEC_E(3);
            TSEC_B(4); hy_inv1<5>(X, t, tw.w512); __syncthreads(); TSEC_E(4);
            TSEC_B(5); hy_inv1_acc(X, t, R, tw.w8192, yacc); TSEC_E(5);
            HY_SCHED();
        }
        TSEC_B(6);
        const int ch = (order + 1) * HYW + c;
        HY_OPAQUE(t);
        { const bf16* row = PT + (size_t)ch * MTOK; hy_bulk(TB, row, row + SEQ, t); __syncthreads(); }
        const float w0 = cw[ch], w1 = cw[NHY + ch], w2 = cw[2 * NHY + ch], cb = cbias[ch], d = skip[order * HYW + c];
        bf16* o0 = YHT + (size_t)c * SEQ; bf16* o1 = YHT + (size_t)(HYW + c) * SEQ;
#pragma unroll
        for (int hh = 0; hh < 2; ++hh) {
            unsigned zq[8][2];
#pragma unroll
            for (int q = 0; q < 8; ++q) { zq[q][0] = zp[(2 * (8 * hh + q)) * 512 + t]; zq[q][1] = zp[(2 * (8 * hh + q) + 1) * 512 + t]; }
#pragma unroll
            for (int q = 0; q < 8; ++q) { const int n1 = 8 * hh + q;
#pragma unroll
                for (int j = 0; j < 2; ++j) { const int n = t + 512 * n1 + HY_P * j; const f2 ux = hy_sconv(TAPS, n, w0, w1, w2, cb), zz = hy_unpack(zq[q][j]);
                    const f2 y = ux * (yacc[n1][j] * (1.0f / 32768.0f) + zz * d);
                    if (order == 0) zp[(2 * n1 + j) * 512 + t] = hy_pack(y); else { o0[n] = (bf16)hy_f2bf(y.x); o1[n] = (bf16)hy_f2bf(y.y); } }
                if (q & 1) HY_FENCE(); }
        }
        __syncthreads();
        TSEC_E(6);
    }
    TSEC_E(7);
}

__device__ __forceinline__ void p4_merge(const Ctx& C, const float* ghy, const float* gatt, unsigned char* ws) {
    const bf16* YHT = (const bf16*)(ws + WS_YHT); const bf16* YATT = (const bf16*)(ws + WS_YATT); bf16* MIX = (bf16*)(ws + WS_MIX);
    const int lane = C.lane, tid = C.tid;
    for (int m = C.gw; m < MTOK; m += C.NGW) { const bf16* r = YATT + (size_t)m * 1024;
        const v4u a = *(const v4u*)(r + 8 * lane), b = *(const v4u*)(r + 512 + 8 * lane);
        float v[16]; v[0] = bflo(a.x); v[1] = bfhi(a.x); v[2] = bflo(a.y); v[3] = bfhi(a.y); v[4] = bflo(a.z); v[5] = bfhi(a.z); v[6] = bflo(a.w); v[7] = bfhi(a.w);
        v[8] = bflo(b.x); v[9] = bfhi(b.x); v[10] = bflo(b.y); v[11] = bfhi(b.y); v[12] = bflo(b.z); v[13] = bfhi(b.z); v[14] = bflo(b.w); v[15] = bfhi(b.w);
        float ss = 0.f;
#pragma unroll
        for (int i = 0; i < 16; ++i) ss += v[i] * v[i];
        const float rs = 1.0f / sqrtf(wave_sum(ss) * (1.0f / 1024.0f) + LN_EPS);
        const f32x4 g0 = *(const f32x4*)(gatt + 8 * lane), g1 = *(const f32x4*)(gatt + 8 * lane + 4), g2 = *(const f32x4*)(gatt + 512 + 8 * lane), g3 = *(const f32x4*)(gatt + 512 + 8 * lane + 4);
        v4u o0, o1;
        o0.x = pk2(v[0] * rs * g0[0], v[1] * rs * g0[1]); o0.y = pk2(v[2] * rs * g0[2], v[3] * rs * g0[3]); o0.z = pk2(v[4] * rs * g1[0], v[5] * rs * g1[1]); o0.w = pk2(v[6] * rs * g1[2], v[7] * rs * g1[3]);
        o1.x = pk2(v[8] * rs * g2[0], v[9] * rs * g2[1]); o1.y = pk2(v[10] * rs * g2[2], v[11] * rs * g2[3]); o1.z = pk2(v[12] * rs * g3[0], v[13] * rs * g3[1]); o1.w = pk2(v[14] * rs * g3[2], v[15] * rs * g3[3]);
        bf16* d = MIX + (size_t)m * DM + 1024; *(v4u*)(d + 8 * lane) = o0; *(v4u*)(d + 512 + 8 * lane) = o1; }
    LAS unsigned short* tile = (LAS unsigned short*)C.lds; LAS float* red = (LAS float*)(C.lds + 512 * 136);
    const int tau = tid & 63, cg = tid >> 6;
    for (int u = blockIdx.x; u < MTOK / 64; u += C.G) { const int b = u >> 8, n0 = (u & 255) * 64;
        unsigned pk[2][32]; float ss = 0.f;
#pragma unroll
        for (int h = 0; h < 2; ++h) {
            __syncthreads();
#pragma unroll
            for (int i = 0; i < 8; ++i) { const int cl = i * 64 + (tid >> 3), seg = tid & 7;
                const v4u v = *(const v4u*)(YHT + ((size_t)(b * 1024 + h * 512 + cl)) * SEQ + n0 + 8 * seg);
                LAS unsigned* d = (LAS unsigned*)(tile + cl * 68 + 8 * seg); d[0] = v.x; d[1] = v.y; d[2] = v.z; d[3] = v.w; }
            __syncthreads();
#pragma unroll
            for (int k = 0; k < 32; ++k) { const unsigned lo = tile[(cg * 64 + 2 * k) * 68 + tau], hi2 = tile[(cg * 64 + 2 * k + 1) * 68 + tau];
                pk[h][k] = lo | (hi2 << 16); const float a = bflo(lo << 0), bb = __builtin_bit_cast(float, hi2 << 16); ss += a * a + bb * bb; }
        }
        __syncthreads();
        red[cg * 64 + tau] = ss; __syncthreads();
        float tot = 0.f;
#pragma unroll
        for (int g = 0; g < 8; ++g) tot += red[g * 64 + tau];
        const float rs = 1.0f / sqrtf(tot * (1.0f / 1024.0f) + LN_EPS);
        bf16* d = MIX + (size_t)(b * SEQ + n0 + tau) * DM;
#pragma unroll
        for (int h = 0; h < 2; ++h) { const int c0 = h * 512 + cg * 64;
#pragma unroll
            for (int q = 0; q < 8; ++q) { const f32x4 g0 = *(const f32x4*)(ghy + c0 + 8 * q), g1 = *(const f32x4*)(ghy + c0 + 8 * q + 4); v4u o;
                o.x = pk2(bflo(pk[h][4 * q]) * rs * g0[0], bfhi(pk[h][4 * q]) * rs * g0[1]); o.y = pk2(bflo(pk[h][4 * q + 1]) * rs * g0[2], bfhi(pk[h][4 * q + 1]) * rs * g0[3]);
                o.z = pk2(bflo(pk[h][4 * q + 2]) * rs * g1[0], bfhi(pk[h][4 * q + 2]) * rs * g1[1]); o.w = pk2(bflo(pk[h][4 * q + 3]) * rs * g1[2], bfhi(pk[h][4 * q + 3]) * rs * g1[3]);
                *(v4u*)(d + c0 + 8 * q) = o; } }
    }
}

__device__ __forceinline__ float p6_dot2(unsigned x, unsigned w, float acc) { typedef __bf16 bf2 __attribute__((ext_vector_type(2))); return __builtin_amdgcn_fdot2_f32_bf16(__builtin_bit_cast(bf2, x), __builtin_bit_cast(bf2, w), acc, false); }
__device__ __forceinline__ void p6_ln_router(const Ctx& C, const float* g, const float* be, const float* wr, const float* br, unsigned char* ws) {
    typedef __bf16 bf2 __attribute__((ext_vector_type(2)));
    const bf16* T = (const bf16*)(ws + WS_T); bf16* X1 = (bf16*)(ws + WS_X1); float* AFF = (float*)(ws + WS_AFF); unsigned char* X8 = ws + WS_X8;
    const int lane = C.lane; LAS v4u* wl = (LAS v4u*)C.lds;
    __syncthreads();
    for (int idx = C.tid; idx < 1024 * 4; idx += 512) { const int pp = idx >> 2, q = idx & 3, k = 2 * pp, ppos = (pp >> 8) * 256 + (pp & 3) * 64 + ((pp >> 2) & 63);
        const f32x4 a = *(const f32x4*)(wr + k * 16 + 4 * q), b = *(const f32x4*)(wr + (k + 1) * 16 + 4 * q);
        v4u o; o.x = pk2(a[0], b[0]); o.y = pk2(a[1], b[1]); o.z = pk2(a[2], b[2]); o.w = pk2(a[3], b[3]); wl[q * 1024 + ppos] = o; }
    __syncthreads();
    for (int m = C.gw; m < MTOK; m += C.NGW) {
        float v[4][8]; float s = 0.f;
#pragma unroll
        for (int j = 0; j < 4; ++j) { const v4u a = *(const v4u*)(T + (size_t)m * DM + 512 * j + 8 * lane);
            v[j][0] = bflo(a.x); v[j][1] = bfhi(a.x); v[j][2] = bflo(a.y); v[j][3] = bfhi(a.y); v[j][4] = bflo(a.z); v[j][5] = bfhi(a.z); v[j][6] = bflo(a.w); v[j][7] = bfhi(a.w);
#pragma unroll
            for (int e = 0; e < 8; ++e) s += v[j][e]; }
        const float mean = wave_sum(s) * (1.0f / DM); float q2 = 0.f;
#pragma unroll
        for (int j = 0; j < 4; ++j)
#pragma unroll
            for (int e = 0; e < 8; ++e) { v[j][e] -= mean; q2 += v[j][e] * v[j][e]; }
        const float rstd = 1.0f / sqrtf(wave_sum(q2) * (1.0f / DM) + LN_EPS);
        float acc[16];
#pragma unroll
        for (int e = 0; e < 16; ++e) acc[e] = 0.f;
#pragma unroll
        for (int j = 0; j < 4; ++j) { const int k0 = 512 * j + 8 * lane;
            const f32x4 ga = *(const f32x4*)(g + k0), gb = *(const f32x4*)(g + k0 + 4), ba = *(const f32x4*)(be + k0), bb = *(const f32x4*)(be + k0 + 4);
            unsigned o[4];
            o[0] = pk2(v[j][0] * rstd * ga[0] + ba[0], v[j][1] * rstd * ga[1] + ba[1]); o[1] = pk2(v[j][2] * rstd * ga[2] + ba[2], v[j][3] * rstd * ga[3] + ba[3]);
            o[2] = pk2(v[j][4] * rstd * gb[0] + bb[0], v[j][5] * rstd * gb[1] + bb[1]); o[3] = pk2(v[j][6] * rstd * gb[2] + bb[2], v[j][7] * rstd * gb[3] + bb[3]);
            *(v4u*)(X1 + (size_t)m * DM + k0) = (v4u){o[0], o[1], o[2], o[3]};
            { int w0 = 0, w1 = 0;
              w0 = __builtin_amdgcn_cvt_pk_fp8_f32(bflo(o[0]), bfhi(o[0]), w0, false); w0 = __builtin_amdgcn_cvt_pk_fp8_f32(bflo(o[1]), bfhi(o[1]), w0, true);
              w1 = __builtin_amdgcn_cvt_pk_fp8_f32(bflo(o[2]), bfhi(o[2]), w1, false); w1 = __builtin_amdgcn_cvt_pk_fp8_f32(bflo(o[3]), bfhi(o[3]), w1, true);
              typedef int v2i_ __attribute__((ext_vector_type(2)));
              *(v2i_*)(X8 + (size_t)m * DM + k0) = (v2i_){w0, w1}; }
#pragma unroll
            for (int pe = 0; pe < 4; ++pe) { const unsigned xp = o[pe]; const int ppos = j * 256 + pe * 64 + lane;
#pragma unroll
                for (int q = 0; q < 4; ++q) { const v4u w = wl[q * 1024 + ppos]; const unsigned w0 = w.x, w1 = w.y, w2 = w.z, w3 = w.w;
                    acc[4 * q] = p6_dot2(xp, w0, acc[4 * q]); acc[4 * q + 1] = p6_dot2(xp, w1, acc[4 * q + 1]); acc[4 * q + 2] = p6_dot2(xp, w2, acc[4 * q + 2]); acc[4 * q + 3] = p6_dot2(xp, w3, acc[4 * q + 3]); }
                if (pe & 1) asm volatile("" ::: "memory"); } }
        const bool b0 = lane & 1, b1 = lane & 2, b2 = lane & 4, b3 = lane & 8;
        float r8[8], r4[4], r2[2];
#pragma unroll
        for (int i = 0; i < 8; ++i) r8[i] = (b0 ? acc[8 + i] : acc[i]) + dpp_f<0xB1>(b0 ? acc[i] : acc[8 + i]);
#pragma unroll
        for (int i = 0; i < 4; ++i) r4[i] = (b1 ? r8[4 + i] : r8[i]) + dpp_f<0x4E>(b1 ? r8[i] : r8[4 + i]);
#pragma unroll
        for (int i = 0; i < 2; ++i) r2[i] = (b2 ? r4[2 + i] : r4[i]) + dpp_f<0x1B>(dpp_f<0x141>(b2 ? r4[i] : r4[2 + i]));
        float lg = (b3 ? r2[1] : r2[0]) + dpp_f<0x128>(b3 ? r2[0] : r2[1]);
        lg += __shfl_xor(lg, 16); lg += __shfl_xor(lg, 32);
        const int ex = (b0 ? 8 : 0) + (b1 ? 4 : 0) + (b2 ? 2 : 0) + (b3 ? 1 : 0);
        lg += br[ex];
        const float mx = row16_max(lg), pe_ = __expf(lg - mx), den = row16_sum(pe_);
        if (lane < 16) AFF[(size_t)((m >> 14) * 16 + ex) * SEQ + (m & (SEQ - 1))] = pe_ / den;
    }
    __syncthreads();
}

__device__ __forceinline__ void p7_topk(const Ctx& C, int be, unsigned char* ws) {
    const float* AFF = (const float*)(ws + WS_AFF); int* IDX = (int*)(ws + WS_IDX); float* GATE = (float*)(ws + WS_GATE); short* SLOT = (short*)(ws + WS_SLOT);
    LAS unsigned* keys = (LAS unsigned*)C.lds;
    LAS unsigned* hist = (LAS unsigned*)(C.lds + 67584); LAS unsigned* misc = hist + 256; LAS unsigned* wsum = misc + 8;
    const int tid = C.tid, lane = C.lane, b = be >> 4, e = be & 15;
    __syncthreads();
    for (int i = tid; i < SEQ; i += 512) keys[i + (i >> 5)] = __float_as_uint(AFF[(size_t)be * SEQ + i]);
    unsigned prefix = 0u, mask = 0u, remaining = CAP;
#pragma unroll 1
    for (int pass = 0; pass < 4; ++pass) { const int shift = 24 - 8 * pass;
        if (tid < 256) hist[tid] = 0u;
        __syncthreads();
        for (int i = tid; i < SEQ; i += 512) { const unsigned k = keys[i + (i >> 5)]; if ((k & mask) == prefix) atomicAdd((unsigned*)&hist[(k >> shift) & 255u], 1u); }
        __syncthreads();
        if (tid < 64) { const unsigned c0 = hist[4 * lane], c1 = hist[4 * lane + 1], c2 = hist[4 * lane + 2], c3 = hist[4 * lane + 3]; const unsigned s4 = c0 + c1 + c2 + c3;
            unsigned inc = s4;
#pragma unroll
            for (int o = 1; o < 64; o <<= 1) { const unsigned y = __shfl_up(inc, o); if (lane >= o) inc += y; }
            const unsigned total = __shfl(inc, 63); unsigned cum = total - inc;
            const unsigned cs[4] = {c0, c1, c2, c3};
#pragma unroll
            for (int q = 3; q >= 0; --q) { if (cum < remaining && cum + cs[q] >= remaining) { misc[0] = 4 * lane + q; misc[1] = remaining - cum; } cum += cs[q]; } }
        __syncthreads();
        prefix |= misc[0] << shift; mask |= 0xffu << shift; remaining = misc[1];
        __syncthreads();
    }
    const unsigned T = prefix, need_eq = remaining;
    unsigned cg = 0, ce = 0;
#pragma unroll 8
    for (int i = 0; i < 32; ++i) { const unsigned k = keys[33 * tid + i]; cg += (k > T); ce += (k == T); }
    unsigned inc = cg | (ce << 16);
#pragma unroll
    for (int o = 1; o < 64; o <<= 1) { const unsigned y = __shfl_up(inc, o); if (lane >= o) inc += y; }
    if (lane == 63) wsum[C.wave] = inc;
    __syncthreads();
    unsigned off = 0;
#pragma unroll
    for (int w = 0; w < 8; ++w) off += (w < C.wave) ? wsum[w] : 0u;
    const unsigned ex = inc - (cg | (ce << 16)) + off; unsigned pg = ex & 0xffffu, pe = ex >> 16;
    const size_t rbase = (size_t)(e * 2 + b) * CAP;
#pragma unroll 4
    for (int i = 0; i < 32; ++i) { const unsigned k = keys[33 * tid + i]; const int tok = 32 * tid + i; int slot = -1;
        if (k > T) { slot = (int)(pg + (pe < need_eq ? pe : need_eq)); ++pg; }
        else if (k == T) { if (pe < need_eq) slot = (int)(pg + pe); ++pe; }
        SLOT[((size_t)b * SEQ + tok) * 16 + e] = (short)slot;
        if (slot >= 0) { IDX[rbase + slot] = tok; GATE[rbase + slot] = __uint_as_float(k); } }
    __syncthreads();
}

__device__ __forceinline__ void p8_gather(const Ctx& C, unsigned char* ws) {
    const bf16* X1 = (const bf16*)(ws + WS_X1); bf16* XG = (bf16*)(ws + WS_XG); const int* IDX = (const int*)(ws + WS_IDX);
    for (int r0 = C.gw; r0 < MOE_ROWS; r0 += 4 * C.NGW) {
        int tok[4];
#pragma unroll
        for (int u = 0; u < 4; ++u) tok[u] = IDX[min(r0 + u * C.NGW, MOE_ROWS - 1)];
        v4u a[4][4];
#pragma unroll
        for (int u = 0; u < 4; ++u) { const int r = min(r0 + u * C.NGW, MOE_ROWS - 1), b = (r >> 11) & 1; const v4u* s = (const v4u*)(X1 + (size_t)(b * SEQ + tok[u]) * DM) + C.lane;
            a[u][0] = s[0]; a[u][1] = s[64]; a[u][2] = s[128]; a[u][3] = s[192]; }
#pragma unroll
        for (int u = 0; u < 4; ++u) { v4u* d = (v4u*)(XG + (size_t)min(r0 + u * C.NGW, MOE_ROWS - 1) * DM) + C.lane; d[0] = a[u][0]; d[64] = a[u][1]; d[128] = a[u][2]; d[192] = a[u][3]; } }
}

__device__ __forceinline__ void p11_final(const Ctx& C, const float* g, const float* be, float* out, unsigned char* ws) {
    const bf16* X1 = (const bf16*)(ws + WS_X1); const unsigned char* Y = ws + WS_Y; const short* SLOT = (const short*)(ws + WS_SLOT);
    const unsigned char* ZROW = ws + WS_CTL + 512 * 1024;
    const int lane = C.lane;
    for (int m = C.gw; m < MTOK; m += C.NGW) { const int b = m >> 14;
        float v[4][8];
#pragma unroll
        for (int j = 0; j < 4; ++j) { const v4u a = *(const v4u*)(X1 + (size_t)m * DM + 512 * j + 8 * lane);
            v[j][0] = bflo(a.x); v[j][1] = bfhi(a.x); v[j][2] = bflo(a.y); v[j][3] = bfhi(a.y); v[j][4] = bflo(a.z); v[j][5] = bfhi(a.z); v[j][6] = bflo(a.w); v[j][7] = bfhi(a.w);
#pragma unroll
            for (int e = 0; e < 8; ++e) v[j][e] *= DN_ALPHA; }
        const v4u s0 = *(const v4u*)(SLOT + (size_t)m * 16), s1 = *(const v4u*)(SLOT + (size_t)m * 16 + 8);
        const unsigned sw[8] = {s0.x, s0.y, s0.z, s0.w, s1.x, s1.y, s1.z, s1.w};
        int r0 = -1, r1 = -1, r2 = -1, r3 = -1, n = 0; unsigned rest = 0u;
#pragma unroll
        for (int e = 0; e < 16; ++e) { const int sl = __builtin_amdgcn_readfirstlane((int)(short)((e & 1) ? (sw[e >> 1] >> 16) : (sw[e >> 1] & 0xffffu)));
            if (sl >= 0) { const int row = (e * 2 + b) * CAP + sl; if (n == 0) r0 = row; else if (n == 1) r1 = row; else if (n == 2) r2 = row; else if (n == 3) r3 = row; else rest |= 1u << e; ++n; } }
        typedef int v2i_ __attribute__((ext_vector_type(2))); typedef float f2v_ __attribute__((ext_vector_type(2)));
#define ADD8(A) do { const int ax_ = A.x, ay_ = A.y; const f2v_ c0 = __builtin_amdgcn_cvt_pk_f32_fp8(ax_, false), c1 = __builtin_amdgcn_cvt_pk_f32_fp8(ax_, true), c2 = __builtin_amdgcn_cvt_pk_f32_fp8(ay_, false), c3 = __builtin_amdgcn_cvt_pk_f32_fp8(ay_, true); \
        v[j][0] += c0.x * (1.f / 64.f); v[j][1] += c0.y * (1.f / 64.f); v[j][2] += c1.x * (1.f / 64.f); v[j][3] += c1.y * (1.f / 64.f); v[j][4] += c2.x * (1.f / 64.f); v[j][5] += c2.y * (1.f / 64.f); v[j][6] += c3.x * (1.f / 64.f); v[j][7] += c3.y * (1.f / 64.f); } while (0)
        { const unsigned char* p0 = r0 >= 0 ? Y + (size_t)r0 * DM : ZROW; const unsigned char* p1 = r1 >= 0 ? Y + (size_t)r1 * DM : ZROW; const unsigned char* p2 = r2 >= 0 ? Y + (size_t)r2 * DM : ZROW; const unsigned char* p3 = r3 >= 0 ? Y + (size_t)r3 * DM : ZROW;
          v2i_ a0[4], a1[4], a2[4], a3[4];
#pragma unroll
          for (int j = 0; j < 4; ++j) { a0[j] = *(const v2i_*)(p0 + 512 * j + 8 * lane); a1[j] = *(const v2i_*)(p1 + 512 * j + 8 * lane); a2[j] = *(const v2i_*)(p2 + 512 * j + 8 * lane); a3[j] = *(const v2i_*)(p3 + 512 * j + 8 * lane); }
#pragma unroll
          for (int j = 0; j < 4; ++j) { ADD8(a0[j]); ADD8(a1[j]); ADD8(a2[j]); ADD8(a3[j]); } }
        while (rest) { const int e = __builtin_ctz(rest); rest &= rest - 1u;
            const int sl = __builtin_amdgcn_readfirstlane((int)*(const short*)(SLOT + (size_t)m * 16 + e));
            const unsigned char* yr = Y + ((size_t)(e * 2 + b) * CAP + sl) * DM;
#pragma unroll
            for (int j = 0; j < 4; ++j) { const v2i_ a = *(const v2i_*)(yr + 512 * j + 8 * lane); ADD8(a); } }
#undef ADD8
        float s = 0.f;
#pragma unroll
        for (int j = 0; j < 4; ++j)
#pragma unroll
            for (int e = 0; e < 8; ++e) s += v[j][e];
        const float mean = wave_sum(s) * (1.0f / DM); float q2 = 0.f;
#pragma unroll
        for (int j = 0; j < 4; ++j)
#pragma unroll
            for (int e = 0; e < 8; ++e) { v[j][e] -= mean; q2 += v[j][e] * v[j][e]; }
        const float rstd = 1.0f / sqrtf(wave_sum(q2) * (1.0f / DM) + LN_EPS);
#pragma unroll
        for (int j = 0; j < 4; ++j) { const int k0 = 512 * j + 8 * lane;
            const f32x4 ga = *(const f32x4*)(g + k0), gb = *(const f32x4*)(g + k0 + 4), ba = *(const f32x4*)(be + k0), bb = *(const f32x4*)(be + k0 + 4);
            f32x4 o0, o1;
#pragma unroll
            for (int e = 0; e < 4; ++e) { o0[e] = v[j][e] * rstd * ga[e] + ba[e]; o1[e] = v[j][4 + e] * rstd * gb[e] + bb[e]; }
            *(f32x4*)(out + (size_t)m * DM + k0) = o0; *(f32x4*)(out + (size_t)m * DM + k0 + 4) = o1; }
    }
}
struct Args { const float* in[28]; float* out; unsigned char* ws; int ph_lo, ph_hi; };
__global__ void __launch_bounds__(NWAVES * 64, 2) mega_fwd(Args args) {
    extern __shared__ __attribute__((aligned(16))) unsigned char lds[];
    Ctx C; C.lds = (LAS unsigned char*)lds; C.tid = threadIdx.x; C.lane = C.tid & 63; C.wave = __builtin_amdgcn_readfirstlane(C.tid >> 6);
    C.G = gridDim.x; C.gw = blockIdx.x * NWAVES + C.wave; C.NGW = C.G * NWAVES;
    unsigned char* ws = args.ws; unsigned* ctl = (unsigned*)(ws + WS_CTL);
    volatile LAS unsigned* MISC = (volatile LAS unsigned*)(C.lds + MISC_OFF);
    for (int u = C.tid; u < (LDS_BYTES - LDSCTL_OFF) / 4; u += NWAVES * 64) ((LAS unsigned*)(C.lds + LDSCTL_OFF))[u] = 0u;
    __syncthreads();
    XcdBarrier bar; bar.bar = ctl + CW_BAR; bar.x = 0; bar.st = nullptr;
    if (N_LAUNCHES == 1) bar = xcd_barrier_post(ctl + CW_BAR, MISC + 8);
    const int lo = args.ph_lo, hi = args.ph_hi;
    unsigned long long tacc_ = 0, t0_ = 0;
#ifndef REP_MASK
#define REP_MASK 0
#endif
#define REPS(k) _Pragma("unroll") for (int rep_ = 0; rep_ < 1 + ((REP_MASK >> (k)) & 1); ++rep_)
#ifndef GREP_MASK
#define GREP_MASK 0
#endif
#define GREPS(k) (1 + ((GREP_MASK >> (k)) & 1))
#ifndef PH_MASK
#define PH_MASK 0xfff
#endif
#define IN(k) (((PH_MASK >> (k)) & 1) && lo <= (k) && (k) < hi)
#define SEAM(k) do { if (IN(k) && IN((k) + 1)) xcd_barrier(bar); } while (0)
    typedef const float* __attribute__((address_space(4))) const* KPtr;
    KPtr in0 = (KPtr)__builtin_amdgcn_kernarg_segment_ptr();
#define LAUNDER_IN() KPtr in = in0; asm volatile("" : "+s"(in))
#define GIN(k) ((const float*)(__attribute__((address_space(1))) const float*)in[k])
    LAS unsigned char* ring = C.lds;

    TSEC_B(100);
    if (IN(0)) REPS(0) { LAUNDER_IN(); p0_prologue(C, in, ws); __syncthreads(); }
    SEAM(0); TSEC_E(100);
    TSEC_B(101);
    if (IN(1)) REPS(1) { LAUNDER_IN();
        { pg8::Gemm g{(const bf16*)(ws + WS_WIN), (const bf16*)(ws + WS_XB), NHY, MTOK, DM}; pg8::StaticOrder S; S.init(NHY, MTOK, C.G, (int)blockIdx.x); S.reps = GREPS(1);
          pg8::EpiRowBias E{(bf16*)(ws + WS_PT), MTOK, GIN(2)};
          pg8::gemm_phase<pg8::EpiRowBias, pg8::StaticOrder, true, true>(ring, g, S, E); }
        __syncthreads();
        { pg8::Gemm g{(const bf16*)(ws + WS_XQ8), (const bf16*)(ws + WS_WIN) + (size_t)NHY * DM, MTOK, NATT, DM / 2}; pg8::StaticOrder S; S.init(MTOK, NATT, C.G, (int)blockIdx.x); S.reps = GREPS(1);
          pg8::EpiColBias E{(bf16*)(ws + WS_QKV), NATT, GIN(2) + NHY};
          pg8::gemm_phase_8<pg8::EpiColBias, pg8::StaticOrder, 122, 124, true, true>(ring, g, S, E); }
        __syncthreads();
        { pg8::Gemm g{(const bf16*)(ws + WS_W3T), (const bf16*)(ws + WS_H2), 4096, SEQ, 256}; pg8::StaticOrder S; S.init(4096, SEQ, C.G, (int)blockIdx.x); S.reps = GREPS(1);
          pg8::EpiFilt E{(bf16*)(ws + WS_FILT), SEQ, GIN(12)};
          pg8::gemm_phase<pg8::EpiFilt, pg8::StaticOrder, true, true>(ring, g, S, E); }
        __syncthreads();
    }
    SEAM(1); TSEC_E(101);
    TSEC_B(102);
    if (IN(2)) REPS(2) { LAUNDER_IN();
        p2_kpass(C, GIN(15), ws);
        for (int c = blockIdx.x; c < HYW; c += C.G) { hy_unit(c, GIN(3), GIN(4), GIN(13), ws, lds, (C.wave << 6) + (int)__builtin_amdgcn_mbcnt_hi(~0u, __builtin_amdgcn_mbcnt_lo(~0u, 0u)), tacc_); __syncthreads(); }
    }
    SEAM(2); TSEC_E(102);
    TSEC_B(103);
    if (IN(3)) REPS(3) { LAUNDER_IN();
        const bf16* QKV = (const bf16*)(ws + WS_QKV); const unsigned char* KP = ws + WS_KP; const unsigned char* VP = ws + WS_VP; bf16* YATT = (bf16*)(ws + WS_YATT);
        for (int rnd = 0; rnd * C.G < 1024; ++rnd) {
            int b, h, qb;
            if (C.G == 256) { const int xcd = blockIdx.x & 7, w = blockIdx.x >> 3, pair = xcd >> 1, idx = (xcd & 1) * 128 + rnd * 32 + w; b = pair >> 1; h = (pair & 1) * 4 + (idx >> 6); qb = idx & 63; }
            else { const int u = rnd * C.G + blockIdx.x; if (u >= 1024) break; b = u >> 9; h = (u >> 6) & 7; qb = u & 63; }
            const int kvh = h >> 2; const size_t m0 = (size_t)b * SEQ + qb * 256;
            att::attn_unit(QKV + m0 * NATT + h * 128, qb * 256, GIN(14), KP + (size_t)(b * 2 + kvh) * SEQ * 128, VP + (size_t)(b * 2 + kvh) * SEQ * 128, YATT + m0 * 1024 + h * 128, SEQ, (char*)lds);
        }
    }
    SEAM(3); TSEC_E(103);
    TSEC_B(104);
    if (IN(4)) REPS(4) { LAUNDER_IN(); p4_merge(C, GIN(16), GIN(17), ws); __syncthreads(); }
    SEAM(4); TSEC_E(104);
    TSEC_B(105);
    if (IN(5)) REPS(5) { LAUNDER_IN();
        pg8::Gemm g{(const bf16*)(ws + WS_MIX), (const bf16*)(ws + WS_WOUT), MTOK, DM, DM}; pg8::StaticOrder S; S.init(MTOK, DM, C.G, (int)blockIdx.x); S.reps = GREPS(5);
        pg8::EpiResid E{(bf16*)(ws + WS_T), DM, (const bf16*)(ws + WS_XB), DN_ALPHA};
        pg8::gemm_phase<pg8::EpiResid, pg8::StaticOrder, true, true>(ring, g, S, E);
        __syncthreads();
    }
    SEAM(5); TSEC_E(105);
    TSEC_B(106);
    if (IN(6)) REPS(6) { LAUNDER_IN(); p6_ln_router(C, GIN(19), GIN(20), GIN(21), GIN(22), ws); }
    SEAM(6); TSEC_E(106);
    TSEC_B(107);
    if (IN(7)) REPS(7) { LAUNDER_IN(); if (blockIdx.x >= 32) p7_side_transposes(C, GIN(25), ws); else { for (int be = blockIdx.x; be < BATCH * NE; be += C.G) p7_topk(C, be, ws); } }
    SEAM(7); TSEC_E(107);
    TSEC_B(109);
    if (IN(9)) REPS(9) { LAUNDER_IN();
        pg8::Gemm g{(const bf16*)(ws + WS_X8), (const bf16*)(ws + WS_WGU), MOE_ROWS, 3072, DM / 2}; pg8::GroupedOrder S; S.initg(12, C.G, (int)blockIdx.x); S.reps = GREPS(9);
        pg8::EpiSwiGLU8 E{ws + WS_HB, EFF, 12};
        struct MoeRows { const int* idx; __device__ __forceinline__ int row(int r) const { return ((r >> 11) & 1) * SEQ + idx[r]; } } Gt{(const int*)(ws + WS_IDX)};
        pg8::gemm_phase_g8<pg8::EpiSwiGLU8, pg8::GroupedOrder, MoeRows, true, true>(ring, g, S, E, Gt);
        __syncthreads();
    }
    SEAM(9); TSEC_E(109);
    TSEC_B(110);
    if (IN(10)) REPS(10) { LAUNDER_IN();
        pg8::Gemm g{(const bf16*)(ws + WS_HB), (const bf16*)(ws + WS_WD), MOE_ROWS, DM, EFF / 2}; pg8::GroupedOrder S; S.initg(8, C.G, (int)blockIdx.x); S.reps = GREPS(10);
        pg8::EpiRowScale E{ws + WS_Y, DM, (const float*)(ws + WS_GATE), 8};
        pg8::gemm_phase_8<pg8::EpiRowScale, pg8::GroupedOrder, 122, 124, true, true>(ring, g, S, E);
        __syncthreads();
    }
    SEAM(10); TSEC_E(110);
    TSEC_B(111);
    if (IN(11)) REPS(11) { LAUNDER_IN(); p11_final(C, GIN(26), GIN(27), args.out, ws); }
    TSEC_E(111);
    if (PROBE_SEC) { const unsigned long long te = __builtin_amdgcn_s_memrealtime(); while (__builtin_amdgcn_s_memrealtime() - te < tacc_) __builtin_amdgcn_s_sleep(8); }
#undef IN
#undef SEAM
}

extern "C" void kernel_launch(void* const* d_in, const int* in_sizes, int n_in, void* d_out, int out_size, void* d_ws, size_t ws_size, hipStream_t stream) {
    static int grid = 0;
    if (grid == 0) {
        if (n_in != 28 || in_sizes[0] != MTOK * DM || out_size != MTOK * DM || ws_size < WS_END) { fprintf(stderr, "kernel_launch: unexpected shapes (n_in %d, in0 %d, out %d, ws %zu < %zu)\n", n_in, n_in > 0 ? in_sizes[0] : -1, out_size, ws_size, (size_t)WS_END); grid = -1; return; }
        int dev = 0, cus = 0, per_cu = 0;
        if (hipGetDevice(&dev) != hipSuccess || hipDeviceGetAttribute(&cus, hipDeviceAttributeMultiprocessorCount, dev) != hipSuccess) { grid = -1; return; }
        if (hipFuncSetAttribute((const void*)mega_fwd, hipFuncAttributeMaxDynamicSharedMemorySize, LDS_BYTES) != hipSuccess) { fprintf(stderr, "kernel_launch: hipFuncSetAttribute failed\n"); grid = -1; return; }
        if (hipOccupancyMaxActiveBlocksPerMultiprocessor(&per_cu, (const void*)mega_fwd, NWAVES * 64, LDS_BYTES) != hipSuccess || per_cu < 1) { fprintf(stderr, "kernel_launch: occupancy query says %d\n", per_cu); }
        (void)hipGetLastError();
        grid = cus;
    }
    if (grid < 0) return;
    if (hipMemsetAsync((char*)d_ws + WS_CTL, 0, CTL_ZERO_BYTES, stream) != hipSuccess) return;
    Args a{};
    for (int i = 0; i < 28; ++i) a.in[i] = (const float*)d_in[i];
    a.out = (float*)d_out; a.ws = (unsigned char*)d_ws;
    for (int li = 0; li < N_LAUNCHES; ++li) {
        a.ph_lo = (N_LAUNCHES == 1) ? 0 : li; a.ph_hi = (N_LAUNCHES == 1) ? N_PHASES : li + 1;
        hipLaunchKernelGGL(mega_fwd, dim3(grid), dim3(NWAVES * 64), LDS_BYTES, stream, a);
    }
}
```

```cpp
#include <hip/hip_runtime.h>
#include <cstdio>
#include <cstdint>
namespace pg8 {
#define PG8_LAS __attribute__((address_space(3)))
typedef unsigned short bf16_t;
typedef short bf16x8 __attribute__((ext_vector_type(8)));
typedef float f32x4 __attribute__((ext_vector_type(4)));
typedef unsigned u32x4 __attribute__((ext_vector_type(4)));
constexpr int BM = 256, BK = 64, HALF = 128, HTB = HALF * BK * 2  , STAGE_BYTES = 8 * HTB, NXCD = 8, WGM = 8;

__host__ __device__ __forceinline__ int lds_byte(int r, int c) { const int st = (r >> 4) * 2 + (c >> 5), rr = r & 15, cc = c & 31, ob = rr * 64 + cc * 2; return st * 1024 + (ob ^ (((ob >> 9) & 1) << 5)); }
__host__ __device__ __forceinline__ void stage_rc(int b, int& R, int& C) { const int st = b / 1024, sb = b % 1024, swz = sb ^ (((sb >> 9) & 1) << 5); R = (st >> 1) * 16 + swz / 64; C = (st & 1) * 32 + (swz % 64) / 2; }
__host__ __device__ __forceinline__ int perm32(int rho) { const int n = rho >> 4, i = rho & 15; return 8 * (i >> 2) + 4 * n + (i & 3); }

struct Unit { int pm, pn; };
struct Gemm { const bf16_t* A; const bf16_t* Bt; int M, N, K; };

struct StaticOrder {
    int nM, nN, nwg, G, c, reps;
    __host__ __device__ void init(int M, int N, int G_, int c_) { nM = M / BM; nN = N / BM; nwg = nM * nN; G = G_; c = c_; reps = 1; }
    __host__ __device__ bool next(int i, Unit& u) const {
        long L = (long)i * G + c; if (L >= (long)nwg * reps) return false; L %= nwg;
        int wgid = (int)L; { const int q = nwg / NXCD, r = nwg % NXCD, xcd = wgid % NXCD, off = wgid / NXCD; wgid = (xcd < r ? xcd * (q + 1) : r * (q + 1) + (xcd - r) * q) + off; }
        const int nig = WGM * nN, gid = wgid / nig, fm = gid * WGM, gsz = (nM - fm) < WGM ? (nM - fm) : WGM;
        u.pm = fm + ((wgid % nig) % gsz); u.pn = (wgid % nig) / gsz; return true;
    }
    __device__ __forceinline__ void a_ready(const Unit&) const {}
    __device__ __forceinline__ void done(const Unit&) const {}
};

__device__ __forceinline__ unsigned cvt_pk_bf16(float lo, float hi) { unsigned r; asm volatile("v_cvt_pk_bf16_f32 %0, %1, %2" : "=v"(r) : "v"(lo), "v"(hi)); return r; }
template <class Epi, class Sched, bool ALIGN_EPI = false, bool SP2 = false>
__device__ __forceinline__ void gemm_phase(PG8_LAS unsigned char* lds, const Gemm g, const Sched& S, const Epi& E) {
    const int tid = threadIdx.x, wid = __builtin_amdgcn_readfirstlane(tid >> 6), lane = tid & 63, wr = wid >> 2, wc = wid & 3, fr = lane & 15, fq = lane >> 4;
    const int K = g.K, nt = K / BK;
    unsigned voffA[2], voffB[2];
#pragma unroll
    for (int i = 0; i < 2; ++i) { int R, C; stage_rc(tid * 16 + i * 8192, R, C); const int Rb = Epi::PERM ? ((R & ~31) + perm32(R & 31)) : R;
        voffA[i] = (unsigned)(R * K + C) * 2u; voffB[i] = (unsigned)(Rb * K + C) * 2u; }
    const size_t kstep = (size_t)(BK * 2);
    const size_t hstep = (size_t)HALF * K * 2;
    const size_t tstep = 2 * hstep;
    const unsigned ldsw = (unsigned)wid * 1024u;
    const int aoff = lds_byte(wr * 64 + fr, fq * 8), boff = lds_byte(wc * 32 + fr, fq * 8);
#define PG8_SA(b, h) (((b) * 2 + (h)) * HTB)
#define PG8_SB(b, h) ((4 + (b) * 2 + (h)) * HTB)
#define PG8_STAGE(bufoff, gbase, voff) do { _Pragma("unroll") for (int _i = 0; _i < 2; ++_i) \
        __builtin_amdgcn_global_load_lds((const unsigned*)((const char*)(gbase) + (voff)[_i]), (PG8_LAS unsigned*)(lds + (bufoff) + ldsw + _i * 8192), 16, 0, 0); } while (0)
#define PG8_LDA(dst, b, h) do { _Pragma("unroll") for (int m = 0; m < 4; ++m) _Pragma("unroll") for (int k = 0; k < 2; ++k) dst[m][k] = *(const PG8_LAS bf16x8*)(lds + PG8_SA(b, h) + aoff + m * 2048 + k * 1024); } while (0)
#define PG8_LDB(dst, b, h) do { _Pragma("unroll") for (int n = 0; n < 2; ++n) _Pragma("unroll") for (int k = 0; k < 2; ++k) dst[n][k] = *(const PG8_LAS bf16x8*)(lds + PG8_SB(b, h) + boff + n * 2048 + k * 1024); } while (0)
#define PG8_MMA(ai, bj, At, Bt) do { __builtin_amdgcn_s_setprio(1); _Pragma("unroll") for (int m = 0; m < 4; ++m) _Pragma("unroll") for (int n = 0; n < 2; ++n) _Pragma("unroll") for (int k = 0; k < 2; ++k) \
        acc[ai][bj][m][n] = __builtin_amdgcn_mfma_f32_16x16x32_bf16(Bt[n][k], At[m][k], acc[ai][bj][m][n], 0, 0, 0); __builtin_amdgcn_s_setprio(0); } while (0)
#define PG8_WAIT_V(n) asm volatile("s_waitcnt vmcnt(" #n ")" ::: "memory")
#define PG8_WAIT_L(n) asm volatile("s_waitcnt lgkmcnt(" #n ")" ::: "memory")
#define PG8_BAR __builtin_amdgcn_s_barrier()
#define PG8_SCHED __builtin_amdgcn_sched_barrier(0)
    Unit cur, nxt; int ui = 0;
    if (!S.next(0, cur)) return;
    f32x4 acc[2][2][4][2];
#pragma unroll
    for (int a = 0; a < 2; ++a)
#pragma unroll
        for (int b = 0; b < 2; ++b)
#pragma unroll
            for (int m = 0; m < 4; ++m)
#pragma unroll
                for (int n = 0; n < 2; ++n) acc[a][b][m][n] = (f32x4){0.f, 0.f, 0.f, 0.f};
    bf16x8 At[4][2], B0[2][2], B1[2][2];
    const char* cA = (const char*)g.A + (size_t)cur.pm * tstep; const char* cB = (const char*)g.Bt + (size_t)cur.pn * tstep;
    S.a_ready(cur);
    if constexpr (SP2) {
        PG8_STAGE(PG8_SB(0, 0), cB, voffB); PG8_STAGE(PG8_SB(0, 1), cB + hstep, voffB); PG8_STAGE(PG8_SA(0, 0), cA, voffA); PG8_STAGE(PG8_SA(0, 1), cA + hstep, voffA);
        if (wr == 1) PG8_BAR;
        PG8_WAIT_V(2); PG8_BAR;
        PG8_STAGE(PG8_SB(1, 0), cB + kstep, voffB); PG8_STAGE(PG8_SA(1, 0), cA + kstep, voffA); PG8_STAGE(PG8_SB(1, 1), cB + hstep + kstep, voffB);
        PG8_WAIT_V(6); PG8_BAR;
    } else {
        PG8_STAGE(PG8_SB(0, 0), cB, voffB); PG8_STAGE(PG8_SA(0, 0), cA, voffA); PG8_STAGE(PG8_SB(0, 1), cB + hstep, voffB); PG8_STAGE(PG8_SA(0, 1), cA + hstep, voffA);
        if (wr == 1) PG8_BAR;
        PG8_WAIT_V(4); PG8_BAR;
        PG8_STAGE(PG8_SB(1, 0), cB + kstep, voffB); PG8_STAGE(PG8_SA(1, 0), cA + kstep, voffA); PG8_STAGE(PG8_SB(1, 1), cB + hstep + kstep, voffB);
        PG8_WAIT_V(6); PG8_BAR;
    }
    for (;;) {
        const bool has_next = S.next(ui + 1, nxt);
        const char* nA = has_next ? (const char*)g.A + (size_t)nxt.pm * tstep : cA; const char* nB = has_next ? (const char*)g.Bt + (size_t)nxt.pn * tstep : cB;
        for (int t = 0; t < nt; t += 2) {
            const bool last = (t == nt - 2);
            const char* a1 = cA + (size_t)(t + 1) * kstep;
            const char* a2 = last ? nA : cA + (size_t)(t + 2) * kstep; const char* b2 = last ? nB : cB + (size_t)(t + 2) * kstep;
            const char* a3 = a2 + kstep; const char* b3 = b2 + kstep;
            if (last && has_next) S.a_ready(nxt);
            if constexpr (SP2) {
            PG8_LDB(B0, 0, 0); PG8_LDB(B1, 0, 1); PG8_SCHED; PG8_LDA(At, 0, 0); PG8_STAGE(PG8_SA(1, 1), a1 + hstep, voffA);
            PG8_WAIT_V(8); PG8_WAIT_L(0); PG8_BAR; PG8_MMA(0, 0, At, B0); PG8_MMA(0, 1, At, B1); PG8_BAR; PG8_SCHED;
            PG8_LDA(At, 0, 1); PG8_STAGE(PG8_SB(0, 0), b2, voffB); PG8_STAGE(PG8_SB(0, 1), b2 + hstep, voffB); PG8_STAGE(PG8_SA(0, 0), a2, voffA);
            PG8_WAIT_V(8); PG8_WAIT_L(0); PG8_BAR; PG8_MMA(1, 0, At, B0); PG8_MMA(1, 1, At, B1); PG8_BAR; PG8_SCHED;
            PG8_LDB(B0, 1, 0); PG8_LDB(B1, 1, 1); PG8_SCHED; PG8_LDA(At, 1, 0); PG8_STAGE(PG8_SA(0, 1), a2 + hstep, voffA);
            PG8_WAIT_V(8); PG8_WAIT_L(0); PG8_BAR; PG8_MMA(0, 0, At, B0); PG8_MMA(0, 1, At, B1); PG8_BAR; PG8_SCHED;
            PG8_LDA(At, 1, 1); PG8_STAGE(PG8_SB(1, 0), b3, voffB); PG8_STAGE(PG8_SB(1, 1), b3 + hstep, voffB); PG8_STAGE(PG8_SA(1, 0), a3, voffA);
            PG8_WAIT_V(8); PG8_WAIT_L(0); PG8_BAR; PG8_MMA(1, 0, At, B0); PG8_MMA(1, 1, At, B1); PG8_BAR; PG8_SCHED;
            } else {
            PG8_LDB(B0, 0, 0); PG8_SCHED; PG8_LDA(At, 0, 0); PG8_STAGE(PG8_SA(1, 1), a1 + hstep, voffA);
            PG8_WAIT_L(8); PG8_BAR; PG8_WAIT_L(0); PG8_MMA(0, 0, At, B0); PG8_BAR; PG8_SCHED;
            PG8_LDB(B1, 0, 1); PG8_STAGE(PG8_SB(0, 0), b2, voffB);
            PG8_BAR; PG8_WAIT_L(0); PG8_MMA(0, 1, At, B1); PG8_BAR;
            PG8_LDA(At, 0, 1); PG8_STAGE(PG8_SA(0, 0), a2, voffA);
            PG8_BAR; PG8_WAIT_L(0); PG8_MMA(1, 0, At, B0); PG8_BAR; PG8_SCHED;
            PG8_STAGE(PG8_SB(0, 1), b2 + hstep, voffB);
            PG8_WAIT_V(6); PG8_BAR; PG8_MMA(1, 1, At, B1); PG8_BAR;
            PG8_LDB(B0, 1, 0); PG8_SCHED; PG8_LDA(At, 1, 0); PG8_STAGE(PG8_SA(0, 1), a2 + hstep, voffA);
            PG8_WAIT_L(8); PG8_BAR; PG8_WAIT_L(0); PG8_MMA(0, 0, At, B0); PG8_BAR; PG8_SCHED;
            PG8_LDB(B1, 1, 1); PG8_STAGE(PG8_SB(1, 0), b3, voffB);
            PG8_BAR; PG8_WAIT_L(0); PG8_MMA(0, 1, At, B1); PG8_BAR;
            PG8_LDA(At, 1, 1); PG8_STAGE(PG8_SA(1, 0), a3, voffA);
            PG8_BAR; PG8_WAIT_L(0); PG8_MMA(1, 0, At, B0); PG8_BAR; PG8_SCHED;
            PG8_STAGE(PG8_SB(1, 1), b3 + hstep, voffB);
            PG8_WAIT_V(6); PG8_BAR; PG8_MMA(1, 1, At, B1); PG8_BAR;
            }
        }
        if constexpr (ALIGN_EPI) { if (wr == 0) PG8_BAR; }
        if constexpr (!Epi::AFTER_DRAIN) { E(acc, cur, wr, wc, fr, fq); S.done(cur); }
        if (!has_next) break;
#pragma unroll
        for (int a = 0; a < 2; ++a)
#pragma unroll
            for (int b = 0; b < 2; ++b)
#pragma unroll
                for (int m = 0; m < 4; ++m)
#pragma unroll
                    for (int n = 0; n < 2; ++n) acc[a][b][m][n] = (f32x4){0.f, 0.f, 0.f, 0.f};
        cur = nxt; cA = nA; cB = nB; ++ui;
        if constexpr (ALIGN_EPI) { if (wr == 1) PG8_BAR; }
    }
    PG8_WAIT_V(0);
    if constexpr (!ALIGN_EPI) { if (wr == 0) PG8_BAR; }
    PG8_BAR;
    if constexpr (Epi::AFTER_DRAIN) { E.fused(acc, cur, wr, wc, fr, fq, lds, wid, lane); S.done(cur); }
#undef PG8_SA
#undef PG8_SB
#undef PG8_STAGE
#undef PG8_LDA
#undef PG8_LDB
#undef PG8_MMA
#undef PG8_WAIT_V
#undef PG8_WAIT_L
#undef PG8_BAR
#undef PG8_SCHED
}
}
namespace pg8 {
typedef int v4i_t __attribute__((ext_vector_type(4)));
typedef int v8i_t __attribute__((ext_vector_type(8)));
__device__ __forceinline__ v8i_t cat32(bf16x8 lo, bf16x8 hi) { const v4i_t a = __builtin_bit_cast(v4i_t, lo), b = __builtin_bit_cast(v4i_t, hi); return __builtin_shufflevector(a, b, 0, 1, 2, 3, 4, 5, 6, 7); }
template <class Epi, class Sched, class Gth, bool ALIGN_EPI = false, bool SP2 = true>
__device__ __forceinline__ void gemm_phase_g8(PG8_LAS unsigned char* lds, const Gemm g, const Sched& S, const Epi& E, const Gth& Gt) {
    static_assert(SP2, "gemm_phase_g8: SP2 loop only");
    const int tid = threadIdx.x, wid = __builtin_amdgcn_readfirstlane(tid >> 6), lane = tid & 63, wr = wid >> 2, wc = wid & 3, fr = lane & 15, fq = lane >> 4;
    const int K = g.K, nt = K / BK;
    unsigned voffA[2], voffB[2]; int Rr[2], Cc[2];
#pragma unroll
    for (int i = 0; i < 2; ++i) { int R, C; stage_rc(tid * 16 + i * 8192, R, C); const int Rb = Epi::PERM ? ((R & ~31) + perm32(R & 31)) : R;
        voffA[i] = (unsigned)(R * K + C) * 2u; voffB[i] = (unsigned)(Rb * K + C) * 2u; Rr[i] = R; Cc[i] = C; }
    (void)voffA;
    unsigned gC[2][2], gN[2][2];
#define PG8_GFILL(dst, pm_) do { _Pragma("unroll") for (int h_ = 0; h_ < 2; ++h_) _Pragma("unroll") for (int i_ = 0; i_ < 2; ++i_) dst[h_][i_] = (unsigned)Gt.row((pm_) * BM + h_ * HALF + Rr[i_]) * (unsigned)(K * 2) + (unsigned)(Cc[i_] * 2); } while (0)
    const size_t kstep = (size_t)(BK * 2);
    const size_t hstep = (size_t)HALF * K * 2;
    const size_t tstep = 2 * hstep;
    const unsigned ldsw = (unsigned)wid * 1024u;
    const int aoff = lds_byte(wr * 64 + fr, fq * 8), boff = lds_byte(wc * 32 + fr, fq * 8);
#define PG8_SA(b, h) (((b) * 2 + (h)) * HTB)
#define PG8_SB(b, h) ((4 + (b) * 2 + (h)) * HTB)
#define PG8_STAGE(bufoff, gbase, voff) do { _Pragma("unroll") for (int _i = 0; _i < 2; ++_i) \
        __builtin_amdgcn_global_load_lds((const unsigned*)((const char*)(gbase) + (voff)[_i]), (PG8_LAS unsigned*)(lds + (bufoff) + ldsw + _i * 8192), 16, 0, 0); } while (0)
#define PG8_LDA(dst, b, h) do { _Pragma("unroll") for (int m = 0; m < 4; ++m) dst[m] = cat32(*(const PG8_LAS bf16x8*)(lds + PG8_SA(b, h) + aoff + m * 2048), *(const PG8_LAS bf16x8*)(lds + PG8_SA(b, h) + aoff + m * 2048 + 1024)); } while (0)
#define PG8_LDB(dst, b, h) do { _Pragma("unroll") for (int n = 0; n < 2; ++n) dst[n] = cat32(*(const PG8_LAS bf16x8*)(lds + PG8_SB(b, h) + boff + n * 2048), *(const PG8_LAS bf16x8*)(lds + PG8_SB(b, h) + boff + n * 2048 + 1024)); } while (0)
#define PG8_MMA(ai, bj, At, Bt) do { __builtin_amdgcn_s_setprio(1); _Pragma("unroll") for (int m = 0; m < 4; ++m) _Pragma("unroll") for (int n = 0; n < 2; ++n) \
        asm volatile("v_mfma_scale_f32_16x16x128_f8f6f4 %0, %1, %2, %0, %3, %4 op_sel_hi:[0,0,0]" : "+v"(acc[ai][bj][m][n]) : "v"(Bt[n]), "v"(At[m]), "v"(scw), "v"(sca)); __builtin_amdgcn_s_setprio(0); } while (0)
#define PG8_WAIT_V(n) asm volatile("s_waitcnt vmcnt(" #n ")" ::: "memory")
#define PG8_WAIT_L(n) asm volatile("s_waitcnt lgkmcnt(" #n ")" ::: "memory")
#define PG8_BAR __builtin_amdgcn_s_barrier()
#define PG8_SCHED __builtin_amdgcn_sched_barrier(0)
    Unit cur, nxt; int ui = 0;
    if (!S.next(0, cur)) return;
    f32x4 acc[2][2][4][2];
#pragma unroll
    for (int a = 0; a < 2; ++a)
#pragma unroll
        for (int b = 0; b < 2; ++b)
#pragma unroll
            for (int m = 0; m < 4; ++m)
#pragma unroll
                for (int n = 0; n < 2; ++n) acc[a][b][m][n] = (f32x4){0.f, 0.f, 0.f, 0.f};
    v8i_t At[4], B0[2], B1[2]; const int scw = 0x7a7a7a7a, sca = 0x7f7f7f7f;
    const char* Ab = (const char*)g.A; const char* cB = (const char*)g.Bt + (size_t)cur.pn * tstep;
    PG8_GFILL(gC, cur.pm);
    S.a_ready(cur);
    if constexpr (SP2) {
        PG8_STAGE(PG8_SB(0, 0), cB, voffB); PG8_STAGE(PG8_SB(0, 1), cB + hstep, voffB); PG8_STAGE(PG8_SA(0, 0), Ab, gC[0]); PG8_STAGE(PG8_SA(0, 1), Ab, gC[1]);
        if (wr == 1) PG8_BAR;
        PG8_WAIT_V(2); PG8_BAR;
        PG8_STAGE(PG8_SB(1, 0), cB + kstep, voffB); PG8_STAGE(PG8_SA(1, 0), Ab + kstep, gC[0]); PG8_STAGE(PG8_SB(1, 1), cB + hstep + kstep, voffB);
        PG8_WAIT_V(6); PG8_BAR;
    }
    for (;;) {
        const bool has_next = S.next(ui + 1, nxt);
        const char* nB = has_next ? (const char*)g.Bt + (size_t)nxt.pn * tstep : cB;
        if (has_next) PG8_GFILL(gN, nxt.pm); else { gN[0][0] = gC[0][0]; gN[0][1] = gC[0][1]; gN[1][0] = gC[1][0]; gN[1][1] = gC[1][1]; }
        for (int t = 0; t < nt; t += 2) {
            const bool last = (t == nt - 2);
            const char* a1 = Ab + (size_t)(t + 1) * kstep;
            const char* a2 = last ? Ab : Ab + (size_t)(t + 2) * kstep; const char* b2 = last ? nB : cB + (size_t)(t + 2) * kstep;
            unsigned g2[2][2];
#pragma unroll
            for (int h_ = 0; h_ < 2; ++h_)
#pragma unroll
                for (int i_ = 0; i_ < 2; ++i_) g2[h_][i_] = last ? gN[h_][i_] : gC[h_][i_];
            const char* a3 = a2 + kstep; const char* b3 = b2 + kstep;
            if (last && has_next) S.a_ready(nxt);
            if constexpr (SP2) {
            PG8_LDB(B0, 0, 0); PG8_LDB(B1, 0, 1); PG8_SCHED; PG8_LDA(At, 0, 0); PG8_STAGE(PG8_SA(1, 1), a1, gC[1]);
            PG8_WAIT_V(8); PG8_WAIT_L(0); PG8_BAR; PG8_MMA(0, 0, At, B0); PG8_MMA(0, 1, At, B1); PG8_BAR; PG8_SCHED;
            PG8_LDA(At, 0, 1); PG8_STAGE(PG8_SB(0, 0), b2, voffB); PG8_STAGE(PG8_SB(0, 1), b2 + hstep, voffB); PG8_STAGE(PG8_SA(0, 0), a2, g2[0]);
            PG8_WAIT_V(8); PG8_WAIT_L(0); PG8_BAR; PG8_MMA(1, 0, At, B0); PG8_MMA(1, 1, At, B1); PG8_BAR; PG8_SCHED;
            PG8_LDB(B0, 1, 0); PG8_LDB(B1, 1, 1); PG8_SCHED; PG8_LDA(At, 1, 0); PG8_STAGE(PG8_SA(0, 1), a2, g2[1]);
            PG8_WAIT_V(8); PG8_WAIT_L(0); PG8_BAR; PG8_MMA(0, 0, At, B0); PG8_MMA(0, 1, At, B1); PG8_BAR; PG8_SCHED;
            PG8_LDA(At, 1, 1); PG8_STAGE(PG8_SB(1, 0), b3, voffB); PG8_STAGE(PG8_SB(1, 1), b3 + hstep, voffB); PG8_STAGE(PG8_SA(1, 0), a3, g2[0]);
            PG8_WAIT_V(8); PG8_WAIT_L(0); PG8_BAR; PG8_MMA(1, 0, At, B0); PG8_MMA(1, 1, At, B1); PG8_BAR; PG8_SCHED;
            }
        }
        asm volatile("s_nop 15\n\ts_nop 15\n\ts_nop 15" ::: "memory");
        if constexpr (ALIGN_EPI) { if (wr == 0) PG8_BAR; }
        if constexpr (!Epi::AFTER_DRAIN) { E(acc, cur, wr, wc, fr, fq); S.done(cur); }
        if (!has_next) break;
#pragma unroll
        for (int a = 0; a < 2; ++a)
#pragma unroll
            for (int b = 0; b < 2; ++b)
#pragma unroll
                for (int m = 0; m < 4; ++m)
#pragma unroll
                    for (int n = 0; n < 2; ++n) acc[a][b][m][n] = (f32x4){0.f, 0.f, 0.f, 0.f};
        cur = nxt; cB = nB; ++ui; gC[0][0] = gN[0][0]; gC[0][1] = gN[0][1]; gC[1][0] = gN[1][0]; gC[1][1] = gN[1][1];
        if constexpr (ALIGN_EPI) { if (wr == 1) PG8_BAR; }
    }
    PG8_WAIT_V(0);
    if constexpr (!ALIGN_EPI) { if (wr == 0) PG8_BAR; }
    PG8_BAR;
    if constexpr (Epi::AFTER_DRAIN) { E.fused(acc, cur, wr, wc, fr, fq, lds, wid, lane); S.done(cur); }
#undef PG8_SA
#undef PG8_SB
#undef PG8_STAGE
#undef PG8_LDA
#undef PG8_LDB
#undef PG8_MMA
#undef PG8_WAIT_V
#undef PG8_WAIT_L
#undef PG8_BAR
#undef PG8_SCHED
#undef PG8_GFILL
}


}
namespace pg8 {
template <class Epi, class Sched, int SCW, int SCA, bool ALIGN_EPI = false, bool SP2 = true>
__device__ __forceinline__ void gemm_phase_8(PG8_LAS unsigned char* lds, const Gemm g, const Sched& S, const Epi& E) {
    static_assert(SP2, "gemm_phase_8: SP2 loop only");
    const int tid = threadIdx.x, wid = __builtin_amdgcn_readfirstlane(tid >> 6), lane = tid & 63, wr = wid >> 2, wc = wid & 3, fr = lane & 15, fq = lane >> 4;
    const int K = g.K, nt = K / BK;
    unsigned voffA[2], voffB[2];
#pragma unroll
    for (int i = 0; i < 2; ++i) { int R, C; stage_rc(tid * 16 + i * 8192, R, C); const int Rb = Epi::PERM ? ((R & ~31) + perm32(R & 31)) : R;
        voffA[i] = (unsigned)(R * K + C) * 2u; voffB[i] = (unsigned)(Rb * K + C) * 2u; }
    const size_t kstep = (size_t)(BK * 2);
    const size_t hstep = (size_t)HALF * K * 2;
    const size_t tstep = 2 * hstep;
    const unsigned ldsw = (unsigned)wid * 1024u;
    const int aoff = lds_byte(wr * 64 + fr, fq * 8), boff = lds_byte(wc * 32 + fr, fq * 8);
#define PG8_SA(b, h) (((b) * 2 + (h)) * HTB)
#define PG8_SB(b, h) ((4 + (b) * 2 + (h)) * HTB)
#define PG8_STAGE(bufoff, gbase, voff) do { _Pragma("unroll") for (int _i = 0; _i < 2; ++_i) \
        __builtin_amdgcn_global_load_lds((const unsigned*)((const char*)(gbase) + (voff)[_i]), (PG8_LAS unsigned*)(lds + (bufoff) + ldsw + _i * 8192), 16, 0, 0); } while (0)
#define PG8_LDA(dst, b, h) do { _Pragma("unroll") for (int m = 0; m < 4; ++m) dst[m] = cat32(*(const PG8_LAS bf16x8*)(lds + PG8_SA(b, h) + aoff + m * 2048), *(const PG8_LAS bf16x8*)(lds + PG8_SA(b, h) + aoff + m * 2048 + 1024)); } while (0)
#define PG8_LDB(dst, b, h) do { _Pragma("unroll") for (int n = 0; n < 2; ++n) dst[n] = cat32(*(const PG8_LAS bf16x8*)(lds + PG8_SB(b, h) + boff + n * 2048), *(const PG8_LAS bf16x8*)(lds + PG8_SB(b, h) + boff + n * 2048 + 1024)); } while (0)
#define PG8_MMA(ai, bj, At, Bt) do { __builtin_amdgcn_s_setprio(1); _Pragma("unroll") for (int m = 0; m < 4; ++m) _Pragma("unroll") for (int n = 0; n < 2; ++n) \
        asm volatile("v_mfma_scale_f32_16x16x128_f8f6f4 %0, %1, %2, %0, %3, %4 op_sel_hi:[0,0,0]" : "+v"(acc[ai][bj][m][n]) : "v"(Bt[n]), "v"(At[m]), "v"(scw), "v"(sca)); __builtin_amdgcn_s_setprio(0); } while (0)
#define PG8_WAIT_V(n) asm volatile("s_waitcnt vmcnt(" #n ")" ::: "memory")
#define PG8_WAIT_L(n) asm volatile("s_waitcnt lgkmcnt(" #n ")" ::: "memory")
#define PG8_BAR __builtin_amdgcn_s_barrier()
#define PG8_SCHED __builtin_amdgcn_sched_barrier(0)
    Unit cur, nxt; int ui = 0;
    if (!S.next(0, cur)) return;
    f32x4 acc[2][2][4][2];
#pragma unroll
    for (int a = 0; a < 2; ++a)
#pragma unroll
        for (int b = 0; b < 2; ++b)
#pragma unroll
            for (int m = 0; m < 4; ++m)
#pragma unroll
                for (int n = 0; n < 2; ++n) acc[a][b][m][n] = (f32x4){0.f, 0.f, 0.f, 0.f};
    v8i_t At[4], B0[2], B1[2]; const int scw = SCW * 0x01010101, sca = SCA * 0x01010101;
    const char* cA = (const char*)g.A + (size_t)cur.pm * tstep; const char* cB = (const char*)g.Bt + (size_t)cur.pn * tstep;
    S.a_ready(cur);
    if constexpr (SP2) {
        PG8_STAGE(PG8_SB(0, 0), cB, voffB); PG8_STAGE(PG8_SB(0, 1), cB + hstep, voffB); PG8_STAGE(PG8_SA(0, 0), cA, voffA); PG8_STAGE(PG8_SA(0, 1), cA + hstep, voffA);
        if (wr == 1) PG8_BAR;
        PG8_WAIT_V(2); PG8_BAR;
        PG8_STAGE(PG8_SB(1, 0), cB + kstep, voffB); PG8_STAGE(PG8_SA(1, 0), cA + kstep, voffA); PG8_STAGE(PG8_SB(1, 1), cB + hstep + kstep, voffB);
        PG8_WAIT_V(6); PG8_BAR;
    }
    for (;;) {
        const bool has_next = S.next(ui + 1, nxt);
        const char* nA = has_next ? (const char*)g.A + (size_t)nxt.pm * tstep : cA; const char* nB = has_next ? (const char*)g.Bt + (size_t)nxt.pn * tstep : cB;
        for (int t = 0; t < nt; t += 2) {
            const bool last = (t == nt - 2);
            const char* a1 = cA + (size_t)(t + 1) * kstep;
            const char* a2 = last ? nA : cA + (size_t)(t + 2) * kstep; const char* b2 = last ? nB : cB + (size_t)(t + 2) * kstep;
            const char* a3 = a2 + kstep; const char* b3 = b2 + kstep;
            if (last && has_next) S.a_ready(nxt);
            if constexpr (SP2) {
            PG8_LDB(B0, 0, 0); PG8_LDB(B1, 0, 1); PG8_SCHED; PG8_LDA(At, 0, 0); PG8_STAGE(PG8_SA(1, 1), a1 + hstep, voffA);
            PG8_WAIT_V(8); PG8_WAIT_L(0); PG8_BAR; PG8_MMA(0, 0, At, B0); PG8_MMA(0, 1, At, B1); PG8_BAR; PG8_SCHED;
            PG8_LDA(At, 0, 1); PG8_STAGE(PG8_SB(0, 0), b2, voffB); PG8_STAGE(PG8_SB(0, 1), b2 + hstep, voffB); PG8_STAGE(PG8_SA(0, 0), a2, voffA);
            PG8_WAIT_V(8); PG8_WAIT_L(0); PG8_BAR; PG8_MMA(1, 0, At, B0); PG8_MMA(1, 1, At, B1); PG8_BAR; PG8_SCHED;
            PG8_LDB(B0, 1, 0); PG8_LDB(B1, 1, 1); PG8_SCHED; PG8_LDA(At, 1, 0); PG8_STAGE(PG8_SA(0, 1), a2 + hstep, voffA);
            PG8_WAIT_V(8); PG8_WAIT_L(0); PG8_BAR; PG8_MMA(0, 0, At, B0); PG8_MMA(0, 1, At, B1); PG8_BAR; PG8_SCHED;
            PG8_LDA(At, 1, 1); PG8_STAGE(PG8_SB(1, 0), b3, voffB); PG8_STAGE(PG8_SB(1, 1), b3 + hstep, voffB); PG8_STAGE(PG8_SA(1, 0), a3, voffA);
            PG8_WAIT_V(8); PG8_WAIT_L(0); PG8_BAR; PG8_MMA(1, 0, At, B0); PG8_MMA(1, 1, At, B1); PG8_BAR; PG8_SCHED;
            }
        }
        asm volatile("s_nop 15\n\ts_nop 15\n\ts_nop 15" ::: "memory");
        if constexpr (ALIGN_EPI) { if (wr == 0) PG8_BAR; }
        if constexpr (!Epi::AFTER_DRAIN) { E(acc, cur, wr, wc, fr, fq); S.done(cur); }
        if (!has_next) break;
#pragma unroll
        for (int a = 0; a < 2; ++a)
#pragma unroll
            for (int b = 0; b < 2; ++b)
#pragma unroll
                for (int m = 0; m < 4; ++m)
#pragma unroll
                    for (int n = 0; n < 2; ++n) acc[a][b][m][n] = (f32x4){0.f, 0.f, 0.f, 0.f};
        cur = nxt; cA = nA; cB = nB; ++ui;
        if constexpr (ALIGN_EPI) { if (wr == 1) PG8_BAR; }
    }
    PG8_WAIT_V(0);
    if constexpr (!ALIGN_EPI) { if (wr == 0) PG8_BAR; }
    PG8_BAR;
    if constexpr (Epi::AFTER_DRAIN) { E.fused(acc, cur, wr, wc, fr, fq, lds, wid, lane); S.done(cur); }
#undef PG8_SA
#undef PG8_SB
#undef PG8_STAGE
#undef PG8_LDA
#undef PG8_LDB
#undef PG8_MMA
#undef PG8_WAIT_V
#undef PG8_WAIT_L
#undef PG8_BAR
#undef PG8_SCHED
}


}
namespace pg8 {
__device__ __forceinline__ u32x4 pack8(f32x4 v0, f32x4 v1) { u32x4 w; w.x = cvt_pk_bf16(v0[0], v0[1]); w.y = cvt_pk_bf16(v0[2], v0[3]); w.z = cvt_pk_bf16(v1[0], v1[1]); w.w = cvt_pk_bf16(v1[2], v1[3]); return w; }
struct EpiColBias {
    static constexpr bool PERM = true, AFTER_DRAIN = false;
    bf16_t* O; int ldc; const float* bias;
    __device__ __forceinline__ void operator()(const f32x4 (&acc)[2][2][4][2], const Unit& u, int wr, int wc, int fr, int fq) const {
        const int row0 = u.pm * BM + wr * 64 + fr, col0 = u.pn * BM + wc * 32 + 8 * fq;
        f32x4 bv[2][2];
#pragma unroll
        for (int bj = 0; bj < 2; ++bj)
#pragma unroll
            for (int n = 0; n < 2; ++n) bv[bj][n] = *(const f32x4*)(bias + col0 + bj * HALF + 4 * n);
#pragma unroll
        for (int ai = 0; ai < 2; ++ai)
#pragma unroll
            for (int m = 0; m < 4; ++m) { bf16_t* rowp = O + (size_t)(row0 + ai * HALF + m * 16) * ldc + col0;
#pragma unroll
                for (int bj = 0; bj < 2; ++bj) *(u32x4*)(rowp + bj * HALF) = pack8(acc[ai][bj][m][0] + bv[bj][0], acc[ai][bj][m][1] + bv[bj][1]); }
    }
};
struct EpiRowBias {
    static constexpr bool PERM = true, AFTER_DRAIN = false;
    bf16_t* O; int ldc; const float* bias;
    __device__ __forceinline__ void operator()(const f32x4 (&acc)[2][2][4][2], const Unit& u, int wr, int wc, int fr, int fq) const {
        const int row0 = u.pm * BM + wr * 64 + fr, col0 = u.pn * BM + wc * 32 + 8 * fq;
#pragma unroll
        for (int ai = 0; ai < 2; ++ai)
#pragma unroll
            for (int m = 0; m < 4; ++m) { const int row = row0 + ai * HALF + m * 16; const float b = bias[row]; bf16_t* rowp = O + (size_t)row * ldc + col0;
#pragma unroll
                for (int bj = 0; bj < 2; ++bj) *(u32x4*)(rowp + bj * HALF) = pack8(acc[ai][bj][m][0] + b, acc[ai][bj][m][1] + b); }
    }
};
struct EpiFilt {
    static constexpr bool PERM = true, AFTER_DRAIN = false;
    bf16_t* O; int ldc; const float* decay;
    __device__ __forceinline__ void operator()(const f32x4 (&acc)[2][2][4][2], const Unit& u, int wr, int wc, int fr, int fq) const {
        const int row0 = u.pm * BM + wr * 64 + fr, col0 = u.pn * BM + wc * 32 + 8 * fq;
#pragma unroll
        for (int ai = 0; ai < 2; ++ai)
#pragma unroll
            for (int m = 0; m < 4; ++m) { const int row = row0 + ai * HALF + m * 16; const float dk = -fabsf(decay[row]) * (1.4426950408889634f / 16383.0f); bf16_t* rowp = O + (size_t)row * ldc + col0;
#pragma unroll
                for (int bj = 0; bj < 2; ++bj) { const float c0 = (float)(col0 + bj * HALF); f32x4 w0, w1;
#pragma unroll
                    for (int e = 0; e < 4; ++e) { w0[e] = __builtin_amdgcn_exp2f((c0 + (float)e) * dk); w1[e] = __builtin_amdgcn_exp2f((c0 + (float)(4 + e)) * dk); }
                    *(u32x4*)(rowp + bj * HALF) = pack8(acc[ai][bj][m][0] * w0, acc[ai][bj][m][1] * w1); } }
    }
};
struct EpiResid {
    static constexpr bool PERM = true, AFTER_DRAIN = false;
    bf16_t* O; int ldc; const bf16_t* x; float alpha;
    __device__ __forceinline__ void operator()(const f32x4 (&acc)[2][2][4][2], const Unit& u, int wr, int wc, int fr, int fq) const {
        const int row0 = u.pm * BM + wr * 64 + fr, col0 = u.pn * BM + wc * 32 + 8 * fq;
#pragma unroll
        for (int ai = 0; ai < 2; ++ai)
#pragma unroll
            for (int m = 0; m < 4; ++m) { const size_t off = (size_t)(row0 + ai * HALF + m * 16) * ldc + col0;
#pragma unroll
                for (int bj = 0; bj < 2; ++bj) { const u32x4 xv = *(const u32x4*)(x + off + bj * HALF);
                    const f32x4 x0 = {__builtin_bit_cast(float, xv.x << 16), __builtin_bit_cast(float, xv.x & 0xffff0000u), __builtin_bit_cast(float, xv.y << 16), __builtin_bit_cast(float, xv.y & 0xffff0000u)};
                    const f32x4 x1 = {__builtin_bit_cast(float, xv.z << 16), __builtin_bit_cast(float, xv.z & 0xffff0000u), __builtin_bit_cast(float, xv.w << 16), __builtin_bit_cast(float, xv.w & 0xffff0000u)};
                    *(u32x4*)(O + off + bj * HALF) = pack8(x0 * alpha + acc[ai][bj][m][0], x1 * alpha + acc[ai][bj][m][1]); } }
    }
};
__device__ __forceinline__ float silu_f(float v) { return v * __builtin_amdgcn_rcpf(1.0f + __builtin_amdgcn_exp2f(-1.4426950408889634f * v)); }
struct EpiSwiGLU {
    static constexpr bool PERM = true, AFTER_DRAIN = false;
    bf16_t* O; int ldc; int nNe;
    __device__ __forceinline__ void operator()(const f32x4 (&acc)[2][2][4][2], const Unit& u, int wr, int wc, int fr, int fq) const {
        const int row0 = u.pm * BM + wr * 64 + fr, pl = u.pn - (u.pm >> 4) * nNe, col0 = pl * HALF + wc * 32 + 8 * fq;
#pragma unroll
        for (int ai = 0; ai < 2; ++ai)
#pragma unroll
            for (int m = 0; m < 4; ++m) { f32x4 h0, h1;
#pragma unroll
                for (int e = 0; e < 4; ++e) { h0[e] = silu_f(acc[ai][0][m][0][e]) * acc[ai][1][m][0][e]; h1[e] = silu_f(acc[ai][0][m][1][e]) * acc[ai][1][m][1][e]; }
                *(u32x4*)(O + (size_t)(row0 + ai * HALF + m * 16) * ldc + col0) = pack8(h0, h1); }
    }
};
struct EpiSwiGLU8 {
    static constexpr bool PERM = true, AFTER_DRAIN = false;
    unsigned char* O; int ldc; int nNe;
    __device__ __forceinline__ void operator()(const f32x4 (&acc)[2][2][4][2], const Unit& u, int wr, int wc, int fr, int fq) const {
        typedef int v2i_ __attribute__((ext_vector_type(2)));
        const int row0 = u.pm * BM + wr * 64 + fr, pl = u.pn - (u.pm >> 4) * nNe, col0 = pl * HALF + wc * 32 + 8 * fq;
#pragma unroll
        for (int ai = 0; ai < 2; ++ai)
#pragma unroll
            for (int m = 0; m < 4; ++m) { float h[8];
#pragma unroll
                for (int e = 0; e < 4; ++e) { h[e] = 8.f * silu_f(acc[ai][0][m][0][e]) * acc[ai][1][m][0][e]; h[4 + e] = 8.f * silu_f(acc[ai][0][m][1][e]) * acc[ai][1][m][1][e]; }
                int w0 = 0, w1 = 0;
                w0 = __builtin_amdgcn_cvt_pk_fp8_f32(h[0], h[1], w0, false); w0 = __builtin_amdgcn_cvt_pk_fp8_f32(h[2], h[3], w0, true);
                w1 = __builtin_amdgcn_cvt_pk_fp8_f32(h[4], h[5], w1, false); w1 = __builtin_amdgcn_cvt_pk_fp8_f32(h[6], h[7], w1, true);
                *(v2i_*)(O + (size_t)(row0 + ai * HALF + m * 16) * ldc + col0) = (v2i_){w0, w1}; }
    }
};
struct EpiRowScale {
    static constexpr bool PERM = true, AFTER_DRAIN = false;
    unsigned char* O; int ldc; const float* gate; int nNe;
    __device__ __forceinline__ void operator()(const f32x4 (&acc)[2][2][4][2], const Unit& u, int wr, int wc, int fr, int fq) const {
        typedef int v2i_ __attribute__((ext_vector_type(2)));
        const int row0 = u.pm * BM + wr * 64 + fr, pl = u.pn - (u.pm >> 4) * nNe, col0 = pl * BM + wc * 32 + 8 * fq;
#pragma unroll
        for (int ai = 0; ai < 2; ++ai)
#pragma unroll
            for (int m = 0; m < 4; ++m) { const int row = row0 + ai * HALF + m * 16; const float g = 64.f * gate[row]; unsigned char* rowp = O + (size_t)row * ldc + col0;
#pragma unroll
                for (int bj = 0; bj < 2; ++bj) { const f32x4 v0 = acc[ai][bj][m][0] * g, v1 = acc[ai][bj][m][1] * g; int w0 = 0, w1 = 0;
                    w0 = __builtin_amdgcn_cvt_pk_fp8_f32(v0[0], v0[1], w0, false); w0 = __builtin_amdgcn_cvt_pk_fp8_f32(v0[2], v0[3], w0, true);
                    w1 = __builtin_amdgcn_cvt_pk_fp8_f32(v1[0], v1[1], w1, false); w1 = __builtin_amdgcn_cvt_pk_fp8_f32(v1[2], v1[3], w1, true);
                    *(v2i_*)(rowp + bj * HALF) = (v2i_){w0, w1}; } }
    }
};
struct GroupedOrder : StaticOrder {
    int nNe;
    __host__ __device__ void initg(int nNe_, int G_, int c_) { nNe = nNe_; init(65536, nNe_ * BM, G_, c_); }
    __host__ __device__ bool next(int i, Unit& u) const { if (!StaticOrder::next(i, u)) return false; u.pn += (u.pm >> 4) * nNe; return true; }
};
}
#ifndef PROBE_SEC
#define PROBE_SEC 0
#endif
#define ATSEC_B(id) do { if (PROBE_SEC == (id)) { t0_ = __builtin_amdgcn_s_memrealtime(); } } while (0)
#define ATSEC_E(id) do { if (PROBE_SEC == (id)) { tacc_ += __builtin_amdgcn_s_memrealtime() - t0_; } } while (0)
namespace att {
using bf16 = unsigned short;
constexpr int D = 128, NW = 8, QBLK = 32, KVBLK = 64; constexpr float SCALE = 0.088388347648318440f; constexpr float THR = 1.f; constexpr int SDEPTH = 2;
constexpr int LDQ = 1536, LDK = 128, LDO = 1024;
constexpr size_t SHM_V = KVBLK * D * 2, SHM_K = KVBLK * D * 2, SHM_ATTN = 8 * (KVBLK * D) + NW * 64 * 4;
using bf16x8 = __attribute__((ext_vector_type(8))) short;
using s16x4  = __attribute__((ext_vector_type(4))) short;
using f32x16 = __attribute__((ext_vector_type(16))) float;
using f32x8  = __attribute__((ext_vector_type(8))) float;
using u32x4  = __attribute__((ext_vector_type(4))) unsigned;
#define KSWZ(row, colB) ((row) * 256 + ((colB) ^ (((row) & 7) << 4)))
#define SBAR() __builtin_amdgcn_sched_barrier(0)
__device__ __forceinline__ int crow(int r, int hi) { return (r & 3) + 8 * (r >> 2) + 4 * hi; }
__device__ __forceinline__ unsigned cvtpk(float lo, float hi) {
  unsigned r; asm volatile("v_cvt_pk_bf16_f32 %0, %1, %2" : "=v"(r) : "v"(lo), "v"(hi)); return r;
}
__device__ __forceinline__ void partialSM(f32x16& p0, f32x16& p1, float& m_reg, float& mn, float& alpha) {
  constexpr float C = SCALE * 1.4426950408889634f;
  float pmax = p0[0]; for (int r = 1; r < 16; ++r) pmax = fmaxf(pmax, p0[r]); for (int r = 0; r < 16; ++r) pmax = fmaxf(pmax, p1[r]);
  { auto rr = __builtin_amdgcn_permlane32_swap(__float_as_uint(pmax), __float_as_uint(pmax), false, false);
    pmax = fmaxf(__uint_as_float(rr[0]), __uint_as_float(rr[1])); }
  if (__builtin_expect(__all(pmax - m_reg <= THR / SCALE), 1)) { mn = m_reg; alpha = 1.f; }
  else { mn = fmaxf(m_reg, pmax); alpha = __builtin_amdgcn_exp2f((m_reg - mn) * C); m_reg = mn; }
  float mnC = 7.0f - mn * C;
  for (int r = 0; r < 16; ++r) p0[r] = fmaf(p0[r], C, mnC); for (int r = 0; r < 16; ++r) p1[r] = fmaf(p1[r], C, mnC);
  for (int r = 0; r < 16; ++r) p0[r] = __builtin_amdgcn_exp2f(p0[r]);
}
__device__ __forceinline__ void finishSM(f32x16& p0, f32x16& p1, float alpha, float& l_reg, bf16x8& pa0, bf16x8& pa1, bf16x8& pa2, bf16x8& pa3) {
  for (int r = 0; r < 16; ++r) p1[r] = __builtin_amdgcn_exp2f(p1[r]);
  float ps = 0; for (int r = 0; r < 16; ++r) ps += p0[r]; for (int r = 0; r < 16; ++r) ps += p1[r];
  { auto rr = __builtin_amdgcn_permlane32_swap(__float_as_uint(ps), __float_as_uint(ps), false, false);
    ps = __uint_as_float(rr[0]) + __uint_as_float(rr[1]); }
  l_reg = l_reg * alpha + ps;
#define PK4(P, BASE, OUT) do { unsigned a0 = cvtpk(P[BASE + 0], P[BASE + 1]), a1 = cvtpk(P[BASE + 2], P[BASE + 3]);   \
    unsigned b0 = cvtpk(P[BASE + 4], P[BASE + 5]), b1 = cvtpk(P[BASE + 6], P[BASE + 7]);                              \
    auto r0 = __builtin_amdgcn_permlane32_swap(a0, b0, false, false); auto r1 = __builtin_amdgcn_permlane32_swap(a1, b1, false, false); \
    u32x4 w = {r0[0], r1[0], r0[1], r1[1]}; OUT = *reinterpret_cast<bf16x8*>(&w); } while (0)
  PK4(p0, 0, pa0); PK4(p0, 8, pa1); PK4(p1, 0, pa2); PK4(p1, 8, pa3);
#undef PK4
}
__device__ __forceinline__ void qkt(f32x16& p0, f32x16& p1, const bf16* Ks, const bf16x8* qr, int r32, int hi) {
  p0 = f32x16{}; p1 = f32x16{};
  __builtin_amdgcn_s_setprio(1);
  for (int d0 = 0; d0 < 8; ++d0) { int cb = (d0 * 16 + hi * 8) * 2;
    bf16x8 b0 = *reinterpret_cast<const bf16x8*>((const char*)Ks + KSWZ(r32, cb));
    bf16x8 b1 = *reinterpret_cast<const bf16x8*>((const char*)Ks + KSWZ(32 + r32, cb));
    p0 = __builtin_amdgcn_mfma_f32_32x32x16_bf16(b0, qr[d0], p0, 0, 0, 0);
    p1 = __builtin_amdgcn_mfma_f32_32x32x16_bf16(b1, qr[d0], p1, 0, 0, 0); }
  __builtin_amdgcn_s_setprio(0);
}
using v8i = __attribute__((ext_vector_type(8))) int;
using v4i = __attribute__((ext_vector_type(4))) int;
constexpr size_t SHM_K8 = KVBLK * D;
__device__ __forceinline__ int k8img(int r, int c) { return r * 128 + ((c ^ ((r >> 1) & 7)) << 4); }
__device__ __forceinline__ v8i ld32(const char* p0, const char* p1) { const v4i a = *reinterpret_cast<const v4i*>(p0), b = *reinterpret_cast<const v4i*>(p1); return __builtin_shufflevector(a, b, 0, 1, 2, 3, 4, 5, 6, 7); }
__device__ __forceinline__ void qkt8(f32x16& p0, f32x16& p1, const char* Ks, const v8i* q8, int r32, int hi, float init) {
#pragma unroll
  for (int r = 0; r < 16; ++r) { p0[r] = init; p1[r] = init; }
  __builtin_amdgcn_s_setprio(1);
#pragma unroll
  for (int s = 0; s < 2; ++s) { const int c = 4 * s + 2 * hi;
    const v8i a0 = ld32(Ks + k8img(r32, c), Ks + k8img(r32, c + 1)), a1 = ld32(Ks + k8img(32 + r32, c), Ks + k8img(32 + r32, c + 1));
    p0 = __builtin_amdgcn_mfma_scale_f32_32x32x64_f8f6f4(a0, q8[s], p0, 0, 0, 0, 0x7f7f7f7f, 0, 0x7c7c7c7c);
    p1 = __builtin_amdgcn_mfma_scale_f32_32x32x64_f8f6f4(a1, q8[s], p1, 0, 0, 0, 0x7f7f7f7f, 0, 0x7c7c7c7c); }
  __builtin_amdgcn_s_setprio(0);
}
template <bool FIRST> __device__ __forceinline__ void partialSM8(f32x16& p0, f32x16& p1, float& m2, float& alpha) {
  constexpr float THR2 = THR * 1.4426950408889634f;
  float pmax = p0[0]; for (int r = 1; r < 16; ++r) pmax = fmaxf(pmax, p0[r]); for (int r = 0; r < 16; ++r) pmax = fmaxf(pmax, p1[r]);
  { auto rr = __builtin_amdgcn_permlane32_swap(__float_as_uint(pmax), __float_as_uint(pmax), false, false);
    pmax = fmaxf(__uint_as_float(rr[0]), __uint_as_float(rr[1])); }
  if (!FIRST && __builtin_expect(__all(pmax <= 7.0f + THR2), 1)) { alpha = 1.f; }
  else { const float d = FIRST ? pmax - 7.0f : fmaxf(pmax - 7.0f, 0.f); alpha = FIRST ? 0.f : __builtin_amdgcn_exp2f(-d); m2 += d;
    for (int r = 0; r < 16; ++r) p0[r] -= d; for (int r = 0; r < 16; ++r) p1[r] -= d; }
  for (int r = 0; r < 16; ++r) p0[r] = __builtin_amdgcn_exp2f(p0[r]);
}
__device__ __forceinline__ int v8img(int c, int q) { return c * 64 + ((q ^ ((c >> 2) & 3)) << 4); }
__device__ __forceinline__ void finishSM8(f32x16& p0, f32x16& p1, v8i& pa) {
  for (int r = 0; r < 16; ++r) p1[r] = __builtin_amdgcn_exp2f(p1[r]);
  int w[8];
#pragma unroll
  for (int i = 0; i < 4; ++i) { int a = 0, b = 0;
    a = __builtin_amdgcn_cvt_pk_fp8_f32(p0[4 * i], p0[4 * i + 1], a, false); a = __builtin_amdgcn_cvt_pk_fp8_f32(p0[4 * i + 2], p0[4 * i + 3], a, true);
    b = __builtin_amdgcn_cvt_pk_fp8_f32(p1[4 * i], p1[4 * i + 1], b, false); b = __builtin_amdgcn_cvt_pk_fp8_f32(p1[4 * i + 2], p1[4 * i + 3], b, true);
    w[i] = a; w[4 + i] = b; }
  pa = (v8i){w[0], w[1], w[2], w[3], w[4], w[5], w[6], w[7]};
}
using f32x4_ = __attribute__((ext_vector_type(4))) float;
__device__ __forceinline__ void pv8(f32x16* o, f32x4_& l4, const char* Vs, const v8i& pa, const v8i& bsel, int r32, int hi) {
  l4 = __builtin_amdgcn_mfma_scale_f32_16x16x128_f8f6f4(pa, bsel, l4, 0, 0, 0, 0x7f7f7f7f, 0, 0x7f7f7f7f);
#pragma unroll
  for (int d0 = 0; d0 < 4; ++d0) { const int c = 32 * d0 + r32;
    const v8i b = ld32(Vs + v8img(c, 2 * hi), Vs + v8img(c, 2 * hi + 1));
    o[d0] = __builtin_amdgcn_mfma_scale_f32_32x32x64_f8f6f4(pa, b, o[d0], 0, 0, 0, 0x7f7f7f7f, 0, 0x7d7d7d7d); }
}
#define ATT_SB() __builtin_amdgcn_sched_barrier(0)
#define ATT_CVT4(P, I) ({ int a_; asm volatile("" : "=v"(a_)); a_ = __builtin_amdgcn_cvt_pk_fp8_f32(P[4 * (I)], P[4 * (I) + 1], a_, false); a_ = __builtin_amdgcn_cvt_pk_fp8_f32(P[4 * (I) + 2], P[4 * (I) + 3], a_, true); a_; })
#define ATT_EXP4(P, I) do { P[4 * (I)] = __builtin_amdgcn_exp2f(P[4 * (I)]); P[4 * (I) + 1] = __builtin_amdgcn_exp2f(P[4 * (I) + 1]); P[4 * (I) + 2] = __builtin_amdgcn_exp2f(P[4 * (I) + 2]); P[4 * (I) + 3] = __builtin_amdgcn_exp2f(P[4 * (I) + 3]); } while (0)
__device__ __forceinline__ float att_max3(float a, float b, float c) { float r; asm("v_max3_f32 %0, %1, %2, %3" : "=v"(r) : "v"(a), "v"(b), "v"(c)); return r; }
#define ATT_MAX16(P, MA, MB) asm("v_max3_f32 %0, %2, %3, %4\n\tv_max3_f32 %1, %11, %12, %13\n\tv_max3_f32 %0, %0, %5, %6\n\tv_max3_f32 %1, %1, %14, %15\n\tv_max3_f32 %0, %0, %7, %8\n\tv_max3_f32 %1, %1, %16, %17\n\tv_max3_f32 %0, %0, %9, %10" : "=&v"(MA), "=&v"(MB) : "v"(P[0]), "v"(P[1]), "v"(P[2]), "v"(P[3]), "v"(P[4]), "v"(P[5]), "v"(P[6]), "v"(P[7]), "v"(P[8]), "v"(P[9]), "v"(P[10]), "v"(P[11]), "v"(P[12]), "v"(P[13]), "v"(P[14]), "v"(P[15]))
#define ATT_MF "v_mfma_scale_f32_32x32x64_f8f6f4 %[acc], %[a], %[b], %[acc], %[sa], %[sb] op_sel_hi:[0,0,0]"
template <bool PREF, bool DK, bool DV>
__device__ __forceinline__ bool att_step(f32x16& c0, f32x16& c1, f32x16& q0, f32x16& q1, float& m2, float& alpha, f32x16& ci, f32x16* o, f32x4_& l4, v8i& ka0, v8i& ka1,
                                         const char* Ks, const char* Vs, const char* Kn, const v8i* q8, const v8i& bsel, const int (&kofs)[4], const int (&vofs)[2],
                                         const unsigned char* kg, const unsigned char* vg, unsigned kd, unsigned vd, unsigned koff, unsigned voff) {
  constexpr float THR2 = THR * 1.4426950408889634f;
  const int s1 = 0x7f7f7f7f, sq = 0x7c7c7c7c, sv = 0x7d7d7d7d;
  const v8i a0 = ka0, a1 = ka1;
  asm volatile("v_mfma_scale_f32_32x32x64_f8f6f4 %[d], %[a], %[b], %[c], %[sa], %[sb] op_sel_hi:[0,0,0]"
               : [d] "=&v"(c0), "+v"(q0), "+v"(q1) : [a] "v"(a0), [b] "v"(q8[0]), [c] "v"(ci), [sa] "v"(s1), [sb] "v"(sq) : "memory"); ATT_SB();
  if constexpr (DK) asm volatile("s_mov_b32 m0, %2\n\ts_nop 0\n\tglobal_load_lds_dwordx4 %0, %1" :: "v"(koff), "s"(kg), "s"(kd) : "memory");
  if constexpr (DV) asm volatile("s_mov_b32 m0, %2\n\ts_nop 0\n\tglobal_load_lds_dwordx4 %0, %1" :: "v"(voff), "s"(vg), "s"(vd) : "memory");
  const v8i b0 = ld32(Ks + kofs[2], Ks + kofs[3]), b1 = ld32(Ks + kofs[2] + 4096, Ks + kofs[3] + 4096);
  ATT_EXP4(q1, 0); int w0 = ATT_CVT4(q0, 0);
  asm volatile("v_mfma_scale_f32_32x32x64_f8f6f4 %[d], %[a], %[b], %[c], %[sa], %[sb] op_sel_hi:[0,0,0]"
               : [d] "=&v"(c1), "+v"(q0), "+v"(q1), "+v"(w0) : [a] "v"(a1), [b] "v"(q8[0]), [c] "v"(ci), [sa] "v"(s1), [sb] "v"(sq) : "memory"); ATT_SB();
  ATT_EXP4(q1, 1); int w1 = ATT_CVT4(q0, 1), w2 = ATT_CVT4(q0, 2);
  asm volatile(ATT_MF : [acc] "+v"(c0), "+v"(q0), "+v"(q1), "+v"(w1), "+v"(w2) : [a] "v"(b0), [b] "v"(q8[1]), [sa] "v"(s1), [sb] "v"(sq) : "memory"); ATT_SB();
  const v8i v0 = ld32(Vs + vofs[0], Vs + vofs[1]), v1 = ld32(Vs + vofs[0] + 2048, Vs + vofs[1] + 2048);
  ATT_EXP4(q1, 2); int w3 = ATT_CVT4(q0, 3), w4 = ATT_CVT4(q1, 0);
  asm volatile(ATT_MF : [acc] "+v"(c1), "+v"(q1), "+v"(w3), "+v"(w4) : [a] "v"(b1), [b] "v"(q8[1]), [sa] "v"(s1), [sb] "v"(sq) : "memory"); ATT_SB();
  ATT_EXP4(q1, 3); const int w5 = ATT_CVT4(q1, 1), w6 = ATT_CVT4(q1, 2), w7 = ATT_CVT4(q1, 3);
  v8i pa = (v8i){w0, w1, w2, w3, w4, w5, w6, w7};
  asm volatile("s_nop 1\n\tv_mfma_scale_f32_16x16x128_f8f6f4 %[acc], %[a], %[b], %[acc], %[sa], %[sb] op_sel_hi:[0,0,0]"
               : [acc] "+v"(l4), "+v"(c0) : [a] "v"(pa), [b] "v"(bsel), [sa] "v"(s1), [sb] "v"(s1) : "memory"); ATT_SB();
  const v8i v2 = ld32(Vs + vofs[0] + 4096, Vs + vofs[1] + 4096);
  float pm0, pm0b; ATT_MAX16(c0, pm0, pm0b);
  asm volatile(ATT_MF : [acc] "+v"(o[0]), "+v"(pm0), "+v"(pm0b), "+v"(c1) : [a] "v"(pa), [b] "v"(v0), [sa] "v"(s1), [sb] "v"(sv) : "memory"); ATT_SB();
  const v8i v3 = ld32(Vs + vofs[0] + 6144, Vs + vofs[1] + 6144);
  float pm1, pm1b; ATT_MAX16(c1, pm1, pm1b);
  asm volatile(ATT_MF : [acc] "+v"(o[1]), "+v"(pm1), "+v"(pm1b) : [a] "v"(pa), [b] "v"(v1), [sa] "v"(s1), [sb] "v"(sv) : "memory"); ATT_SB();
  float pmax, pmx2;
  asm("v_max3_f32 %0, %2, %3, %4\n\tv_max3_f32 %0, %0, %5, %5\n\tv_mov_b32 %1, %0\n\ts_nop 1\n\tv_permlane32_swap_b32 %0, %1\n\tv_max3_f32 %0, %0, %1, %1"
      : "=&v"(pmax), "=&v"(pmx2) : "v"(pm0), "v"(pm0b), "v"(pm1), "v"(pm1b));
  const bool need = !__all(pmax <= 7.0f + THR2);
  if (__builtin_expect(need, 0)) { const float d = fmaxf(pmax - 7.0f, 0.f); alpha = __builtin_amdgcn_exp2f(-d); m2 += d; const float init = 7.0f - m2;
#pragma unroll
    for (int r = 0; r < 16; ++r) { c0[r] -= d; c1[r] -= d; ci[r] = init; } }
  asm volatile(ATT_MF : [acc] "+v"(o[2]), "+v"(c0) : [a] "v"(pa), [b] "v"(v2), [sa] "v"(s1), [sb] "v"(sv) : "memory"); ATT_SB();
  if constexpr (PREF) { ka0 = ld32(Kn + kofs[0], Kn + kofs[1]); ka1 = ld32(Kn + kofs[0] + 4096, Kn + kofs[1] + 4096); }
  ATT_EXP4(c0, 0); ATT_EXP4(c0, 1);
  asm volatile(ATT_MF : [acc] "+v"(o[3]), "+v"(c0) : [a] "v"(pa), [b] "v"(v3), [sa] "v"(s1), [sb] "v"(sv) : "memory"); ATT_SB();
  ATT_EXP4(c0, 2); ATT_EXP4(c0, 3);
  asm volatile("" : "+v"(c0)); ATT_SB();
  return need;
}
__device__ __forceinline__ int v_st(int k, int c) { const int kk = (k & ~0xC) | ((k & 4) << 1) | ((k & 8) >> 1); return ((kk >> 3) * 4 + (c >> 5)) * 512 + ((kk & 7) * 32 + (c & 31)) * 2; }
__device__ __forceinline__ int v_rd_base(int lane) { return ((lane & 3) << 3) | (((lane >> 2) & 3) << 6) | (((lane >> 4) & 1) << 5) | (((lane >> 5) & 1) << 8); }
constexpr int v_rd_off(int d0, int ks, int half) { return d0 * 512 + ks * 4096 + half * 2048; }
template <int OFF> __device__ __forceinline__ s16x4 tr_read(int vb) {
  s16x4 r; asm volatile("ds_read_b64_tr_b16 %0, %1 offset:%2" : "=&v"(r) : "v"(vb), "i"(OFF) : "memory"); return r;
}
template <int D0> __device__ __forceinline__ void pv_one(f32x16& od, int vb, bf16x8 pa0, bf16x8 pa1, bf16x8 pa2, bf16x8 pa3) {
  const s16x4 l0 = tr_read<v_rd_off(D0, 0, 0)>(vb), h0 = tr_read<v_rd_off(D0, 0, 1)>(vb), l1 = tr_read<v_rd_off(D0, 1, 0)>(vb), h1 = tr_read<v_rd_off(D0, 1, 1)>(vb);
  const s16x4 l2 = tr_read<v_rd_off(D0, 2, 0)>(vb), h2 = tr_read<v_rd_off(D0, 2, 1)>(vb), l3 = tr_read<v_rd_off(D0, 3, 0)>(vb), h3 = tr_read<v_rd_off(D0, 3, 1)>(vb);
  asm volatile("s_waitcnt lgkmcnt(0)" ::: "memory"); SBAR();
#define PK(L, H) (bf16x8){L[0], L[1], L[2], L[3], H[0], H[1], H[2], H[3]}
  od = __builtin_amdgcn_mfma_f32_32x32x16_bf16(pa0, PK(l0, h0), od, 0, 0, 0);
  od = __builtin_amdgcn_mfma_f32_32x32x16_bf16(pa1, PK(l1, h1), od, 0, 0, 0);
  od = __builtin_amdgcn_mfma_f32_32x32x16_bf16(pa2, PK(l2, h2), od, 0, 0, 0);
  od = __builtin_amdgcn_mfma_f32_32x32x16_bf16(pa3, PK(l3, h3), od, 0, 0, 0);
#undef PK
}
__device__ __forceinline__ void pv_d0(f32x16* o, int vb, bf16x8 pa0, bf16x8 pa1, bf16x8 pa2, bf16x8 pa3) {
  pv_one<0>(o[0], vb, pa0, pa1, pa2, pa3); pv_one<1>(o[1], vb, pa0, pa1, pa2, pa3); pv_one<2>(o[2], vb, pa0, pa1, pa2, pa3); pv_one<3>(o[3], vb, pa0, pa1, pa2, pa3);
}
__device__ __forceinline__ void attn_unit(const bf16* __restrict__ Qb, int l0, const float* __restrict__ qn, const unsigned char* __restrict__ Kh, const unsigned char* __restrict__ Vh,
                                          bf16* __restrict__ Ob, int seq, char* lds) {
  int tid_ = threadIdx.x; asm volatile("" : "+v"(tid_));
  const int tid = tid_, wid = tid >> 6, lane = tid & 63, r32 = lane & 31, hi = lane >> 5;
  char* V_lds = lds; char* K_lds = lds + 4 * SHM_K8;
  float* ws = (float*)(lds + 8 * SHM_K8) + wid * 64; float* li_l = ws; float* al_l = ws + 32;
  float m_reg = 0.f; f32x4_ l4 = {0.f, 0.f, 0.f, 0.f}; f32x16 o[4] = {}; v8i q8[2];
  const int wu = __builtin_amdgcn_readfirstlane(wid);
  unsigned koff; const unsigned voff = (unsigned)(wu * 1024 + 16 * lane);
  { const int row = 8 * wu + (lane >> 3), pos = lane & 7; koff = (unsigned)(row * 128 + ((pos ^ ((row >> 1) & 7)) << 4)); }
  const unsigned kdst = (unsigned)(size_t)K_lds + (unsigned)(wu * 1024), vdst = (unsigned)(size_t)V_lds + (unsigned)(wu * 1024);
#define DMA_K(slot, key0) asm volatile("s_mov_b32 m0, %2\n\ts_nop 0\n\tglobal_load_lds_dwordx4 %0, %1" :: "v"(koff), "s"(Kh + (size_t)(key0) * 128), "s"(kdst + (unsigned)((slot) * SHM_K8)) : "memory")
#define DMA_V(slot, key0) asm volatile("s_mov_b32 m0, %2\n\ts_nop 0\n\tglobal_load_lds_dwordx4 %0, %1" :: "v"(voff), "s"(Vh + (size_t)(key0) * 128), "s"(vdst + (unsigned)((slot) * SHM_K8)) : "memory")
  DMA_K(0, 0); DMA_K(1, KVBLK); DMA_V(0, 0); DMA_K(2, 2 * KVBLK); DMA_V(1, KVBLK); DMA_K(3, 3 * KVBLK); DMA_V(2, 2 * KVBLK);
  {
    const bf16* Qw = Qb + (long)(wid * QBLK + r32) * LDQ + hi * 32;
    const int lpos = l0 + wid * QBLK + r32; const float prow = (float)(lpos >> 6), pcol = (float)(lpos & 63);
    bf16x8 qraw[2][4]; float ss = 0.f;
#pragma unroll
    for (int s_ = 0; s_ < 2; ++s_)
#pragma unroll
      for (int c = 0; c < 4; ++c) { qraw[s_][c] = *reinterpret_cast<const bf16x8*>(Qw + 64 * s_ + 8 * c);
#pragma unroll
        for (int e = 0; e < 8; ++e) { const float v = __uint_as_float(((unsigned)(unsigned short)qraw[s_][c][e]) << 16); ss += v * v; } }
    ss += __shfl_xor(ss, 32);
    const float rs = 1.0201391f / sqrtf(ss * (1.0f / 128.0f) + 1e-6f);
#pragma unroll
    for (int s_ = 0; s_ < 2; ++s_) { int w[8];
#pragma unroll
      for (int c = 0; c < 4; ++c) { const int d = 64 * s_ + 32 * hi + 8 * c;
        const float4 g0 = *reinterpret_cast<const float4*>(qn + d), g1 = *reinterpret_cast<const float4*>(qn + d + 4);
        const float gg[8] = {g0.x, g0.y, g0.z, g0.w, g1.x, g1.y, g1.z, g1.w}; float r8[8];
#pragma unroll
        for (int e2 = 0; e2 < 4; ++e2) {
          const float x0 = __uint_as_float(((unsigned)(unsigned short)qraw[s_][c][2 * e2]) << 16) * rs * gg[2 * e2], x1 = __uint_as_float(((unsigned)(unsigned short)qraw[s_][c][2 * e2 + 1]) << 16) * rs * gg[2 * e2 + 1];
          const int i = 32 * s_ + 16 * hi + 4 * c + e2, j = i & 31;
          const float inv = __builtin_amdgcn_exp2f(-(float)j * (13.287712379549449f / 32.0f));
          const float rev = (s_ == 0 ? prow : pcol) * inv * 0.15915494309189535f;
          const float cc = __builtin_amdgcn_cosf(rev), sn_ = __builtin_amdgcn_sinf(rev);
          r8[2 * e2] = x0 * cc - x1 * sn_; r8[2 * e2 + 1] = x0 * sn_ + x1 * cc; }
        int w0 = 0, w1 = 0;
        w0 = __builtin_amdgcn_cvt_pk_fp8_f32(r8[0], r8[1], w0, false); w0 = __builtin_amdgcn_cvt_pk_fp8_f32(r8[2], r8[3], w0, true);
        w1 = __builtin_amdgcn_cvt_pk_fp8_f32(r8[4], r8[5], w1, false); w1 = __builtin_amdgcn_cvt_pk_fp8_f32(r8[6], r8[7], w1, true);
        w[2 * c] = w0; w[2 * c + 1] = w1; }
      q8[s_] = (v8i){w[0], w[1], w[2], w[3], w[4], w[5], w[6], w[7]}; }
  }
  const int lrow = (16 * (lane & 15) + 4 * (lane >> 4)) & 31;
  v8i bsel; { const int c_ = ((lane & 15) < 2 && ((lane >> 4) & 1) == (lane & 15)) ? 0x38383838 : 0; bsel = (v8i){c_, c_, c_, c_, c_, c_, c_, c_}; asm volatile("" : "+v"(bsel)); }
#define DMA_BAR(n) asm volatile("s_waitcnt vmcnt(" #n ") lgkmcnt(0)\n\ts_barrier" ::: "memory")
#define RESC(a) do { if (__any((a) < 1.f)) { if (hi == 0) al_l[r32] = (a); asm volatile("s_nop 15\n\ts_nop 15\n\ts_nop 15\n\ts_waitcnt lgkmcnt(0)" ::: "memory"); \
    for (int d = 0; d < 4; ++d) for (int r = 0; r < 16; ++r) o[d][r] *= al_l[crow(r, hi)]; l4 *= *reinterpret_cast<const f32x4_*>(al_l + lrow); } } while (0)
#define KSLOT(s) (K_lds + (s) * SHM_K8)
#define VSLOT(s) (V_lds + (s) * SHM_K8)
  f32x16 pA0, pA1, pB0, pB1; float mnA, mnB, alA, alB; v8i pa; const int NT = seq / KVBLK;
  DMA_BAR(4);
  qkt8(pA0, pA1, KSLOT(0), q8, r32, hi, 7.0f); partialSM8<true>(pA0, pA1, m_reg, alA);
  f32x16 ci; const int kofs[4] = {k8img(r32, 2 * hi), k8img(r32, 2 * hi + 1), k8img(r32, 4 + 2 * hi), k8img(r32, 5 + 2 * hi)}, vofs[2] = {v8img(r32, 2 * hi), v8img(r32, 2 * hi + 1)};
  v8i ka0 = ld32(KSLOT(1) + kofs[0], KSLOT(1) + kofs[1]), ka1 = ld32(KSLOT(1) + kofs[0] + 4096, KSLOT(1) + kofs[1] + 4096);
  DMA_BAR(3);
#pragma unroll
  for (int r = 0; r < 16; ++r) ci[r] = 7.0f - m_reg;
#define ATT_STEP(t_, S_, CUR0, CUR1, PRV0, PRV1, ALC, PREF_, DK_, DV_, WAITN) do { SBAR(); \
    const bool need_ = att_step<PREF_, DK_, DV_>(CUR0, CUR1, PRV0, PRV1, m_reg, ALC, ci, o, l4, ka0, ka1, KSLOT(S_), VSLOT(((S_) + 3) & 3), KSLOT(((S_) + 1) & 3), q8, bsel, kofs, vofs, \
        Kh + (size_t)((t_) + 3) * (KVBLK * 128), Vh + (size_t)((t_) + 2) * (KVBLK * 128), kdst + (unsigned)((((S_) + 3) & 3) * SHM_K8), vdst + (unsigned)((((S_) + 2) & 3) * SHM_K8), koff, voff); \
    if (__builtin_expect(need_, 0)) { RESC(ALC); } DMA_BAR(WAITN); } while (0)
  int j = 1;
  for (; j + 3 < NT - 2; j += 4) {
    ATT_STEP(j,     1, pB0, pB1, pA0, pA1, alB, true, true, true, 3);
    ATT_STEP(j + 1, 2, pA0, pA1, pB0, pB1, alA, true, true, true, 3);
    ATT_STEP(j + 2, 3, pB0, pB1, pA0, pA1, alB, true, true, true, 3);
    ATT_STEP(j + 3, 0, pA0, pA1, pB0, pB1, alA, true, true, true, 3);
  }
  ATT_STEP(j,     1, pB0, pB1, pA0, pA1, alB, true, false, true, 0);
  ATT_STEP(j + 1, 2, pA0, pA1, pB0, pB1, alA, false, false, false, 0);
#undef ATT_STEP
  SBAR(); qkt8(pB0, pB1, KSLOT((NT - 1) & 3), q8, r32, hi, 7.0f - m_reg);
  finishSM8(pA0, pA1, pa); SBAR();
  pv8(o, l4, VSLOT((NT - 2) & 3), pa, bsel, r32, hi); partialSM8<false>(pB0, pB1, m_reg, alB);
  RESC(alB);
  finishSM8(pB0, pB1, pa); SBAR();
  pv8(o, l4, VSLOT((NT - 1) & 3), pa, bsel, r32, hi);
#undef KSLOT
#undef VSLOT
#undef DMA_K
#undef DMA_V
#undef DMA_BAR
  if ((lane & 15) < 2) *reinterpret_cast<f32x4_*>(li_l + lrow) = l4; asm volatile("s_waitcnt lgkmcnt(0)" ::: "memory");
  float rli[16];
#pragma unroll
  for (int r = 0; r < 16; ++r) rli[r] = __builtin_amdgcn_rcpf(li_l[crow(r, hi)]);
  bf16* Ow = Ob + (long)(wid * QBLK) * LDO;
#pragma unroll
  for (int r = 0; r < 16; ++r) { int orow = crow(r, hi);
    for (int d0 = 0; d0 < 4; ++d0) { const float v = o[d0][r] * rli[r]; unsigned u = __float_as_uint(v); u = (u + 0x7fffu + ((u >> 16) & 1u)) >> 16; Ow[(long)orow * LDO + d0 * 32 + r32] = (bf16)u; } }
  __syncthreads();
#undef RESC
}
#undef KSWZ
#undef SBAR
}
#define HD __device__ __forceinline__
#define HY_COSREV(x) __builtin_amdgcn_cosf(x)
#define HY_SINREV(x) __builtin_amdgcn_sinf(x)
#define HY_OPAQUE(x) asm volatile("" : "+v"(x))
#define HY_OPAQUE2(w) asm volatile("" : "+v"(w.x), "+v"(w.y))
#define HY_FENCE() asm volatile("" ::: "memory")
#define HY_SCHED() __builtin_amdgcn_sched_barrier(0)
#define HY_PIN2(w) asm volatile("" : "+v"(w.x), "+v"(w.y))
#ifndef HD
#define HD __device__ __forceinline__
#endif
typedef float f2 __attribute__((ext_vector_type(2)));
constexpr int HY_P = 8192, HY_L = 16384, HY_BUF = 8704;
HD int hy_pidx(int p) { return p + 2 * (p >> 5); }
#if defined(__HIP_DEVICE_COMPILE__) && !defined(HY_NO_ASM)
HD f2 cmul(f2 a, f2 w) { f2 t, r; asm("v_pk_mul_f32 %0, %2, %3 op_sel_hi:[1,0]\n\tv_pk_fma_f32 %1, %2, %3, %0 op_sel:[1,1,0] op_sel_hi:[0,1,1] neg_lo:[1,0,0]" : "=&v"(t), "=v"(r) : "v"(a), "v"(w)); return r; }
HD f2 cmulc(f2 a, f2 w) { f2 t, r; asm("v_pk_mul_f32 %0, %2, %3 op_sel_hi:[1,0]\n\tv_pk_fma_f32 %1, %2, %3, %0 op_sel:[1,1,0] op_sel_hi:[0,1,1] neg_hi:[1,0,0]" : "=&v"(t), "=v"(r) : "v"(a), "v"(w)); return r; }
HD f2 cmul_k(f2 a, f2 w) { f2 t, r; asm("v_pk_mul_f32 %0, %2, %3 op_sel_hi:[1,0]\n\tv_pk_fma_f32 %1, %2, %3, %0 op_sel:[1,1,0] op_sel_hi:[0,1,1] neg_lo:[1,0,0]" : "=&v"(t), "=v"(r) : "v"(a), "s"(w)); return r; }
#define HY_ASM 1
template <bool CONJ1> HD void cmul2(f2& r1, f2 a1, f2 w1, f2& r2, f2 a2, f2 w2) { f2 t1, t2;
    if (CONJ1) asm("v_pk_mul_f32 %0, %4, %5 op_sel_hi:[1,0]\n\tv_pk_mul_f32 %1, %6, %7 op_sel_hi:[1,0]\n\tv_pk_fma_f32 %2, %4, %5, %0 op_sel:[1,1,0] op_sel_hi:[0,1,1] neg_hi:[1,0,0]\n\tv_pk_fma_f32 %3, %6, %7, %1 op_sel:[1,1,0] op_sel_hi:[0,1,1] neg_lo:[1,0,0]"
                   : "=&v"(t1), "=&v"(t2), "=&v"(r1), "=&v"(r2) : "v"(a1), "v"(w1), "v"(a2), "v"(w2));
    else       asm("v_pk_mul_f32 %0, %4, %5 op_sel_hi:[1,0]\n\tv_pk_mul_f32 %1, %6, %7 op_sel_hi:[1,0]\n\tv_pk_fma_f32 %2, %4, %5, %0 op_sel:[1,1,0] op_sel_hi:[0,1,1] neg_lo:[1,0,0]\n\tv_pk_fma_f32 %3, %6, %7, %1 op_sel:[1,1,0] op_sel_hi:[0,1,1] neg_lo:[1,0,0]"
                   : "=&v"(t1), "=&v"(t2), "=&v"(r1), "=&v"(r2) : "v"(a1), "v"(w1), "v"(a2), "v"(w2)); }
#else
HD f2 cmul(f2 a, f2 w) { return (f2){a.x * w.x - a.y * w.y, a.x * w.y + a.y * w.x}; }
HD f2 cmulc(f2 a, f2 w) { return (f2){a.x * w.x + a.y * w.y, a.y * w.x - a.x * w.y}; }
HD f2 cmul_k(f2 a, f2 w) { return cmul(a, w); }
template <bool CONJ1> HD void cmul2(f2& r1, f2 a1, f2 w1, f2& r2, f2 a2, f2 w2) { r1 = CONJ1 ? cmulc(a1, w1) : cmul(a1, w1); r2 = cmul(a2, w2); }
#endif
template <int DIR> HD f2 hy_mi(f2 a) { return DIR > 0 ? (f2){a.y, -a.x} : (f2){-a.y, a.x}; }
#ifdef HY_ASM
HD f2 hy_cis(float rev) { f2 r = (f2){HY_COSREV(rev), HY_SINREV(rev)}; asm volatile("s_nop 0" : "+v"(r)); return r; }
#else
HD f2 hy_cis(float rev) { return (f2){HY_COSREV(rev), HY_SINREV(rev)}; }
#endif
HD float hy_bf(unsigned short u) { return __builtin_bit_cast(float, (unsigned)u << 16); }
HD unsigned hy_f2bf(float f) { unsigned u = __builtin_bit_cast(unsigned, f); return (u + 0x7fffu + ((u >> 16) & 1u)) >> 16; }
HD f2 hy_unpack(unsigned w) { return (f2){__builtin_bit_cast(float, w << 16), __builtin_bit_cast(float, w & 0xffff0000u)}; }
#if defined(__HIP_DEVICE_COMPILE__) && !defined(HY_NO_ASM)
HD unsigned hy_pack(f2 v) { unsigned r; asm("v_cvt_pk_bf16_f32 %0, %1, %2" : "=v"(r) : "v"(v.x), "v"(v.y)); return r; }
#else
HD unsigned hy_pack(f2 v) { return hy_f2bf(v.x) | (hy_f2bf(v.y) << 16); }
#endif

template <int DIR> HD void hy_r4(f2& x0, f2& x1, f2& x2, f2& x3) {
#ifdef HY_ASM
    const f2 s02 = x0 + x2, d02 = x0 - x2, s13 = x1 + x3, e = x1 - x3;
    f2 p, q; asm("v_pk_add_f32 %0, %2, %3 op_sel:[0,1] op_sel_hi:[1,0] neg_hi:[0,1]\n\tv_pk_add_f32 %1, %2, %3 op_sel:[0,1] op_sel_hi:[1,0] neg_lo:[0,1]" : "=&v"(p), "=&v"(q) : "v"(d02), "v"(e));
    x0 = s02 + s13; x2 = s02 - s13; x1 = DIR > 0 ? p : q; x3 = DIR > 0 ? q : p;
#else
    const f2 s02 = x0 + x2, d02 = x0 - x2, s13 = x1 + x3, d13 = hy_mi<DIR>(x1 - x3);
    x0 = s02 + s13; x1 = d02 + d13; x2 = s02 - s13; x3 = d02 - d13;
#endif
}
template <int DIR> HD void hy_dft16(f2 (&x)[16]) {
#pragma unroll
    for (int b = 0; b < 4; ++b) hy_r4<DIR>(x[b], x[4 + b], x[8 + b], x[12 + b]);
    constexpr float C1 = 0.92387953251128674f, S1 = 0.38268343236508977f, H = 0.70710678118654752f;
#define HY_TW(idx, cr, ci) x[idx] = cmul_k(x[idx], (f2){(cr), DIR > 0 ? (ci) : -(ci)})
    HY_TW(5, C1, -S1); HY_TW(9, H, -H); HY_TW(13, S1, -C1);
    HY_TW(6, H, -H); x[10] = hy_mi<DIR>(x[10]); HY_TW(14, -H, -H);
    HY_TW(7, S1, -C1); HY_TW(11, -H, -H); HY_TW(15, -C1, S1);
#undef HY_TW
#pragma unroll
    for (int c = 0; c < 4; ++c) hy_r4<DIR>(x[4 * c], x[4 * c + 1], x[4 * c + 2], x[4 * c + 3]);
}
#define HY_OUT(k) (4 * ((k) & 3) + ((k) >> 2))
template <int SL> HD constexpr int hy_koff(int k) { return SL >= 5 ? k * ((1 << SL) + (1 << (SL - 4))) : k * (1 << SL); }
template <int SL> HD int hy_pbase(int t) { const int blk = t >> SL, n0 = t & ((1 << SL) - 1); return hy_pidx((blk << (SL + 4)) + n0); }
template <int SL> HD void hy_fwd1(f2* X, int t, f2 w1) {
    HY_OPAQUE(t); HY_OPAQUE2(w1);
    const int pb = hy_pbase<SL>(t);
    f2 x[16];
#pragma unroll
    for (int k = 0; k < 16; ++k) x[k] = X[pb + hy_koff<SL>(k)];
    hy_dft16<1>(x);
    X[pb] = x[0];
    f2 w = w1;
#pragma unroll
    for (int k0 = 1; k0 < 16; ++k0) { f2 o; if (k0 < 15) { f2 wn; cmul2<false>(o, x[HY_OUT(k0)], w, wn, w, w1); X[pb + hy_koff<SL>(k0)] = o; w = wn; } else X[pb + hy_koff<SL>(k0)] = cmul(x[HY_OUT(k0)], w); }
}
template <int SL> HD void hy_inv1(f2* X, int t, f2 w1) {
    HY_OPAQUE(t); HY_OPAQUE2(w1);
    const int pb = hy_pbase<SL>(t);
    f2 x[16];
    x[0] = X[pb];
    f2 w = w1;
#pragma unroll
    for (int k0 = 1; k0 < 16; ++k0) { if (k0 < 15) { f2 wn; cmul2<true>(x[k0], X[pb + hy_koff<SL>(k0)], w, wn, w, w1); w = wn; } else x[k0] = cmulc(X[pb + hy_koff<SL>(k0)], w); }
    hy_dft16<-1>(x);
#pragma unroll
    for (int n1 = 0; n1 < 16; ++n1) X[pb + hy_koff<SL>(n1)] = x[HY_OUT(n1)];
}
HD f2 hy_cr(int R) { return R == 0 ? (f2){1.f, 0.f} : R == 1 ? (f2){0.f, -1.f} : R == 2 ? (f2){-1.f, 0.f} : (f2){0.f, 1.f}; }
HD void hy_s1_store(f2* X, int t, f2 (&x)[16], f2 w1) {
    const int pb = hy_pidx(t);
    X[pb] = x[0];
    f2 w = w1;
#pragma unroll
    for (int k0 = 1; k0 < 16; ++k0) { f2 o; if (k0 < 15) { f2 wn; cmul2<false>(o, x[HY_OUT(k0)], w, wn, w, w1); X[pb + hy_koff<9>(k0)] = o; w = wn; } else X[pb + hy_koff<9>(k0)] = cmul(x[HY_OUT(k0)], w); }
}
HD void hy_stage1A(f2* X, int t, int R, const unsigned short* hf, const unsigned short* hb, f2 w1) {
    HY_OPAQUE(t); HY_OPAQUE2(w1);
    const f2 cr = hy_cr(R); const float c2 = (R & 1) ? -1.f : 1.f;
    const float ang0 = -(float)(R * t) * (1.0f / 32768.0f), angs = -(float)R * (1.0f / 64.0f);
    f2 x[16];
#pragma unroll
    for (int n1 = 0; n1 < 16; ++n1) {
        const int np = t + 512 * n1;
        const float g0 = hy_bf(hf[np]), g1 = hy_bf(hf[np + HY_P]), g2 = hy_bf(hb[np ? HY_L - np : 0]) * (np ? 1.f : 0.f), g3 = hy_bf(hb[HY_P - np]);
        x[n1] = cmul((f2){g0 + c2 * g2 + (g1 + g3) * cr.x, (g1 - g3) * cr.y}, hy_cis(ang0 + (float)n1 * angs));
        if ((n1 & 3) == 3) HY_FENCE();
    }
    hy_dft16<1>(x);
    hy_s1_store(X, t, x, w1);
}
HD void hy_stage1B(f2* X, int t, int R, const unsigned* zp  , f2 w1) {
    HY_OPAQUE(t); HY_OPAQUE2(w1);
    const f2 cr = hy_cr(R);
    const float ang0 = -(float)(R * t) * (1.0f / 32768.0f), angs = -(float)R * (1.0f / 64.0f);
    f2 x[16];
#pragma unroll
    for (int n1 = 0; n1 < 16; ++n1) {
        unsigned q0 = zp[(2 * n1) * 512 + t], q1 = zp[(2 * n1 + 1) * 512 + t];
        const f2 z0 = hy_unpack(q0), z1 = hy_unpack(q1);
        x[n1] = cmul(z0 + cmul(z1, cr), hy_cis(ang0 + (float)n1 * angs));
    }
    hy_dft16<1>(x);
    hy_s1_store(X, t, x, w1);
}
HD f2 hy_w32(int k) {
    constexpr float c[16] = {1.f, 0.98078528040323043f, 0.92387953251128674f, 0.83146961230254524f, 0.70710678118654752f, 0.55557023301960218f, 0.38268343236508977f, 0.19509032201612825f,
                             0.f, -0.19509032201612825f, -0.38268343236508977f, -0.55557023301960218f, -0.70710678118654752f, -0.83146961230254524f, -0.92387953251128674f, -0.98078528040323043f};
    constexpr float sn[16] = {0.f, 0.19509032201612825f, 0.38268343236508977f, 0.55557023301960218f, 0.70710678118654752f, 0.83146961230254524f, 0.92387953251128674f, 0.98078528040323043f,
                              1.f, 0.98078528040323043f, 0.92387953251128674f, 0.83146961230254524f, 0.70710678118654752f, 0.55557023301960218f, 0.38268343236508977f, 0.19509032201612825f};
    return (f2){c[k], -sn[k]}; }
HD void hy_fwd3(const f2* X, int t, f2 (&x)[16]) {
    const int pb = hy_pbase<1>(t), n0 = t & 1;
#pragma unroll
    for (int k = 0; k < 16; ++k) x[k] = X[pb + 2 * k];
    hy_dft16<1>(x);
#pragma unroll
    for (int k0 = 1; k0 < 16; ++k0) x[HY_OUT(k0)] = cmul(x[HY_OUT(k0)], n0 ? hy_w32(k0) : (f2){1.f, 0.f});
}
template <class XCH> HD void hy_s3_fin(f2* X, int t, f2 (&xb)[16], const unsigned (&gp)[16], const XCH& P) {
    const int n0 = t & 1; const float sg = n0 ? -1.f : 1.f; const int pb = hy_pbase<1>(t);
#pragma unroll
    for (int k0 = 0; k0 < 16; ++k0) {
        const f2 a = hy_unpack(gp[HY_OUT(k0)]), b = xb[HY_OUT(k0)], qa = hy_unpack(P.a(HY_OUT(k0))), qb = P.b(HY_OUT(k0));
        const f2 y0 = cmul(b + qb, a + qa), y1 = cmul(b - qb, a - qa);
        const f2 yy = y0 + y1 * sg;
        xb[HY_OUT(k0)] = k0 ? cmulc(yy, n0 ? hy_w32(k0) : (f2){1.f, 0.f}) : yy;
        HY_PIN2(xb[HY_OUT(k0)]);
    }
    f2 y[16];
#pragma unroll
    for (int k0 = 0; k0 < 16; ++k0) y[k0] = xb[HY_OUT(k0)];
    hy_dft16<-1>(y);
#pragma unroll
    for (int n1 = 0; n1 < 16; ++n1) X[pb + 2 * n1] = y[HY_OUT(n1)];
}
HD void hy_inv1_acc(const f2* X, int t, int R, f2 w1, f2 (&yacc)[16][2]) {
    HY_OPAQUE(t); HY_OPAQUE2(w1);
    const f2 cr = hy_cr(R);
    const int pb = hy_pidx(t);
    f2 x[16];
    x[0] = X[pb];
    f2 w = w1;
#pragma unroll
    for (int k0 = 1; k0 < 16; ++k0) { if (k0 < 15) { f2 wn; cmul2<true>(x[k0], X[pb + hy_koff<9>(k0)], w, wn, w, w1); w = wn; } else x[k0] = cmulc(X[pb + hy_koff<9>(k0)], w); }
    hy_dft16<-1>(x);
    const float ang0 = (float)(R * t) * (1.0f / 32768.0f), angs = (float)R * (1.0f / 64.0f);
#pragma unroll
    for (int n1 = 0; n1 < 16; ++n1) {
        const f2 v = cmul(x[HY_OUT(n1)], hy_cis(ang0 + (float)n1 * angs));
        yacc[n1][0] += v;
        yacc[n1][1] += cmulc(v, cr);
        HY_PIN2(yacc[n1][0]); HY_PIN2(yacc[n1][1]);
    }
}
HD f2 hy_sconv(const unsigned short* row, int n, float w0, float w1, float w2, float cb) {
    const int nm = n > 0 ? n - 1 : 0, np = n < HY_L - 1 ? n + 1 : HY_L - 1;
    const float wm = n > 0 ? w0 : 0.f, wp = n < HY_L - 1 ? w2 : 0.f;
    const float a0 = hy_bf(row[nm]), a1 = hy_bf(row[n]), a2 = hy_bf(row[np]);
    const float b0 = hy_bf(row[HY_L + nm]), b1 = hy_bf(row[HY_L + n]), b2 = hy_bf(row[HY_L + np]);
    return (f2){wm * a0 + w1 * a1 + wp * a2 + cb, wm * b0 + w1 * b1 + wp * b2 + cb};
}
struct HyTw { f2 w8192, w512, w32; };
HD HyTw hy_tw(int t) { HyTw w; w.w8192 = hy_cis(-(float)t * (1.0f / 8192.0f)); w.w512 = hy_cis(-(float)(t & 31) * (1.0f / 512.0f)); w.w32 = hy_cis(-(float)(t & 1) * (1.0f / 32.0f)); return w; }
constexpr int NWAVES = 8;
#ifndef MK_N_LAUNCHES
#define MK_N_LAUNCHES 1
#endif
constexpr int N_PHASES = 12;
constexpr int N_LAUNCHES = MK_N_LAUNCHES;
constexpr int BATCH = 2, SEQ = 16384, DM = 2048, MTOK = BATCH * SEQ;
constexpr int HYW = 1024, NHY = 3072, NATT = 1536, INW = 4608;
constexpr int NE = 16, EFF = 1536, CAP = 2048, MOE_ROWS = NE * BATCH * CAP;
constexpr float LN_EPS = 1e-6f, DN_ALPHA = 1.189207115002721f;
typedef unsigned short bf16;
typedef unsigned v4u __attribute__((ext_vector_type(4)));
typedef float f32x4 __attribute__((ext_vector_type(4)));
typedef short bf16x8 __attribute__((ext_vector_type(8)));
#define LAS __attribute__((address_space(3)))
#define RLX_AGENT __ATOMIC_RELAXED, __HIP_MEMORY_SCOPE_AGENT
constexpr size_t MiB = 1u << 20;
constexpr size_t WS_CTL = 0, CTL_ZERO_BYTES = 1 * MiB;
constexpr size_t WS_H2 = 1 * MiB;
constexpr size_t WS_W3T = 9 * MiB;
constexpr size_t WS_AFF = 11 * MiB;
constexpr size_t WS_IDX = 13 * MiB;
constexpr size_t WS_GATE = 13 * MiB + 256 * 1024;
constexpr size_t WS_SLOT = 13 * MiB + 512 * 1024;
constexpr size_t WS_WIN = 16 * MiB;
constexpr size_t WS_WOUT = 34 * MiB;
constexpr size_t WS_WGU = 42 * MiB;
constexpr size_t WS_WD = 138 * MiB;
constexpr size_t WS_XB = 186 * MiB;
constexpr size_t WS_PT = 458 * MiB;
constexpr size_t WS_QKV = 650 * MiB;
constexpr size_t WS_FILT = 746 * MiB;
constexpr size_t WS_KP = 874 * MiB, WS_VP = 890 * MiB;
constexpr size_t WS_YHT = 906 * MiB;
constexpr size_t WS_ZPG = 330 * MiB;
constexpr size_t WS_YACC = 346 * MiB;
constexpr size_t WS_GSPEC = 378 * MiB;
constexpr size_t WS_YATT = 330 * MiB;
constexpr size_t WS_MIX = 394 * MiB;
constexpr size_t WS_T = 522 * MiB;
constexpr size_t WS_X1 = 650 * MiB;
constexpr size_t WS_XQ8 = 330 * MiB;
constexpr size_t WS_X8 = 330 * MiB;
constexpr size_t WS_XG = 330 * MiB;
constexpr size_t WS_HB = 778 * MiB;
constexpr size_t WS_Y = 330 * MiB;
constexpr size_t WS_END = 1024 * MiB;
constexpr int CW_TMO = 0, CW_BAR = 4096;
constexpr int RING_BYTES = 139264;
constexpr int LDSCTL_OFF = RING_BYTES, MISC_OFF = LDSCTL_OFF + 320;
constexpr int LDS_BYTES = 147456;
static_assert(HY_BUF * 8 + 65536 <= RING_BYTES && pg8::STAGE_BYTES <= RING_BYTES && (int)att::SHM_ATTN <= RING_BYTES && MISC_OFF + 128 <= LDS_BYTES, "LDS map");

__device__ __forceinline__ unsigned f2bf(float f) { unsigned u = __builtin_bit_cast(unsigned, f); return (u + 0x7fffu + ((u >> 16) & 1u)) >> 16; }
__device__ __forceinline__ unsigned pk2(float lo, float hi) { unsigned r; asm("v_cvt_pk_bf16_f32 %0, %1, %2" : "=v"(r) : "v"(lo), "v"(hi)); return r; }
__device__ __forceinline__ float bflo(unsigned w) { return __builtin_bit_cast(float, w << 16); }
__device__ __forceinline__ float bfhi(unsigned w) { return __builtin_bit_cast(float, w & 0xffff0000u); }
template <int CTRL> __device__ __forceinline__ float dpp_f(float v) { return __builtin_bit_cast(float, __builtin_amdgcn_mov_dpp(__builtin_bit_cast(int, v), CTRL, 0xF, 0xF, true)); }
__device__ __forceinline__ float row16_sum(float v) { v += dpp_f<0xB1>(v); v += dpp_f<0x4E>(v); v += dpp_f<0x141>(v); v += dpp_f<0x140>(v); return v; }
__device__ __forceinline__ float row16_max(float v) { v = fmaxf(v, dpp_f<0xB1>(v)); v = fmaxf(v, dpp_f<0x4E>(v)); v = fmaxf(v, dpp_f<0x141>(v)); v = fmaxf(v, dpp_f<0x140>(v)); return v; }
__device__ __forceinline__ float wave_sum(float v) {
    v = row16_sum(v);
    const float a = __builtin_bit_cast(float, __builtin_amdgcn_readlane(__builtin_bit_cast(int, v), 0)), b = __builtin_bit_cast(float, __builtin_amdgcn_readlane(__builtin_bit_cast(int, v), 16));
    const float c = __builtin_bit_cast(float, __builtin_amdgcn_readlane(__builtin_bit_cast(int, v), 32)), d = __builtin_bit_cast(float, __builtin_amdgcn_readlane(__builtin_bit_cast(int, v), 48));
    return (a + b) + (c + d);
}
#define LDS_WAIT() asm volatile("s_waitcnt lgkmcnt(0)" ::: "memory")
#define XB_TMO      128
#define XB_XCNT(j)  (256  + 64 * (j))
#define XB_XSUB(j)  (1280 + 64 * (j))
#define XB_XGEN(j)  (2304 + 64 * (j))
#define XB_TOP      3328
#define XB_TOPGEN   3392
#define XCD_BAR_WORDS 3456
#define XB_SPIN_CAP (1u << 18)

__device__ __forceinline__ unsigned xb_ld(unsigned* p)              { return __hip_atomic_load(p, __ATOMIC_RELAXED, __HIP_MEMORY_SCOPE_AGENT); }
__device__ __forceinline__ unsigned xb_add(unsigned* p, unsigned v) { return __hip_atomic_fetch_add(p, v, __ATOMIC_RELAXED, __HIP_MEMORY_SCOPE_AGENT); }
__device__ __forceinline__ unsigned xb_xcc_id() { return (unsigned)__builtin_amdgcn_s_getreg((3 << 11) | 20) & 0xFu; }
#define XB_SPIN(cond, bar) do { unsigned _sp = 0; while (cond) { __builtin_amdgcn_s_sleep(1); \
    if ((++_sp & 255u) == 0u) { if (xb_ld(&(bar)[XB_TMO])) break; if (_sp > XB_SPIN_CAP) { atomicAdd(&(bar)[XB_TMO], 1u); break; } } } } while (0)

struct XcdBarrier {
    unsigned* bar; unsigned x;
    volatile LAS unsigned* st;
};

__device__ __forceinline__ XcdBarrier xcd_barrier_post(unsigned* bar, volatile LAS unsigned* st) {
    XcdBarrier b; b.bar = bar; b.x = xb_xcc_id(); b.st = st;
    if (threadIdx.x == 0) (void)xb_add(&bar[XB_XCNT(b.x)], 1u);
    return b;
}
__device__ __forceinline__ void xcd_barrier_complete(unsigned* bar, unsigned x, unsigned& nloc, unsigned& nx) {
    const unsigned G = gridDim.x * gridDim.y * gridDim.z;
    unsigned sum, cnt, mine, sp = 0u;
    for (;;) {
        sum = 0u; cnt = 0u; mine = 0u;
#pragma unroll
        for (unsigned j = 0; j < 16; ++j) { const unsigned c = xb_ld(&bar[XB_XCNT(j)]); sum += c; cnt += (c > 0u) ? 1u : 0u; mine = (j == x) ? c : mine; }
        if (sum == G) break;
        __builtin_amdgcn_s_sleep(1);
        if ((++sp & 255u) == 0u) { if (xb_ld(&bar[XB_TMO])) break; if (sp > XB_SPIN_CAP) { atomicAdd(&bar[XB_TMO], 1u); break; } }
    }
    nloc = mine > 0u ? mine : 1u; nx = cnt > 0u ? cnt : 1u;
}

__device__ __forceinline__ void xcd_barrier(const XcdBarrier& b) {
    asm volatile("s_waitcnt vmcnt(0)" ::: "memory");
    __syncthreads();
    if (threadIdx.x == 0) {
        unsigned* bar = b.bar;
        __builtin_amdgcn_s_waitcnt(0);
        unsigned nloc = b.st[0], nx = b.st[1];
        if (nloc == 0u) { xcd_barrier_complete(bar, b.x, nloc, nx); b.st[0] = nloc; b.st[1] = nx; }
        const unsigned old = xb_add(&bar[XB_XSUB(b.x)], 1u);
        const unsigned gen = old / nloc;
        if (old + 1u == (gen + 1u) * nloc) {
            __builtin_amdgcn_fence(__ATOMIC_RELEASE, "agent");
            asm volatile("s_waitcnt vmcnt(0)" ::: "memory");
            const unsigned og = xb_add(&bar[XB_TOP], 1u);
            const unsigned tg = og / nx;
            if (og + 1u == (tg + 1u) * nx) xb_add(&bar[XB_TOPGEN], 1u);
            else XB_SPIN(xb_ld(&bar[XB_TOPGEN]) == tg, bar);
            __builtin_amdgcn_fence(__ATOMIC_ACQUIRE, "agent");
            xb_add(&bar[XB_XGEN(b.x)], 1u);
            asm volatile("s_waitcnt vmcnt(0)" ::: "memory");
        } else {
            XB_SPIN(xb_ld(&bar[XB_XGEN(b.x)]) == gen, bar);
            __builtin_amdgcn_fence(__ATOMIC_ACQUIRE, "agent");
            asm volatile("s_waitcnt vmcnt(0)" ::: "memory");
        }
    }
    __syncthreads();
}
#ifndef PROBE_SEC
#define PROBE_SEC 0
#endif
#define TSEC_B(id) do { if (PROBE_SEC == (id)) { asm volatile("s_waitcnt vmcnt(0) lgkmcnt(0)" ::: "memory"); t0_ = __builtin_amdgcn_s_memrealtime(); } } while (0)
#define TSEC_E(id) do { if (PROBE_SEC == (id)) { asm volatile("s_waitcnt vmcnt(0) lgkmcnt(0)" ::: "memory"); tacc_ += __builtin_amdgcn_s_memrealtime() - t0_; } } while (0)
struct Ctx { LAS unsigned char* lds; int tid, lane, wave, G, gw, NGW; };
#define COSREV(x) __builtin_amdgcn_cosf(x)
#define SINREV(x) __builtin_amdgcn_sinf(x)

__device__ __forceinline__ void transpose_item(const float* W, int ldw, int k0, int n0, bf16* dst, int ldk, LAS float* scr, int lane) {
    float tv[32];
#pragma unroll
    for (int i = 0; i < 32; ++i) tv[i] = W[(size_t)(k0 + 2 * i + (lane >> 5)) * ldw + n0 + (lane & 31)];
#pragma unroll
    for (int i = 0; i < 32; ++i) scr[(2 * i + (lane >> 5)) * 33 + (lane & 31)] = tv[i];
    LDS_WAIT(); asm volatile("" ::: "memory");
    const int c = lane & 7;
    if (ldk > 0) {
#pragma unroll
        for (int j = 0; j < 4; ++j) { const int n = (lane >> 3) + 8 * j; const LAS float* s = scr + (8 * c) * 33 + n;
            v4u o; o.x = pk2(s[0 * 33], s[1 * 33]); o.y = pk2(s[2 * 33], s[3 * 33]); o.z = pk2(s[4 * 33], s[5 * 33]); o.w = pk2(s[6 * 33], s[7 * 33]);
            *(v4u*)(dst + (size_t)n * ldk + 8 * c) = o; }
    } else {
#pragma unroll
        for (int j = 0; j < 4; ++j) { const int n = (lane >> 3) + 8 * j; const LAS float* s = scr + (8 * c) * 33 + n;
            int w0 = 0, w1 = 0;
            w0 = __builtin_amdgcn_cvt_pk_fp8_f32(32.f * s[0 * 33], 32.f * s[1 * 33], w0, false); w0 = __builtin_amdgcn_cvt_pk_fp8_f32(32.f * s[2 * 33], 32.f * s[3 * 33], w0, true);
            w1 = __builtin_amdgcn_cvt_pk_fp8_f32(32.f * s[4 * 33], 32.f * s[5 * 33], w1, false); w1 = __builtin_amdgcn_cvt_pk_fp8_f32(32.f * s[6 * 33], 32.f * s[7 * 33], w1, true);
            typedef int v2i_ __attribute__((ext_vector_type(2)));
            *(v2i_*)((unsigned char*)dst + (size_t)n * (size_t)(-ldk) + 8 * c) = (v2i_){w0, w1}; }
    }
    LDS_WAIT(); asm volatile("" ::: "memory");
}
constexpr int P7_MOVE = 20480;
template <class KP> __device__ __forceinline__ void p0_prologue(const Ctx& C, KP inp, unsigned char* ws) {
#define in(k) ((const float*)(__attribute__((address_space(1))) const float*)inp[k])
    LAS float* scr = (LAS float*)(C.lds + C.wave * 16384);
    const int lane = C.lane;
    bf16* WIN = (bf16*)(ws + WS_WIN); bf16* WOUT = (bf16*)(ws + WS_WOUT); bf16* WGU = (bf16*)(ws + WS_WGU); bf16* WD = (bf16*)(ws + WS_WD); bf16* W3T = (bf16*)(ws + WS_W3T);
    constexpr int I_IN = 32 * 144, I_OUT = 32 * 64, I_G = 16 * 32 * 48, I_D = 16 * 24 * 64 - P7_MOVE, I_3 = 128;
    constexpr int NITEMS = I_IN + I_OUT + 2 * I_G + I_D + I_3;
#define P0_DECODE(it_, SRC, LDW, DST, LDK) do { int r = (it_); \
        if (r < I_IN) { const int kb = r / 144, nb = r % 144; SRC = in(1) + (size_t)(64 * kb) * INW + 32 * nb; LDW = INW; \
            if (nb < 96) { DST = WIN + (size_t)(32 * nb) * DM + 64 * kb; LDK = DM; } else { DST = (bf16*)((unsigned char*)(WIN + (size_t)NHY * DM) + (size_t)(32 * (nb - 96)) * DM + 64 * kb); LDK = -DM; } break; } r -= I_IN; \
        if (r < I_OUT) { const int kb = r / 64, nb = r % 64; SRC = in(18) + (size_t)(64 * kb) * DM + 32 * nb; LDW = DM; DST = WOUT + (size_t)(32 * nb) * DM + 64 * kb; LDK = DM; break; } r -= I_OUT; \
        if (r < 2 * I_G) { const int up = r >= I_G; if (up) r -= I_G; const int e = r / (32 * 48), q = r % (32 * 48), kb = q / 48, nb = q % 48, n0 = 32 * nb; \
            const size_t drow = (size_t)e * 3072 + (n0 >> 7) * 256 + (n0 & 127) + (up ? 128 : 0); \
            SRC = (up ? in(24) : in(23)) + (size_t)e * DM * EFF + (size_t)(64 * kb) * EFF + n0; LDW = EFF; DST = (bf16*)((unsigned char*)WGU + drow * DM + 64 * kb); LDK = -DM; break; } r -= 2 * I_G; \
        if (r < I_D) { r += P7_MOVE; const int e = r / (24 * 64), q = r % (24 * 64), kb = q / 64, nb = q % 64; \
            SRC = in(25) + (size_t)e * EFF * DM + (size_t)(64 * kb) * DM + 32 * nb; LDW = DM; DST = (bf16*)((unsigned char*)WD + ((size_t)e * DM + 32 * nb) * EFF + 64 * kb); LDK = -EFF; break; } r -= I_D; \
        SRC = in(11) + 32 * r; LDW = 4096; DST = W3T + (size_t)(32 * r) * 128; LDK = 128; } while (0)
#define P0_LOAD(SRC, LDW, TV) do { _Pragma("unroll") for (int i = 0; i < 32; ++i) TV[i] = SRC[(size_t)(2 * i + (lane >> 5)) * LDW + (lane & 31)]; } while (0)
#pragma unroll 1
    for (int pass = 0; pass < 2; ++pass) {
    if (((C.wave & 1) != 0) != (pass == 0)) {
    { int it = C.gw; const float* src = nullptr; bf16* dst = nullptr; int ldw = 0, ldk = 0; float tv[32];
      if (it < NITEMS) { P0_DECODE(it, src, ldw, dst, ldk); P0_LOAD(src, ldw, tv); }
      while (it < NITEMS) {
          const int nx = it + C.NGW; const float* nsrc = src; bf16* ndst = dst; int nldw = ldw, nldk = ldk; float tn[32];
          if (nx < NITEMS) { P0_DECODE(nx, nsrc, nldw, ndst, nldk); P0_LOAD(nsrc, nldw, tn); }
          else {
#pragma unroll
              for (int i = 0; i < 32; ++i) tn[i] = 0.f; }
#pragma unroll
          for (int i = 0; i < 32; ++i) scr[(2 * i + (lane >> 5)) * 33 + (lane & 31)] = tv[i];
          LDS_WAIT(); asm volatile("" ::: "memory");
          const int c = lane & 7;
          if (ldk > 0) {
#pragma unroll
              for (int j = 0; j < 4; ++j) { const int n = (lane >> 3) + 8 * j; const LAS float* s = scr + (8 * c) * 33 + n;
                  v4u o; o.x = pk2(s[0 * 33], s[1 * 33]); o.y = pk2(s[2 * 33], s[3 * 33]); o.z = pk2(s[4 * 33], s[5 * 33]); o.w = pk2(s[6 * 33], s[7 * 33]);
                  *(v4u*)(dst + (size_t)n * ldk + 8 * c) = o; }
          } else {
#pragma unroll
              for (int j = 0; j < 4; ++j) { const int n = (lane >> 3) + 8 * j; const LAS float* s = scr + (8 * c) * 33 + n;
                  int w0 = 0, w1 = 0;
                  w0 = __builtin_amdgcn_cvt_pk_fp8_f32(32.f * s[0 * 33], 32.f * s[1 * 33], w0, false); w0 = __builtin_amdgcn_cvt_pk_fp8_f32(32.f * s[2 * 33], 32.f * s[3 * 33], w0, true);
                  w1 = __builtin_amdgcn_cvt_pk_fp8_f32(32.f * s[4 * 33], 32.f * s[5 * 33], w1, false); w1 = __builtin_amdgcn_cvt_pk_fp8_f32(32.f * s[6 * 33], 32.f * s[7 * 33], w1, true);
                  typedef int v2i_ __attribute__((ext_vector_type(2)));
                  *(v2i_*)((unsigned char*)dst + (size_t)n * (size_t)(-ldk) + 8 * c) = (v2i_){w0, w1}; }
          }
          LDS_WAIT(); asm volatile("" ::: "memory");
#pragma unroll
          for (int i = 0; i < 32; ++i) tv[i] = tn[i];
          src = nsrc; dst = ndst; ldw = nldw; ldk = nldk; it = nx; } }
#undef P0_DECODE
#undef P0_LOAD
    for (int i = C.gw * 64 + lane; i < 4096 * 8; i += C.NGW * 64) { const int row = i / 8, ch = i % 8; *(v4u*)(W3T + (size_t)row * 128 + 64 + 8 * ch) = (v4u){0u, 0u, 0u, 0u}; }
    { const float* x = in(0); bf16* XB = (bf16*)(ws + WS_XB); unsigned char* XQ8 = ws + WS_XQ8; const int NB = MTOK * DM / 512;
      typedef unsigned v2u_ __attribute__((ext_vector_type(2)));
#define XCVT(A, B, BASE) do { *(v2u_*)(XB + (BASE) + 4 * lane) = (v2u_){pk2(A[0], A[1]), pk2(A[2], A[3])}; *(v2u_*)(XB + (BASE) + 256 + 4 * lane) = (v2u_){pk2(B[0], B[1]), pk2(B[2], B[3])}; \
          int w0 = 0, w1 = 0; w0 = __builtin_amdgcn_cvt_pk_fp8_f32(8.f * A[0], 8.f * A[1], w0, false); w0 = __builtin_amdgcn_cvt_pk_fp8_f32(8.f * A[2], 8.f * A[3], w0, true); \
          w1 = __builtin_amdgcn_cvt_pk_fp8_f32(8.f * B[0], 8.f * B[1], w1, false); w1 = __builtin_amdgcn_cvt_pk_fp8_f32(8.f * B[2], 8.f * B[3], w1, true); \
          *(int*)(XQ8 + (BASE) + 4 * lane) = w0; *(int*)(XQ8 + (BASE) + 256 + 4 * lane) = w1; } while (0)
      for (int blk = C.gw; blk < NB; blk += 2 * C.NGW) { const int blk2 = blk + C.NGW; const bool h = blk2 < NB; const size_t e0 = (size_t)blk * 512, e1 = (size_t)blk2 * 512;
          const f32x4 a0 = *(const f32x4*)(x + e0 + 4 * lane), b0 = *(const f32x4*)(x + e0 + 256 + 4 * lane);
          f32x4 a1 = a0, b1 = b0; if (h) { a1 = *(const f32x4*)(x + e1 + 4 * lane); b1 = *(const f32x4*)(x + e1 + 256 + 4 * lane); }
          XCVT(a0, b0, e0);
          if (h) XCVT(a1, b1, e1); }
#undef XCVT
    }
    } else
    { const float* w1 = in(5); const float* b1 = in(6); const float* f1 = in(7); const float* w2 = in(8); const float* b2 = in(9); const float* fq2 = in(10); bf16* H2 = (bf16*)(ws + WS_H2);
      const float b1k = b1[lane], f1k = f1[lane], b2k = b2[lane], f2k = fq2[lane];
      float w1r[33], w2r[64];
#pragma unroll
      for (int i = 0; i < 33; ++i) w1r[i] = w1[i * 64 + lane];
#pragma unroll
      for (int j = 0; j < 64; ++j) w2r[j] = w2[j * 64 + lane];
      for (int t = C.gw; t < SEQ; t += C.NGW) {
          float acc = b1k + ((float)t * (1.0f / 16383.0f)) * w1r[0];
#pragma unroll
          for (int i = 0; i < 16; ++i) { const float fi = 1e-4f + (float)i * ((15.0f - 1e-4f) / 15.0f); const float rev = fi * (float)t * (1.0f / 16384.0f);
              acc += COSREV(rev) * w1r[1 + i] - SINREV(rev) * w1r[17 + i]; }
          const float h1 = SINREV(f1k * acc * 0.15915494309189535f);
          scr[lane] = h1; LDS_WAIT(); asm volatile("" ::: "memory");
          float a2 = b2k;
#pragma unroll
          for (int j = 0; j < 64; ++j) a2 += scr[j] * w2r[j];
          const float h2 = SINREV(f2k * a2 * 0.15915494309189535f);
          LDS_WAIT(); asm volatile("" ::: "memory");
          bf16* o = H2 + (size_t)t * 128; o[lane] = (bf16)f2bf(h2); o[64 + lane] = 0;
      } }
    }
#undef in
}

__device__ __forceinline__ void p7_side_transposes(const Ctx& C, const float* wdown, unsigned char* ws) {
    LAS float* scr = (LAS float*)(C.lds + C.wave * 16384); bf16* WD = (bf16*)(ws + WS_WD);
    const int nw = (C.G - 32) * NWAVES, w0 = (blockIdx.x - 32) * NWAVES + C.wave;
    for (int r = w0; r < P7_MOVE; r += nw) { const int e = r / (24 * 64), q = r % (24 * 64), kb = q / 64, nb = q % 64;
        transpose_item(wdown + (size_t)e * EFF * DM, DM, 64 * kb, 32 * nb, (bf16*)((unsigned char*)WD + ((size_t)e * DM + 32 * nb) * EFF + 64 * kb), -EFF, scr, C.lane); }
}
__device__ __forceinline__ void p2_kpass(const Ctx& C, const float* kn, unsigned char* ws) {
    const bf16* QKV = (const bf16*)(ws + WS_QKV); unsigned char* KP8 = ws + WS_KP; unsigned char* VT8 = ws + WS_VP;
    const int lane = C.lane; const float g0 = kn[2 * lane], g1 = kn[2 * lane + 1];
    const float inv = __builtin_amdgcn_exp2f(-(float)(lane & 31) * (13.287712379549449f / 32.0f));
    for (int it = C.gw; it < MTOK / 16; it += C.NGW) {
        const int kvh = it & 1, H = (it >> 1) & 1, T = it >> 2, m0 = 64 * T + 32 * H, b = m0 >> 14, l0 = m0 & (SEQ - 1);
        unsigned pv[32];
#pragma unroll
        for (int u = 0; u < 32; ++u) pv[u] = *(const unsigned*)(QKV + (size_t)(m0 + u) * NATT + 1280 + kvh * 128 + 2 * lane);
        unsigned vlo[8], vhi[8];
#pragma unroll
        for (int g = 0; g < 8; ++g) { vlo[g] = 0u; vhi[g] = 0u;
#pragma unroll
            for (int u = 0; u < 4; ++u) { const unsigned w8 = (unsigned)__builtin_amdgcn_cvt_pk_fp8_f32(4.f * bflo(pv[4 * g + u]), 4.f * bfhi(pv[4 * g + u]), 0, false);
                vlo[g] |= (w8 & 0xffu) << (8 * u); vhi[g] |= ((w8 >> 8) & 0xffu) << (8 * u); } }
        unsigned char* tb = VT8 + (((size_t)(b * 2 + kvh) * SEQ) + (size_t)(l0 & ~63)) * 128; const int c0 = 2 * lane, c1 = 2 * lane + 1;
#pragma unroll
        for (int hi_ = 0; hi_ < 2; ++hi_) { const int q4 = 2 * hi_ + H;
            *(v4u*)(tb + c0 * 64 + ((q4 ^ ((c0 >> 2) & 3)) << 4)) = (v4u){vlo[hi_], vlo[2 + hi_], vlo[4 + hi_], vlo[6 + hi_]};
            *(v4u*)(tb + c1 * 64 + ((q4 ^ ((c1 >> 2) & 3)) << 4)) = (v4u){vhi[hi_], vhi[2 + hi_], vhi[4 + hi_], vhi[6 + hi_]}; } }
#define KP_LOAD(it_, PK) do { const int kvh_ = (it_) & 1, m0_ = 4 * ((it_) >> 1); _Pragma("unroll") for (int u = 0; u < 4; ++u) { \
        PK[u] = *(const unsigned*)(QKV + (size_t)(m0_ + u) * NATT + 1024 + kvh_ * 128 + 2 * lane); } } while (0)
    unsigned pk[4];
    if (C.gw < MTOK / 2) KP_LOAD(C.gw, pk);
    for (int it = C.gw; it < MTOK / 2; it += C.NGW) {
        const int kvh = it & 1, m0 = 4 * (it >> 1), b = m0 >> 14, l0 = m0 & (SEQ - 1);
        unsigned nk[4]; { const int nx = it + C.NGW < MTOK / 2 ? it + C.NGW : it; KP_LOAD(nx, nk); }
#pragma unroll
        for (int u = 0; u < 4; ++u) { const int l = l0 + u;
            float x0 = bflo(pk[u]), x1 = bfhi(pk[u]);
            const float ss = wave_sum(x0 * x0 + x1 * x1), rs = 1.0f / sqrtf(ss * (1.0f / 128.0f) + LN_EPS);
            x0 *= rs * g0; x1 *= rs * g1;
            const float pos = (float)(lane < 32 ? (l >> 6) : (l & 63)), rev = pos * inv * 0.15915494309189535f, c = COSREV(rev), s = SINREV(rev);
            *(unsigned short*)(KP8 + (((size_t)(b * 2 + kvh) * SEQ + l) * 128) + 2 * lane) = (unsigned short)__builtin_amdgcn_cvt_pk_fp8_f32(x0 * c - x1 * s, x0 * s + x1 * c, 0, false); }
#pragma unroll
        for (int u = 0; u < 4; ++u) pk[u] = nk[u]; }
#undef KP_LOAD
}

__device__ __forceinline__ float hy_dppx(float v) { return __builtin_bit_cast(float, __builtin_amdgcn_mov_dpp(__builtin_bit_cast(int, v), 0xB1, 0xF, 0xF, true)); }
__device__ __forceinline__ void hy_bulk(unsigned char* dst, const bf16* src0, const bf16* src1, int t) {
    v4u v[8];
#pragma unroll
    for (int k = 0; k < 8; ++k) { const int ch = t + 512 * k; const bf16* s = (ch < 2048 ? src0 : src1) + (size_t)(ch & 2047) * 8; v[k] = *(const v4u*)s; }
#pragma unroll
    for (int k = 0; k < 8; ++k) *(v4u*)(dst + (size_t)(t + 512 * k) * 16) = v[k];
}
__device__ __forceinline__ void hy_unit(int c, const float* cw, const float* cbias, const float* skip, unsigned char* ws, unsigned char* lds, int t, unsigned long long& tacc_) {
    unsigned long long t0_ = 0; TSEC_B(7);
    const bf16* PT = (const bf16*)(ws + WS_PT); const bf16* FILT = (const bf16*)(ws + WS_FILT); bf16* YHT = (bf16*)(ws + WS_YHT);
    f2* X = (f2*)lds; unsigned char* TB = lds + HY_BUF * 8; const bf16* TAPS = (const bf16*)TB;
    const HyTw tw = hy_tw(t);
    unsigned* zp = (unsigned*)(ws + WS_ZPG) + (size_t)blockIdx.x * (32 * 512); f2* yg = (f2*)(ws + WS_YACC) + (size_t)blockIdx.x * (32 * 512);
    unsigned* gs = (unsigned*)(ws + WS_GSPEC) + (size_t)blockIdx.x * (16 * 512);
    HY_OPAQUE(t);
    TSEC_B(6);
    {
      const bf16* f0 = FILT + (size_t)c * SEQ; const bf16* f1 = FILT + (size_t)(2048 + c) * SEQ; const int wv = t >> 6;
#pragma unroll
      for (int k = 0; k < 8; ++k) __builtin_amdgcn_global_load_lds((const unsigned*)((k < 4 ? f0 : f1) + (size_t)(t + 512 * (k & 3)) * 8), (LAS unsigned*)(lds + (size_t)(wv * 64 + 512 * k) * 16), 16, 0, 0); }
    { const bf16* row = PT + (size_t)c * MTOK; hy_bulk(TB, row, row + SEQ, t); __syncthreads();
      const float w0 = cw[c], w1 = cw[NHY + c], w2 = cw[2 * NHY + c], cb = cbias[c];
#pragma unroll
      for (int n1 = 0; n1 < 16; ++n1)
#pragma unroll
          for (int j = 0; j < 2; ++j) { zp[(2 * n1 + j) * 512 + t] = hy_pack(hy_sconv(TAPS, t + 512 * n1 + HY_P * j, w0, w1, w2, cb)); if (n1 & 1) HY_FENCE(); }
      __syncthreads(); }
    TSEC_E(6);
#pragma unroll 1
    for (int order = 0; order < 2; ++order) {
        TSEC_B(6);
        if (order == 0) { TB = lds; TAPS = (const bf16*)TB; X = (f2*)(lds + 65536); }
        else { TB = lds + HY_BUF * 8; TAPS = (const bf16*)TB; X = (f2*)lds; }
        TSEC_E(6);
        f2 yacc[16][2];
#pragma unroll
        for (int n1 = 0; n1 < 16; ++n1) { yacc[n1][0] = (f2){0.f, 0.f}; yacc[n1][1] = (f2){0.f, 0.f}; }
#pragma unroll 1
        for (int R = 0; R < 4; ++R) {
            unsigned Gp[16];
            if (R != 3) {
            TSEC_B(1); hy_stage1A(X, t, R, TAPS, TAPS + SEQ, tw.w8192); __syncthreads(); TSEC_E(1);
            TSEC_B(2); hy_fwd1<5>(X, t, tw.w512); __syncthreads(); TSEC_E(2);
            TSEC_B(3); { int t3 = t; HY_OPAQUE(t3); f2 G[16]; hy_fwd3(X, t3, G);
#pragma unroll
              for (int i = 0; i < 16; ++i) Gp[i] = hy_pack(G[i]); } __syncthreads(); TSEC_E(3);
              if (R == 1) { v4u* gd = (v4u*)(gs + (size_t)t * 16);
#pragma unroll
                for (int q = 0; q < 4; ++q) gd[q] = (v4u){Gp[4 * q], Gp[4 * q + 1], Gp[4 * q + 2], Gp[4 * q + 3]}; }
            } else {
              {
                const bf16* grow = PT + (size_t)((order + 1) * HYW + c) * MTOK; const int wv = t >> 6;
#pragma unroll
                for (int k = 0; k < 8; ++k) __builtin_amdgcn_global_load_lds((const unsigned*)(grow + (size_t)(t + 512 * k) * 8), (LAS unsigned*)(TB + (size_t)(wv * 64 + 512 * k) * 16), 16, 0, 0); }
              int t2 = 2 * (255 - (t >> 1)) + (t & 1); HY_OPAQUE(t2);
              const v4u* gsrc = (const v4u*)(gs + (size_t)t2 * 16); unsigned gl[16];
#pragma unroll
              for (int q = 0; q < 4; ++q) { const v4u v = gsrc[q]; gl[4 * q] = v.x; gl[4 * q + 1] = v.y; gl[4 * q + 2] = v.z; gl[4 * q + 3] = v.w; }
              const unsigned flip = (t & 1) ? 0x00008000u : 0x80000000u;
#pragma unroll
              for (int k0 = 0; k0 < 16; ++k0) Gp[HY_OUT(k0)] = gl[HY_OUT(15 - k0)] ^ flip;
            }
            TSEC_B(1); hy_stage1B(X, t, R, zp, tw.w8192); __syncthreads(); TSEC_E(1);
            TSEC_B(2); hy_fwd1<5>(X, t, tw.w512); __syncthreads(); TSEC_E(2);
            TSEC_B(3);
            { int t3 = t; HY_OPAQUE(t3); f2 xb[16];
              hy_fwd3(X, t3, xb);
              struct XD { const unsigned (&g)[16]; const f2 (&xb)[16];
                  __device__ __forceinline__ unsigned a(int i) const { return (unsigned)__builtin_amdgcn_mov_dpp((int)g[i], 0xB1, 0xF, 0xF, true); }
                  __device__ __forceinline__ f2 b(int i) const { return (f2){hy_dppx(xb[i].x), hy_dppx(xb[i].y)}; } } P{Gp, xb};
              hy_s3_fin(X, t3, xb, Gp, P); }
            __syncthreads(); TSEC_E(3);
            TSEC_B(4); hy_inv1<5>(X, t, tw.w512); __syncthreads(); TSEC_E(4);
            TSEC_B(5); hy_inv1_acc(X, t, R, tw.w8192, yacc); TSEC_E(5);
            HY_SCHED();
        }
        TSEC_B(6);
        const int ch = (order + 1) * HYW + c;
        HY_OPAQUE(t);
        __syncthreads();
        if (order == 0) {
            const bf16* f0 = FILT + (size_t)(1024 + c) * SEQ; const bf16* f1 = FILT + (size_t)(2048 + 1024 + c) * SEQ; const int wv = t >> 6;
#pragma unroll
            for (int k = 0; k < 8; ++k) __builtin_amdgcn_global_load_lds((const unsigned*)((k < 4 ? f0 : f1) + (size_t)(t + 512 * (k & 3)) * 8), (LAS unsigned*)(lds + HY_BUF * 8 + (size_t)(wv * 64 + 512 * k) * 16), 16, 0, 0); }
        const float w0 = cw[ch], w1 = cw[NHY + ch], w2 = cw[2 * NHY + ch], cb = cbias[ch], d = skip[order * HYW + c];
        bf16* o0 = YHT + (size_t)c * SEQ; bf16* o1 = YHT + (size_t)(HYW + c) * SEQ;
#pragma unroll
        for (int hh = 0; hh < 2; ++hh) {
            unsigned zq[8][2];
#pragma unroll
            for (int q = 0; q < 8; ++q) { zq[q][0] = zp[(2 * (8 * hh + q)) * 512 + t]; zq[q][1] = zp[(2 * (8 * hh + q) + 1) * 512 + t]; }
#pragma unroll
            for (int q = 0; q < 8; ++q) { const int n1 = 8 * hh + q;
#pragma unroll
                for (int j = 0; j < 2; ++j) { const int n = t + 512 * n1 + HY_P * j; const f2 ux = hy_sconv(TAPS, n, w0, w1, w2, cb), zz = hy_unpack(zq[q][j]);
                    const f2 y = ux * (yacc[n1][j] * (1.0f / 32768.0f) + zz * d);
                    if (order == 0) zp[(2 * n1 + j) * 512 + t] = hy_pack(y); else { const unsigned w = hy_pack(y); o0[n] = (bf16)(w & 0xffffu); o1[n] = (bf16)(w >> 16); } }
                if (q & 1) HY_FENCE(); }
        }
        __syncthreads();
        TSEC_E(6);
    }
    TSEC_E(7);
}

__device__ __forceinline__ void p4_merge(const Ctx& C, const float* ghy, const float* gatt, unsigned char* ws) {
    const bf16* YHT = (const bf16*)(ws + WS_YHT); const bf16* YATT = (const bf16*)(ws + WS_YATT); bf16* MIX = (bf16*)(ws + WS_MIX);
    const int lane = C.lane, tid = C.tid;
    const f32x4 g0 = *(const f32x4*)(gatt + 8 * lane), g1 = *(const f32x4*)(gatt + 8 * lane + 4), g2 = *(const f32x4*)(gatt + 512 + 8 * lane), g3 = *(const f32x4*)(gatt + 512 + 8 * lane + 4);
    v4u na = *(const v4u*)(YATT + (size_t)C.gw * 1024 + 8 * lane), nb = *(const v4u*)(YATT + (size_t)C.gw * 1024 + 512 + 8 * lane);
    for (int m = C.gw; m < MTOK; m += C.NGW) {
        const v4u a = na, b = nb;
        { const int mn = m + C.NGW < MTOK ? m + C.NGW : m; const bf16* rn = YATT + (size_t)mn * 1024; na = *(const v4u*)(rn + 8 * lane); nb = *(const v4u*)(rn + 512 + 8 * lane); }
        float v[16]; v[0] = bflo(a.x); v[1] = bfhi(a.x); v[2] = bflo(a.y); v[3] = bfhi(a.y); v[4] = bflo(a.z); v[5] = bfhi(a.z); v[6] = bflo(a.w); v[7] = bfhi(a.w);
        v[8] = bflo(b.x); v[9] = bfhi(b.x); v[10] = bflo(b.y); v[11] = bfhi(b.y); v[12] = bflo(b.z); v[13] = bfhi(b.z); v[14] = bflo(b.w); v[15] = bfhi(b.w);
        float ss = 0.f;
#pragma unroll
        for (int i = 0; i < 16; ++i) ss += v[i] * v[i];
        const float rs = 1.0f / sqrtf(wave_sum(ss) * (1.0f / 1024.0f) + LN_EPS);
        v4u o0, o1;
        o0.x = pk2(v[0] * rs * g0[0], v[1] * rs * g0[1]); o0.y = pk2(v[2] * rs * g0[2], v[3] * rs * g0[3]); o0.z = pk2(v[4] * rs * g1[0], v[5] * rs * g1[1]); o0.w = pk2(v[6] * rs * g1[2], v[7] * rs * g1[3]);
        o1.x = pk2(v[8] * rs * g2[0], v[9] * rs * g2[1]); o1.y = pk2(v[10] * rs * g2[2], v[11] * rs * g2[3]); o1.z = pk2(v[12] * rs * g3[0], v[13] * rs * g3[1]); o1.w = pk2(v[14] * rs * g3[2], v[15] * rs * g3[3]);
        bf16* d = MIX + (size_t)m * DM + 1024; *(v4u*)(d + 8 * lane) = o0; *(v4u*)(d + 512 + 8 * lane) = o1; }
    LAS unsigned short* tile = (LAS unsigned short*)C.lds; LAS float* red = (LAS float*)(C.lds + 512 * 136);
    const int cg = tid >> 6;
#define P4_LOAD(u_, h_, V) do { const int b_ = (u_) >> 8, n0_ = ((u_) & 255) * 64; _Pragma("unroll") for (int i = 0; i < 8; ++i) { const int cl = i * 64 + (tid >> 3), seg = tid & 7; \
        V[i] = *(const v4u*)(YHT + ((size_t)(b_ * 1024 + (h_) * 512 + cl)) * SEQ + n0_ + 8 * seg); } } while (0)
    LAS float* tots = red + 512;
    const int part = lane & 7, tl = lane >> 3;
    v4u cv[8];
    if ((int)blockIdx.x < MTOK / 64) P4_LOAD((int)blockIdx.x, 0, cv);
    for (int u = blockIdx.x; u < MTOK / 64; u += C.G) { const int b = u >> 8, n0 = (u & 255) * 64;
        v4u pkv[2][8]; float ssv[8];
#pragma unroll
        for (int it = 0; it < 8; ++it) ssv[it] = 0.f;
#pragma unroll
        for (int h = 0; h < 2; ++h) {
            v4u nv[8];
            if (h == 0) P4_LOAD(u, 1, nv); else { const int un = u + C.G < MTOK / 64 ? u + C.G : u; P4_LOAD(un, 0, nv); }
            __syncthreads();
#pragma unroll
            for (int i = 0; i < 8; ++i) { const int cl = i * 64 + (tid >> 3), seg = tid & 7; const v4u v = cv[i];
                LAS unsigned* d = (LAS unsigned*)(tile + cl * 68 + 8 * seg); d[0] = v.x; d[1] = v.y; d[2] = v.z; d[3] = v.w; }
            __syncthreads();
#pragma unroll
            for (int it = 0; it < 8; ++it) { const LAS unsigned short* tp = tile + (cg * 64 + 8 * part) * 68 + 8 * it + tl; unsigned w[4]; float q = 0.f;
#pragma unroll
                for (int j = 0; j < 4; ++j) { const unsigned lo = tp[(2 * j) * 68], hi2 = tp[(2 * j + 1) * 68]; w[j] = lo | (hi2 << 16);
                    const float a = __builtin_bit_cast(float, lo << 16), bb = __builtin_bit_cast(float, hi2 << 16); q += a * a + bb * bb; }
                pkv[h][it] = (v4u){w[0], w[1], w[2], w[3]}; ssv[it] += q; }
#pragma unroll
            for (int i = 0; i < 8; ++i) cv[i] = nv[i];
        }
        float mine = 0.f;
#pragma unroll
        for (int it = 0; it < 8; ++it) { float v = ssv[it]; v += dpp_f<0xB1>(v); v += dpp_f<0x4E>(v); v += dpp_f<0x141>(v); mine = (part == it) ? v : mine; }
        __syncthreads();
        red[cg * 64 + 8 * part + tl] = mine; __syncthreads();
        if (tid < 64) { float tot = 0.f;
#pragma unroll
            for (int g = 0; g < 8; ++g) tot += red[g * 64 + tid];
            tots[tid] = 1.0f / sqrtf(tot * (1.0f / 1024.0f) + LN_EPS); }
        __syncthreads();
#pragma unroll
        for (int h = 0; h < 2; ++h) { const int c0 = h * 512 + cg * 64 + 8 * part;
            const f32x4 g0 = *(const f32x4*)(ghy + c0), g1 = *(const f32x4*)(ghy + c0 + 4);
#pragma unroll
            for (int it = 0; it < 8; ++it) { const float rs = tots[8 * it + tl]; const v4u w = pkv[h][it]; v4u o;
                o.x = pk2(bflo(w.x) * rs * g0[0], bfhi(w.x) * rs * g0[1]); o.y = pk2(bflo(w.y) * rs * g0[2], bfhi(w.y) * rs * g0[3]);
                o.z = pk2(bflo(w.z) * rs * g1[0], bfhi(w.z) * rs * g1[1]); o.w = pk2(bflo(w.w) * rs * g1[2], bfhi(w.w) * rs * g1[3]);
                *(v4u*)(MIX + (size_t)(b * SEQ + n0 + 8 * it + tl) * DM + c0) = o; } }
    }
#undef P4_LOAD
}

__device__ __forceinline__ float p6_dot2(unsigned x, unsigned w, float acc) { typedef __bf16 bf2 __attribute__((ext_vector_type(2))); return __builtin_amdgcn_fdot2_f32_bf16(__builtin_bit_cast(bf2, x), __builtin_bit_cast(bf2, w), acc, false); }
__device__ __forceinline__ void p6_ln_router(const Ctx& C, const float* g, const float* be, const float* wr, const float* br, unsigned char* ws) {
    typedef __bf16 bf2 __attribute__((ext_vector_type(2)));
    const bf16* T = (const bf16*)(ws + WS_T); bf16* X1 = (bf16*)(ws + WS_X1); float* AFF = (float*)(ws + WS_AFF); unsigned char* X8 = ws + WS_X8;
    const int lane = C.lane; LAS v4u* wl = (LAS v4u*)C.lds;
    __syncthreads();
    for (int idx = C.tid; idx < 1024 * 4; idx += 512) { const int pp = idx >> 2, q = idx & 3, k = 2 * pp, ppos = (pp >> 8) * 256 + (pp & 3) * 64 + ((pp >> 2) & 63);
        const f32x4 a = *(const f32x4*)(wr + k * 16 + 4 * q), b = *(const f32x4*)(wr + (k + 1) * 16 + 4 * q);
        v4u o; o.x = pk2(a[0], b[0]); o.y = pk2(a[1], b[1]); o.z = pk2(a[2], b[2]); o.w = pk2(a[3], b[3]); wl[q * 1024 + ppos] = o; }
    __syncthreads();
    v4u ta[4];
#pragma unroll
    for (int j = 0; j < 4; ++j) ta[j] = *(const v4u*)(T + (size_t)(C.gw < MTOK ? C.gw : 0) * DM + 512 * j + 8 * lane);
    f32x4 gam[4][2], bet[4][2];
#pragma unroll
    for (int j = 0; j < 4; ++j) { const int k0 = 512 * j + 8 * lane; gam[j][0] = *(const f32x4*)(g + k0); gam[j][1] = *(const f32x4*)(g + k0 + 4); bet[j][0] = *(const f32x4*)(be + k0); bet[j][1] = *(const f32x4*)(be + k0 + 4); }
    for (int m = C.gw; m < MTOK; m += C.NGW) {
        float v[4][8]; float s = 0.f;
#pragma unroll
        for (int j = 0; j < 4; ++j) { const v4u a = ta[j];
            v[j][0] = bflo(a.x); v[j][1] = bfhi(a.x); v[j][2] = bflo(a.y); v[j][3] = bfhi(a.y); v[j][4] = bflo(a.z); v[j][5] = bfhi(a.z); v[j][6] = bflo(a.w); v[j][7] = bfhi(a.w);
#pragma unroll
            for (int e = 0; e < 8; ++e) s += v[j][e]; }
        { const int mn = m + C.NGW < MTOK ? m + C.NGW : m;
#pragma unroll
          for (int j = 0; j < 4; ++j) ta[j] = *(const v4u*)(T + (size_t)mn * DM + 512 * j + 8 * lane); }
        const float mean = wave_sum(s) * (1.0f / DM); float q2 = 0.f;
#pragma unroll
        for (int j = 0; j < 4; ++j)
#pragma unroll
            for (int e = 0; e < 8; ++e) { v[j][e] -= mean; q2 += v[j][e] * v[j][e]; }
        const float rstd = 1.0f / sqrtf(wave_sum(q2) * (1.0f / DM) + LN_EPS);
        float acc[16];
#pragma unroll
        for (int e = 0; e < 16; ++e) acc[e] = 0.f;
#pragma unroll
        for (int j = 0; j < 4; ++j) { const int k0 = 512 * j + 8 * lane;
            const f32x4 ga = gam[j][0], gb = gam[j][1], ba = bet[j][0], bb = bet[j][1];
            unsigned o[4];
            o[0] = pk2(v[j][0] * rstd * ga[0] + ba[0], v[j][1] * rstd * ga[1] + ba[1]); o[1] = pk2(v[j][2] * rstd * ga[2] + ba[2], v[j][3] * rstd * ga[3] + ba[3]);
            o[2] = pk2(v[j][4] * rstd * gb[0] + bb[0], v[j][5] * rstd * gb[1] + bb[1]); o[3] = pk2(v[j][6] * rstd * gb[2] + bb[2], v[j][7] * rstd * gb[3] + bb[3]);
            *(v4u*)(X1 + (size_t)m * DM + k0) = (v4u){o[0], o[1], o[2], o[3]};
            { int w0 = 0, w1 = 0;
              w0 = __builtin_amdgcn_cvt_pk_fp8_f32(bflo(o[0]), bfhi(o[0]), w0, false); w0 = __builtin_amdgcn_cvt_pk_fp8_f32(bflo(o[1]), bfhi(o[1]), w0, true);
              w1 = __builtin_amdgcn_cvt_pk_fp8_f32(bflo(o[2]), bfhi(o[2]), w1, false); w1 = __builtin_amdgcn_cvt_pk_fp8_f32(bflo(o[3]), bfhi(o[3]), w1, true);
              typedef int v2i_ __attribute__((ext_vector_type(2)));
              *(v2i_*)(X8 + (size_t)m * DM + k0) = (v2i_){w0, w1}; }
#pragma unroll
            for (int pe = 0; pe < 4; ++pe) { const unsigned xp = o[pe]; const int ppos = j * 256 + pe * 64 + lane;
#pragma unroll
                for (int q = 0; q < 4; ++q) { const v4u w = wl[q * 1024 + ppos]; const unsigned w0 = w.x, w1 = w.y, w2 = w.z, w3 = w.w;
                    acc[4 * q] = p6_dot2(xp, w0, acc[4 * q]); acc[4 * q + 1] = p6_dot2(xp, w1, acc[4 * q + 1]); acc[4 * q + 2] = p6_dot2(xp, w2, acc[4 * q + 2]); acc[4 * q + 3] = p6_dot2(xp, w3, acc[4 * q + 3]); }
                if (pe & 1) asm volatile("" ::: "memory"); } }
        const bool b0 = lane & 1, b1 = lane & 2, b2 = lane & 4, b3 = lane & 8;
        float r8[8], r4[4], r2[2];
#pragma unroll
        for (int i = 0; i < 8; ++i) r8[i] = (b0 ? acc[8 + i] : acc[i]) + dpp_f<0xB1>(b0 ? acc[i] : acc[8 + i]);
#pragma unroll
        for (int i = 0; i < 4; ++i) r4[i] = (b1 ? r8[4 + i] : r8[i]) + dpp_f<0x4E>(b1 ? r8[i] : r8[4 + i]);
#pragma unroll
        for (int i = 0; i < 2; ++i) r2[i] = (b2 ? r4[2 + i] : r4[i]) + dpp_f<0x1B>(dpp_f<0x141>(b2 ? r4[i] : r4[2 + i]));
        float lg = (b3 ? r2[1] : r2[0]) + dpp_f<0x128>(b3 ? r2[0] : r2[1]);
        lg += __shfl_xor(lg, 16); lg += __shfl_xor(lg, 32);
        const int ex = (b0 ? 8 : 0) + (b1 ? 4 : 0) + (b2 ? 2 : 0) + (b3 ? 1 : 0);
        lg += br[ex];
        const float mx = row16_max(lg), pe_ = __expf(lg - mx), den = row16_sum(pe_);
        if (lane < 16) AFF[(size_t)((m >> 14) * 16 + ex) * SEQ + (m & (SEQ - 1))] = pe_ / den;
    }
    __syncthreads();
}

__device__ __forceinline__ void p7_topk(const Ctx& C, int be, unsigned char* ws) {
    const float* AFF = (const float*)(ws + WS_AFF); int* IDX = (int*)(ws + WS_IDX); float* GATE = (float*)(ws + WS_GATE); short* SLOT = (short*)(ws + WS_SLOT);
    LAS unsigned* keys = (LAS unsigned*)C.lds;
    LAS unsigned* hist = (LAS unsigned*)(C.lds + 67584); LAS unsigned* misc = hist + 256; LAS unsigned* wsum = misc + 8;
    const int tid = C.tid, lane = C.lane, b = be >> 4, e = be & 15;
    __syncthreads();
    for (int i = tid; i < SEQ; i += 512) keys[i + (i >> 5)] = __float_as_uint(AFF[(size_t)be * SEQ + i]);
    unsigned prefix = 0u, mask = 0u, remaining = CAP;
#pragma unroll 1
    for (int pass = 0; pass < 4; ++pass) { const int shift = 24 - 8 * pass;
        if (tid < 256) hist[tid] = 0u;
        __syncthreads();
        for (int i = tid; i < SEQ; i += 512) { const unsigned k = keys[i + (i >> 5)]; if ((k & mask) == prefix) atomicAdd((unsigned*)&hist[(k >> shift) & 255u], 1u); }
        __syncthreads();
        if (tid < 64) { const unsigned c0 = hist[4 * lane], c1 = hist[4 * lane + 1], c2 = hist[4 * lane + 2], c3 = hist[4 * lane + 3]; const unsigned s4 = c0 + c1 + c2 + c3;
            unsigned inc = s4;
#pragma unroll
            for (int o = 1; o < 64; o <<= 1) { const unsigned y = __shfl_up(inc, o); if (lane >= o) inc += y; }
            const unsigned total = __shfl(inc, 63); unsigned cum = total - inc;
            const unsigned cs[4] = {c0, c1, c2, c3};
#pragma unroll
            for (int q = 3; q >= 0; --q) { if (cum < remaining && cum + cs[q] >= remaining) { misc[0] = 4 * lane + q; misc[1] = remaining - cum; } cum += cs[q]; } }
        __syncthreads();
        prefix |= misc[0] << shift; mask |= 0xffu << shift; remaining = misc[1];
        __syncthreads();
    }
    const unsigned T = prefix, need_eq = remaining;
    unsigned cg = 0, ce = 0;
#pragma unroll 8
    for (int i = 0; i < 32; ++i) { const unsigned k = keys[33 * tid + i]; cg += (k > T); ce += (k == T); }
    unsigned inc = cg | (ce << 16);
#pragma unroll
    for (int o = 1; o < 64; o <<= 1) { const unsigned y = __shfl_up(inc, o); if (lane >= o) inc += y; }
    if (lane == 63) wsum[C.wave] = inc;
    __syncthreads();
    unsigned off = 0;
#pragma unroll
    for (int w = 0; w < 8; ++w) off += (w < C.wave) ? wsum[w] : 0u;
    const unsigned ex = inc - (cg | (ce << 16)) + off; unsigned pg = ex & 0xffffu, pe = ex >> 16;
    const size_t rbase = (size_t)(e * 2 + b) * CAP;
#pragma unroll 4
    for (int i = 0; i < 32; ++i) { const unsigned k = keys[33 * tid + i]; const int tok = 32 * tid + i; int slot = -1;
        if (k > T) { slot = (int)(pg + (pe < need_eq ? pe : need_eq)); ++pg; }
        else if (k == T) { if (pe < need_eq) slot = (int)(pg + pe); ++pe; }
        SLOT[((size_t)b * SEQ + tok) * 16 + e] = (short)slot;
        if (slot >= 0) { IDX[rbase + slot] = tok; GATE[rbase + slot] = __uint_as_float(k); } }
    __syncthreads();
}

__device__ __forceinline__ void p8_gather(const Ctx& C, unsigned char* ws) {
    const bf16* X1 = (const bf16*)(ws + WS_X1); bf16* XG = (bf16*)(ws + WS_XG); const int* IDX = (const int*)(ws + WS_IDX);
    for (int r0 = C.gw; r0 < MOE_ROWS; r0 += 4 * C.NGW) {
        int tok[4];
#pragma unroll
        for (int u = 0; u < 4; ++u) tok[u] = IDX[min(r0 + u * C.NGW, MOE_ROWS - 1)];
        v4u a[4][4];
#pragma unroll
        for (int u = 0; u < 4; ++u) { const int r = min(r0 + u * C.NGW, MOE_ROWS - 1), b = (r >> 11) & 1; const v4u* s = (const v4u*)(X1 + (size_t)(b * SEQ + tok[u]) * DM) + C.lane;
            a[u][0] = s[0]; a[u][1] = s[64]; a[u][2] = s[128]; a[u][3] = s[192]; }
#pragma unroll
        for (int u = 0; u < 4; ++u) { v4u* d = (v4u*)(XG + (size_t)min(r0 + u * C.NGW, MOE_ROWS - 1) * DM) + C.lane; d[0] = a[u][0]; d[64] = a[u][1]; d[128] = a[u][2]; d[192] = a[u][3]; } }
}

__device__ __forceinline__ void p11_final(const Ctx& C, const float* g, const float* be, float* out, unsigned char* ws) {
    const bf16* X1 = (const bf16*)(ws + WS_X1); const unsigned char* Y = ws + WS_Y; const short* SLOT = (const short*)(ws + WS_SLOT);
    const unsigned char* ZROW = ws + WS_CTL + 512 * 1024;
    const int lane = C.lane;
    f32x4 gam[4][2], bet[4][2];
#pragma unroll
    for (int j = 0; j < 4; ++j) { const int k0 = 512 * j + 4 * lane; gam[j][0] = *(const f32x4*)(g + k0); gam[j][1] = *(const f32x4*)(g + k0 + 256); bet[j][0] = *(const f32x4*)(be + k0); bet[j][1] = *(const f32x4*)(be + k0 + 256); }
    for (int m = C.gw; m < MTOK; m += C.NGW) { const int b = m >> 14;
        float v[4][8];
#pragma unroll
        for (int j = 0; j < 4; ++j) { typedef unsigned v2u_ __attribute__((ext_vector_type(2)));
            const v2u_ aL = *(const v2u_*)(X1 + (size_t)m * DM + 512 * j + 4 * lane), aH = *(const v2u_*)(X1 + (size_t)m * DM + 512 * j + 256 + 4 * lane); const v4u a = (v4u){aL.x, aL.y, aH.x, aH.y};
            v[j][0] = bflo(a.x); v[j][1] = bfhi(a.x); v[j][2] = bflo(a.y); v[j][3] = bfhi(a.y); v[j][4] = bflo(a.z); v[j][5] = bfhi(a.z); v[j][6] = bflo(a.w); v[j][7] = bfhi(a.w);
#pragma unroll
            for (int e = 0; e < 8; ++e) v[j][e] *= DN_ALPHA; }
        const v4u s0 = *(const v4u*)(SLOT + (size_t)m * 16), s1 = *(const v4u*)(SLOT + (size_t)m * 16 + 8);
        const unsigned sw[8] = {s0.x, s0.y, s0.z, s0.w, s1.x, s1.y, s1.z, s1.w};
        int r0 = -1, r1 = -1, r2 = -1, r3 = -1, n = 0; unsigned rest = 0u;
#pragma unroll
        for (int e = 0; e < 16; ++e) { const int sl = __builtin_amdgcn_readfirstlane((int)(short)((e & 1) ? (sw[e >> 1] >> 16) : (sw[e >> 1] & 0xffffu)));
            if (sl >= 0) { const int row = (e * 2 + b) * CAP + sl; if (n == 0) r0 = row; else if (n == 1) r1 = row; else if (n == 2) r2 = row; else if (n == 3) r3 = row; else rest |= 1u << e; ++n; } }
        typedef int v2i_ __attribute__((ext_vector_type(2))); typedef float f2v_ __attribute__((ext_vector_type(2)));
#define ADD8(A) do { const int ax_ = A.x, ay_ = A.y; const f2v_ c0 = __builtin_amdgcn_cvt_pk_f32_fp8(ax_, false), c1 = __builtin_amdgcn_cvt_pk_f32_fp8(ax_, true), c2 = __builtin_amdgcn_cvt_pk_f32_fp8(ay_, false), c3 = __builtin_amdgcn_cvt_pk_f32_fp8(ay_, true); \
        v[j][0] += c0.x * (1.f / 64.f); v[j][1] += c0.y * (1.f / 64.f); v[j][2] += c1.x * (1.f / 64.f); v[j][3] += c1.y * (1.f / 64.f); v[j][4] += c2.x * (1.f / 64.f); v[j][5] += c2.y * (1.f / 64.f); v[j][6] += c3.x * (1.f / 64.f); v[j][7] += c3.y * (1.f / 64.f); } while (0)
        { const unsigned char* p0 = r0 >= 0 ? Y + (size_t)r0 * DM : ZROW; const unsigned char* p1 = r1 >= 0 ? Y + (size_t)r1 * DM : ZROW; const unsigned char* p2 = r2 >= 0 ? Y + (size_t)r2 * DM : ZROW; const unsigned char* p3 = r3 >= 0 ? Y + (size_t)r3 * DM : ZROW;
          v2i_ a0[4], a1[4], a2[4], a3[4];
#pragma unroll
#define LD8(P) (v2i_){*(const int*)((P) + 512 * j + 4 * lane), *(const int*)((P) + 512 * j + 256 + 4 * lane)}
          for (int j = 0; j < 4; ++j) { a0[j] = LD8(p0); a1[j] = LD8(p1); a2[j] = LD8(p2); a3[j] = LD8(p3); }
#pragma unroll
          for (int j = 0; j < 4; ++j) { ADD8(a0[j]); ADD8(a1[j]); ADD8(a2[j]); ADD8(a3[j]); } }
        while (rest) { const int e = __builtin_ctz(rest); rest &= rest - 1u;
            const int sl = __builtin_amdgcn_readfirstlane((int)*(const short*)(SLOT + (size_t)m * 16 + e));
            const unsigned char* yr = Y + ((size_t)(e * 2 + b) * CAP + sl) * DM;
#pragma unroll
            for (int j = 0; j < 4; ++j) { const v2i_ a = LD8(yr); ADD8(a); } }
#undef ADD8
#undef LD8
        float s = 0.f;
#pragma unroll
        for (int j = 0; j < 4; ++j)
#pragma unroll
            for (int e = 0; e < 8; ++e) s += v[j][e];
        const float mean = wave_sum(s) * (1.0f / DM); float q2 = 0.f;
#pragma unroll
        for (int j = 0; j < 4; ++j)
#pragma unroll
            for (int e = 0; e < 8; ++e) { v[j][e] -= mean; q2 += v[j][e] * v[j][e]; }
        const float rstd = 1.0f / sqrtf(wave_sum(q2) * (1.0f / DM) + LN_EPS);
#pragma unroll
        for (int j = 0; j < 4; ++j) { const int k0 = 512 * j + 4 * lane;
            const f32x4 ga = gam[j][0], gb = gam[j][1], ba = bet[j][0], bb = bet[j][1];
            f32x4 o0, o1;
#pragma unroll
            for (int e = 0; e < 4; ++e) { o0[e] = v[j][e] * rstd * ga[e] + ba[e]; o1[e] = v[j][4 + e] * rstd * gb[e] + bb[e]; }
            *(f32x4*)(out + (size_t)m * DM + k0) = o0; *(f32x4*)(out + (size_t)m * DM + k0 + 256) = o1; }
    }
}
struct Args { const float* in[28]; float* out; unsigned char* ws; int ph_lo, ph_hi; };
__global__ void __launch_bounds__(NWAVES * 64, 2) mega_fwd(Args args) {
    extern __shared__ __attribute__((aligned(16))) unsigned char lds[];
    Ctx C; C.lds = (LAS unsigned char*)lds; C.tid = threadIdx.x; C.lane = C.tid & 63; C.wave = __builtin_amdgcn_readfirstlane(C.tid >> 6);
    C.G = gridDim.x; C.gw = blockIdx.x * NWAVES + C.wave; C.NGW = C.G * NWAVES;
    unsigned char* ws = args.ws; unsigned* ctl = (unsigned*)(ws + WS_CTL);
    volatile LAS unsigned* MISC = (volatile LAS unsigned*)(C.lds + MISC_OFF);
    for (int u = C.tid; u < (LDS_BYTES - LDSCTL_OFF) / 4; u += NWAVES * 64) ((LAS unsigned*)(C.lds + LDSCTL_OFF))[u] = 0u;
    __syncthreads();
    XcdBarrier bar; bar.bar = ctl + CW_BAR; bar.x = 0; bar.st = nullptr;
    if (N_LAUNCHES == 1) bar = xcd_barrier_post(ctl + CW_BAR, MISC + 8);
    const int lo = args.ph_lo, hi = args.ph_hi;
    unsigned long long tacc_ = 0, t0_ = 0;
#ifndef PROBE_MULT
#define PROBE_MULT 1
#endif
#ifndef REP_MASK
#define REP_MASK 0
#endif
#define REPS(k) _Pragma("unroll") for (int rep_ = 0; rep_ < 1 + ((REP_MASK >> (k)) & 1); ++rep_)
#ifndef GREP_MASK
#define GREP_MASK 0
#endif
#define GREPS(k) (1 + ((GREP_MASK >> (k)) & 1))
#ifndef PH_MASK
#define PH_MASK 0xfff
#endif
#define IN(k) (((PH_MASK >> (k)) & 1) && lo <= (k) && (k) < hi)
#define SEAM(k) do { if (IN(k) && IN((k) + 1)) xcd_barrier(bar); } while (0)
    typedef const float* __attribute__((address_space(4))) const* KPtr;
    KPtr in0 = (KPtr)__builtin_amdgcn_kernarg_segment_ptr();
#define LAUNDER_IN() KPtr in = in0; asm volatile("" : "+s"(in))
#define GIN(k) ((const float*)(__attribute__((address_space(1))) const float*)in[k])
    LAS unsigned char* ring = C.lds;

    TSEC_B(100);
    if (IN(0)) REPS(0) { LAUNDER_IN(); p0_prologue(C, in, ws); __syncthreads(); }
    SEAM(0); TSEC_E(100);
    TSEC_B(101);
    if (IN(1)) REPS(1) { LAUNDER_IN();
        { pg8::Gemm g{(const bf16*)(ws + WS_WIN), (const bf16*)(ws + WS_XB), NHY, MTOK, DM}; pg8::StaticOrder S; S.init(NHY, MTOK, C.G, (int)blockIdx.x); S.reps = GREPS(1);
          pg8::EpiRowBias E{(bf16*)(ws + WS_PT), MTOK, GIN(2)};
          pg8::gemm_phase<pg8::EpiRowBias, pg8::StaticOrder, true, true>(ring, g, S, E); }
        __syncthreads();
        { pg8::Gemm g{(const bf16*)(ws + WS_XQ8), (const bf16*)(ws + WS_WIN) + (size_t)NHY * DM, MTOK, NATT, DM / 2}; pg8::StaticOrder S; S.init(MTOK, NATT, C.G, (int)blockIdx.x); S.reps = GREPS(1);
          pg8::EpiColBias E{(bf16*)(ws + WS_QKV), NATT, GIN(2) + NHY};
          pg8::gemm_phase_8<pg8::EpiColBias, pg8::StaticOrder, 122, 124, true, true>(ring, g, S, E); }
        __syncthreads();
        { pg8::Gemm g{(const bf16*)(ws + WS_W3T), (const bf16*)(ws + WS_H2), 4096, SEQ, 128}; pg8::StaticOrder S; S.init(4096, SEQ, C.G, (int)blockIdx.x); S.reps = GREPS(1);
          pg8::EpiFilt E{(bf16*)(ws + WS_FILT), SEQ, GIN(12)};
          pg8::gemm_phase<pg8::EpiFilt, pg8::StaticOrder, true, true>(ring, g, S, E); }
        __syncthreads();
    }
    SEAM(1); TSEC_E(101);
    TSEC_B(102);
    if (IN(2)) REPS(2) { LAUNDER_IN();
        p2_kpass(C, GIN(15), ws);
        for (int c = blockIdx.x; c < HYW; c += C.G) { hy_unit(c, GIN(3), GIN(4), GIN(13), ws, lds, (C.wave << 6) + (int)__builtin_amdgcn_mbcnt_hi(~0u, __builtin_amdgcn_mbcnt_lo(~0u, 0u)), tacc_); __syncthreads(); }
    }
    SEAM(2); TSEC_E(102);
    TSEC_B(103);
    if (IN(3)) REPS(3) { LAUNDER_IN();
        const bf16* QKV = (const bf16*)(ws + WS_QKV); const unsigned char* KP = ws + WS_KP; const unsigned char* VP = ws + WS_VP; bf16* YATT = (bf16*)(ws + WS_YATT);
        for (int rnd = 0; rnd * C.G < 1024; ++rnd) {
            int b, h, qb;
            if (C.G == 256) { const int xcd = blockIdx.x & 7, w = blockIdx.x >> 3, pair = xcd >> 1, idx = (xcd & 1) * 128 + rnd * 32 + w; b = pair >> 1; h = (pair & 1) * 4 + (idx >> 6); qb = idx & 63; }
            else { const int u = rnd * C.G + blockIdx.x; if (u >= 1024) break; b = u >> 9; h = (u >> 6) & 7; qb = u & 63; }
            const int kvh = h >> 2; const size_t m0 = (size_t)b * SEQ + qb * 256;
            att::attn_unit(QKV + m0 * NATT + h * 128, qb * 256, GIN(14), KP + (size_t)(b * 2 + kvh) * SEQ * 128, VP + (size_t)(b * 2 + kvh) * SEQ * 128, YATT + m0 * 1024 + h * 128, SEQ, (char*)lds);
        }
    }
    SEAM(3); TSEC_E(103);
    TSEC_B(104);
    if (IN(4)) REPS(4) { LAUNDER_IN(); p4_merge(C, GIN(16), GIN(17), ws); __syncthreads(); }
    SEAM(4); TSEC_E(104);
    TSEC_B(105);
    if (IN(5)) REPS(5) { LAUNDER_IN();
        pg8::Gemm g{(const bf16*)(ws + WS_MIX), (const bf16*)(ws + WS_WOUT), MTOK, DM, DM}; pg8::StaticOrder S; S.init(MTOK, DM, C.G, (int)blockIdx.x); S.reps = GREPS(5);
        pg8::EpiResid E{(bf16*)(ws + WS_T), DM, (const bf16*)(ws + WS_XB), DN_ALPHA};
        pg8::gemm_phase<pg8::EpiResid, pg8::StaticOrder, true, true>(ring, g, S, E);
        __syncthreads();
    }
    SEAM(5); TSEC_E(105);
    TSEC_B(106);
    if (IN(6)) REPS(6) { LAUNDER_IN(); p6_ln_router(C, GIN(19), GIN(20), GIN(21), GIN(22), ws); }
    SEAM(6); TSEC_E(106);
    TSEC_B(107);
    if (IN(7)) REPS(7) { LAUNDER_IN(); if (blockIdx.x >= 32) p7_side_transposes(C, GIN(25), ws); else { for (int be = blockIdx.x; be < BATCH * NE; be += C.G) p7_topk(C, be, ws); } }
    SEAM(7); TSEC_E(107);
    TSEC_B(109);
    if (IN(9)) REPS(9) { LAUNDER_IN();
        pg8::Gemm g{(const bf16*)(ws + WS_X8), (const bf16*)(ws + WS_WGU), MOE_ROWS, 3072, DM / 2}; pg8::GroupedOrder S; S.initg(12, C.G, (int)blockIdx.x); S.reps = GREPS(9);
        pg8::EpiSwiGLU8 E{ws + WS_HB, EFF, 12};
        struct MoeRows { const int* idx; __device__ __forceinline__ int row(int r) const { return ((r >> 11) & 1) * SEQ + idx[r]; } } Gt{(const int*)(ws + WS_IDX)};
        pg8::gemm_phase_g8<pg8::EpiSwiGLU8, pg8::GroupedOrder, MoeRows, true, true>(ring, g, S, E, Gt);
        __syncthreads();
    }
    SEAM(9); TSEC_E(109);
    TSEC_B(110);
    if (IN(10)) REPS(10) { LAUNDER_IN();
        pg8::Gemm g{(const bf16*)(ws + WS_HB), (const bf16*)(ws + WS_WD), MOE_ROWS, DM, EFF / 2}; pg8::GroupedOrder S; S.initg(8, C.G, (int)blockIdx.x); S.reps = GREPS(10);
        pg8::EpiRowScale E{ws + WS_Y, DM, (const float*)(ws + WS_GATE), 8};
        pg8::gemm_phase_8<pg8::EpiRowScale, pg8::GroupedOrder, 122, 124, true, true>(ring, g, S, E);
        __syncthreads();
    }
    SEAM(10); TSEC_E(110);
    TSEC_B(111);
    if (IN(11)) REPS(11) { LAUNDER_IN(); p11_final(C, GIN(26), GIN(27), args.out, ws); }
    TSEC_E(111);
    if (PROBE_SEC) { const unsigned long long te = __builtin_amdgcn_s_memrealtime(); while (__builtin_amdgcn_s_memrealtime() - te < tacc_ * PROBE_MULT) __builtin_amdgcn_s_sleep(8); }
#undef IN
#undef SEAM
}

extern "C" void kernel_launch(void* const* d_in, const int* in_sizes, int n_in, void* d_out, int out_size, void* d_ws, size_t ws_size, hipStream_t stream) {
    static int grid = 0;
    if (grid == 0) {
        if (n_in != 28 || in_sizes[0] != MTOK * DM || out_size != MTOK * DM || ws_size < WS_END) { fprintf(stderr, "kernel_launch: unexpected shapes (n_in %d, in0 %d, out %d, ws %zu < %zu)\n", n_in, n_in > 0 ? in_sizes[0] : -1, out_size, ws_size, (size_t)WS_END); grid = -1; return; }
        int dev = 0, cus = 0, per_cu = 0;
        if (hipGetDevice(&dev) != hipSuccess || hipDeviceGetAttribute(&cus, hipDeviceAttributeMultiprocessorCount, dev) != hipSuccess) { grid = -1; return; }
        if (hipFuncSetAttribute((const void*)mega_fwd, hipFuncAttributeMaxDynamicSharedMemorySize, LDS_BYTES) != hipSuccess) { fprintf(stderr, "kernel_launch: hipFuncSetAttribute failed\n"); grid = -1; return; }
        if (hipOccupancyMaxActiveBlocksPerMultiprocessor(&per_cu, (const void*)mega_fwd, NWAVES * 64, LDS_BYTES) != hipSuccess || per_cu < 1) { fprintf(stderr, "kernel_launch: occupancy query says %d\n", per_cu); }
        (void)hipGetLastError();
        grid = cus;
    }
    if (grid < 0) return;
    if (hipMemsetAsync((char*)d_ws + WS_CTL, 0, CTL_ZERO_BYTES, stream) != hipSuccess) return;
    Args a{};
    for (int i = 0; i < 28; ++i) a.in[i] = (const float*)d_in[i];
    a.out = (float*)d_out; a.ws = (unsigned char*)d_ws;
    for (int li = 0; li < N_LAUNCHES; ++li) {
        a.ph_lo = (N_LAUNCHES == 1) ? 0 : li; a.ph_hi = (N_LAUNCHES == 1) ? N_PHASES : li + 1;
        hipLaunchKernelGGL(mega_fwd, dim3(grid), dim3(NWAVES * 64), LDS_BYTES, stream, a);
    }
}
```
